# Optimizing an MI355X kernel written in HIP

```python
import math
import jax, jax.numpy as jnp
from jax import lax
import numpy as np

D_MODEL = 2048
BATCH = 2
SEQ = 4096
DEPTH = 1

CHUNK = 64
QBLOCK = 128
EPS = 1e-6

MLA_HEADS = 8
MLA_NOPE = 128
MLA_ROPE = 64
MLA_V = 128
MLA_QK = MLA_NOPE + MLA_ROPE
Q_LORA = 512
KV_LORA = 256
ROPE_THETA = 10000.0

DSA_HEADS = 8
DSA_HD = 128
IDX_HEADS = 16
IDX_HD = 64
DSA_TOPK = 256

REL_BUCKETS = 32
REL_MAX_DIST = 128

PEER_HEADS = 8
PEER_NKEYS = 128
PEER_EXPERTS = PEER_NKEYS * PEER_NKEYS
PEER_DKEY = 256
PEER_TOPK = 16

MIX_WIDTH = MLA_HEADS * MLA_V + DSA_HEADS * DSA_HD
IN_SPLITS = (Q_LORA, KV_LORA, MLA_ROPE,
             DSA_HEADS * DSA_HD, DSA_HEADS * DSA_HD, DSA_HEADS * DSA_HD,
             IDX_HEADS * IDX_HD, IDX_HD, IDX_HEADS)
IN_WIDTH = sum(IN_SPLITS)
IN_OFFSETS = tuple(int(o) for o in np.cumsum(IN_SPLITS)[:-1])

kernel_name = "hybrid_mla_dsa_peer_block"


def rmsnorm(x, g):
    xf = x.astype(jnp.float32)
    y = xf * lax.rsqrt(jnp.mean(xf * xf, axis=-1, keepdims=True) + EPS)
    return (y * g.astype(jnp.float32)).astype(x.dtype)


def rope(x, pos):
    half = MLA_ROPE // 2
    freqs = ROPE_THETA ** (-2.0 * jnp.arange(half, dtype=jnp.float32) / MLA_ROPE)
    ang = pos.astype(jnp.float32)[:, None] * freqs[None, :]
    cos = jnp.cos(ang)[None, :, None, :]
    sin = jnp.sin(ang)[None, :, None, :]
    xf = x.astype(jnp.float32)
    x1, x2 = xf[..., :half], xf[..., half:]
    return jnp.concatenate([x1 * cos - x2 * sin, x1 * sin + x2 * cos], axis=-1).astype(x.dtype)


def to_blocks(a):
    b, s = a.shape[:2]
    return jnp.moveaxis(a.reshape((b, s // QBLOCK, QBLOCK) + a.shape[2:]), 1, 0)


def from_blocks(a):
    n, b, t = a.shape[:3]
    return jnp.moveaxis(a, 0, 1).reshape((b, n * t) + a.shape[3:])


def t5_bucket(rel):
    nb = REL_BUCKETS // 2
    max_exact = nb // 2
    ret = jnp.where(rel > 0, nb, 0)
    n = jnp.abs(rel)
    nf = jnp.maximum(n, 1).astype(jnp.float32)
    large = max_exact + (jnp.log(nf / max_exact) / math.log(REL_MAX_DIST / max_exact)
                         * (nb - max_exact)).astype(jnp.int32)
    large = jnp.minimum(large, nb - 1)
    return ret + jnp.where(n < max_exact, n, large)


def mla_attention(c_q, c_kv, k_rope, g_cq, g_ckv, w_uq, w_ukv, g_qn, g_kn, pos):
    b, s, _ = c_q.shape
    q = (rmsnorm(c_q, g_cq) @ w_uq).reshape(b, s, MLA_HEADS, MLA_QK)
    kv = (rmsnorm(c_kv, g_ckv) @ w_ukv).reshape(b, s, MLA_HEADS, MLA_NOPE + MLA_V)
    k_nope, v = kv[..., :MLA_NOPE], kv[..., MLA_NOPE:]
    k = jnp.concatenate([k_nope, jnp.broadcast_to(k_rope[:, :, None, :], (b, s, MLA_HEADS, MLA_ROPE))], axis=-1)
    q = rmsnorm(q, g_qn)
    k = rmsnorm(k, g_kn)
    q = jnp.concatenate([q[..., :MLA_NOPE], rope(q[..., MLA_NOPE:], pos)], axis=-1)
    k = jnp.concatenate([k[..., :MLA_NOPE], rope(k[..., MLA_NOPE:], pos)], axis=-1)
    key_chunk = pos // CHUNK
    scale = MLA_QK ** -0.5

    def block(args):
        qb, tb = args
        sc = jnp.einsum('bthd,bshd->bhts', qb, k, preferred_element_type=jnp.float32) * scale
        mask = key_chunk[None, :] <= (tb // CHUNK)[:, None]
        sc = jnp.where(mask[None, None], sc, -jnp.inf)
        p = jax.nn.softmax(sc, axis=-1)
        return jnp.einsum('bhts,bshd->bthd', p.astype(v.dtype), v)

    out = lax.map(block, (to_blocks(q), pos.reshape(-1, QBLOCK)))
    return from_blocks(out).reshape(b, s, MLA_HEADS * MLA_V)


def dsa_attention(q, k, v, q_idx, k_idx, w_idx, g_qn, g_kn, rel_bias, pos):
    b, s, _ = q.shape
    q = rmsnorm(q.reshape(b, s, DSA_HEADS, DSA_HD), g_qn)
    k = rmsnorm(k.reshape(b, s, DSA_HEADS, DSA_HD), g_kn)
    v = v.reshape(b, s, DSA_HEADS, DSA_HD)
    q_idx = q_idx.reshape(b, s, IDX_HEADS, IDX_HD)
    n_sel = min(DSA_TOPK, s // 4)
    key_chunk = pos // CHUNK
    scale = DSA_HD ** -0.5
    idx_scale = IDX_HD ** -0.5
    gather = jax.vmap(lambda a, i: a[i])

    def block(args):
        qb, qib, wb, tb = args
        dots = jnp.einsum('bthd,bsd->bths', qib, k_idx, preferred_element_type=jnp.float32) * idx_scale
        index_score = jnp.einsum('bth,bths->bts', wb.astype(jnp.float32), jax.nn.relu(dots))
        admissible = key_chunk[None, :] <= (tb // CHUNK)[:, None]
        index_score = jnp.where(admissible[None], index_score, -jnp.inf)
        _, sel = lax.top_k(index_score, n_sel)
        valid = (sel // CHUNK) <= (tb // CHUNK)[None, :, None]
        ks = gather(k, sel)
        vs = gather(v, sel)
        bias = rel_bias[t5_bucket(sel - tb[None, :, None])]
        logits = (jnp.einsum('bthd,btkhd->bhtk', qb, ks, preferred_element_type=jnp.float32) * scale
                  + jnp.moveaxis(bias, -1, 1).astype(jnp.float32))
        logits = jnp.where(valid[:, None], logits, -jnp.inf)
        p = jax.nn.softmax(logits, axis=-1)
        return jnp.einsum('bhtk,btkhd->bthd', p.astype(vs.dtype), vs)

    out = lax.map(block, (to_blocks(q), to_blocks(q_idx), to_blocks(w_idx), pos.reshape(-1, QBLOCK)))
    return from_blocks(out).reshape(b, s, DSA_HEADS * DSA_HD)


def peer(h, w_pq, sub_keys, u_tab, v_tab):
    def block(hb):
        b, t, _ = hb.shape
        qr = (hb @ w_pq).reshape(b, t, PEER_HEADS, 2, PEER_DKEY // 2)
        sc = jnp.einsum('bthpd,hpnd->bthpn', qr, sub_keys, preferred_element_type=jnp.float32)
        s_top, i_top = lax.top_k(sc, PEER_TOPK)
        cand = s_top[..., 0, :, None] + s_top[..., 1, None, :]
        c_top, c_pos = lax.top_k(cand.reshape(b, t, PEER_HEADS, PEER_TOPK * PEER_TOPK), PEER_TOPK)
        i0 = jnp.take_along_axis(i_top[..., 0, :], c_pos // PEER_TOPK, axis=-1)
        i1 = jnp.take_along_axis(i_top[..., 1, :], c_pos % PEER_TOPK, axis=-1)
        expert = i0 * PEER_NKEYS + i1
        g = jax.nn.softmax(c_top, axis=-1)
        u = u_tab[expert]
        a = jax.nn.gelu(jnp.einsum('bthkd,btd->bthk', u, hb, preferred_element_type=jnp.float32),
                        approximate=False)
        return jnp.einsum('bthk,bthkd->btd', (g * a).astype(v_tab.dtype), v_tab[expert])

    return from_blocks(lax.map(block, to_blocks(h)))


def setup_inputs(seed: int = 0) -> dict:
    key = jax.random.key(seed)
    ks = jax.random.split(key, 20)
    f32 = jnp.float32

    def nrm(k, shape, scale):
        return jax.random.normal(k, shape, f32) * scale

    def gain(k, shape):
        return 1.0 + 0.01 * jax.random.normal(k, shape, f32)

    return {
        "x": nrm(ks[0], (BATCH, SEQ, D_MODEL), 1.0),
        "g_attn": gain(ks[1], (DEPTH, D_MODEL)),
        "w_in": nrm(ks[2], (DEPTH, D_MODEL, IN_WIDTH), D_MODEL ** -0.5),
        "g_cq": gain(ks[3], (DEPTH, Q_LORA)),
        "g_ckv": gain(ks[4], (DEPTH, KV_LORA)),
        "w_uq": nrm(ks[5], (DEPTH, Q_LORA, MLA_HEADS * MLA_QK), Q_LORA ** -0.5),
        "w_ukv": nrm(ks[6], (DEPTH, KV_LORA, MLA_HEADS * (MLA_NOPE + MLA_V)), KV_LORA ** -0.5),
        "g_mla_q": gain(ks[7], (DEPTH, MLA_QK)),
        "g_mla_k": gain(ks[8], (DEPTH, MLA_QK)),
        "g_dsa_q": gain(ks[9], (DEPTH, DSA_HD)),
        "g_dsa_k": gain(ks[10], (DEPTH, DSA_HD)),
        "rel_bias": nrm(ks[11], (REL_BUCKETS, DSA_HEADS), 0.5),
        "w_o": nrm(ks[12], (DEPTH, MIX_WIDTH, D_MODEL), MIX_WIDTH ** -0.5),
        "g_ffn": gain(ks[13], (DEPTH, D_MODEL)),
        "w_pq": nrm(ks[14], (DEPTH, D_MODEL, PEER_HEADS * PEER_DKEY), D_MODEL ** -0.5),
        "sub_keys": nrm(ks[15], (DEPTH, PEER_HEADS, 2, PEER_NKEYS, PEER_DKEY // 2), (PEER_DKEY // 2) ** -0.5),
        "u_tab": nrm(ks[16], (DEPTH, PEER_EXPERTS, D_MODEL), D_MODEL ** -0.5),
        "v_tab": nrm(ks[17], (DEPTH, PEER_EXPERTS, D_MODEL), PEER_HEADS ** -0.5),
    }


def reference(x, g_attn, w_in, g_cq, g_ckv, w_uq, w_ukv, g_mla_q, g_mla_k, g_dsa_q, g_dsa_k,
              rel_bias, w_o, g_ffn, w_pq, sub_keys, u_tab, v_tab):
    s = x.shape[1]
    pos = jnp.arange(s, dtype=jnp.int32)
    for l in range(DEPTH):
        h = rmsnorm(x, g_attn[l])
        proj = h @ w_in[l]
        c_q, c_kv, k_rope, q_d, k_d, v_d, q_i, k_i, w_i = jnp.split(proj, IN_OFFSETS, axis=-1)
        y_a = mla_attention(c_q, c_kv, k_rope, g_cq[l], g_ckv[l], w_uq[l], w_ukv[l],
                            g_mla_q[l], g_mla_k[l], pos)
        y_b = dsa_attention(q_d, k_d, v_d, q_i, k_i, w_i, g_dsa_q[l], g_dsa_k[l], rel_bias, pos)
        x = x + jnp.concatenate([y_a, y_b], axis=-1) @ w_o[l]
        x = x + peer(rmsnorm(x, g_ffn[l]), w_pq[l], sub_keys[l], u_tab[l], v_tab[l])
    return x
```

```cpp
#include <hip/hip_runtime.h>
#include <stdint.h>
#include <cstdio>

constexpr int B_ = 2, S_ = 4096, D_ = 2048, T_ = B_ * S_;
constexpr int INW = 5008;
constexpr int OFF_CQ = 0, OFF_CKV = 512, OFF_KR = 768, OFF_QD = 832, OFF_KD = 1856, OFF_VD = 2880, OFF_QI = 3904, OFF_KI = 4928, OFF_WI = 4992;
constexpr float EPS = 1e-6f;

__device__ __forceinline__ float wave_sum(float v) {
#pragma unroll
  for (int o = 1; o < 64; o <<= 1) v += __shfl_xor(v, o);
  return v;
}
__device__ __forceinline__ float wave_max(float v) {
#pragma unroll
  for (int o = 1; o < 64; o <<= 1) v = fmaxf(v, __shfl_xor(v, o));
  return v;
}

__global__ __launch_bounds__(256) void k_rmsnorm(const float* __restrict__ in, int ld_in, int C, const float* __restrict__ g, float* __restrict__ out, int ld_out, int rows) {
  const int row = blockIdx.x * 4 + (threadIdx.x >> 6), lane = threadIdx.x & 63;
  if (row >= rows) return;
  const float* x = in + (size_t)row * ld_in;
  float s = 0.f;
  for (int c = lane; c < C; c += 64) { const float v = x[c]; s += v * v; }
  s = wave_sum(s);
  const float r = 1.0f / sqrtf(s / (float)C + EPS);
  float* o = out + (size_t)row * ld_out;
  for (int c = lane; c < C; c += 64) o[c] = x[c] * r * g[c];
}

__global__ __launch_bounds__(256) void k_gemm(const float* __restrict__ A, int lda, const float* __restrict__ Bm, int ldb, float* __restrict__ C, int ldc,
                                              int M, int N, int K, const float* __restrict__ R, int ldr) {
  __shared__ float As[16][68];
  __shared__ float Bs[16][68];
  const int tid = threadIdx.x, tx = tid & 15, ty = tid >> 4;
  const int m0 = blockIdx.y * 64, n0 = blockIdx.x * 64;
  float acc[4][4];
#pragma unroll
  for (int i = 0; i < 4; ++i)
#pragma unroll
    for (int j = 0; j < 4; ++j) acc[i][j] = 0.f;
  const int ar = tid >> 2, ak = (tid & 3) * 4;
  const int bk = tid >> 4, bn = (tid & 15) * 4;
  for (int k0 = 0; k0 < K; k0 += 16) {
    const float4 av = *(const float4*)(A + (size_t)(m0 + ar) * lda + k0 + ak);
    float4 bv = make_float4(0.f, 0.f, 0.f, 0.f);
    if (n0 + bn < N) bv = *(const float4*)(Bm + (size_t)(k0 + bk) * ldb + n0 + bn);
    __syncthreads();
    As[ak + 0][ar] = av.x; As[ak + 1][ar] = av.y; As[ak + 2][ar] = av.z; As[ak + 3][ar] = av.w;
    *(float4*)&Bs[bk][bn] = bv;
    __syncthreads();
#pragma unroll
    for (int k = 0; k < 16; ++k) {
      const float4 a = *(const float4*)&As[k][ty * 4];
      const float4 b = *(const float4*)&Bs[k][tx * 4];
      const float aa[4] = {a.x, a.y, a.z, a.w}, bb[4] = {b.x, b.y, b.z, b.w};
#pragma unroll
      for (int i = 0; i < 4; ++i)
#pragma unroll
        for (int j = 0; j < 4; ++j) acc[i][j] = fmaf(aa[i], bb[j], acc[i][j]);
    }
  }
  if (n0 + tx * 4 < N) {
#pragma unroll
    for (int i = 0; i < 4; ++i) {
      const int m = m0 + ty * 4 + i;
      float4 o = make_float4(acc[i][0], acc[i][1], acc[i][2], acc[i][3]);
      if (R) { const float4 r = *(const float4*)(R + (size_t)m * ldr + n0 + tx * 4); o.x += r.x; o.y += r.y; o.z += r.z; o.w += r.w; }
      *(float4*)(C + (size_t)m * ldc + n0 + tx * 4) = o;
    }
  }
}

__global__ __launch_bounds__(256) void k_mla_prep(const float* __restrict__ Qraw  , const float* __restrict__ KVraw  , const float* __restrict__ proj,
                                                  const float* __restrict__ gq, const float* __restrict__ gk, float* __restrict__ Qm, float* __restrict__ KmT) {
  const int w = blockIdx.x * 4 + (threadIdx.x >> 6), lane = threadIdx.x & 63;
  const int t = w >> 3, h = w & 7, b = t / S_, s = t % S_;
  const int bh = b * 8 + h;
  const int i = lane & 31;
  const float freq = powf(10000.0f, -2.0f * (float)i / 64.0f);
  const float ang = (float)s * freq;
  const float cs = cosf(ang), sn = sinf(ang);
  {
    const float* q = Qraw + (size_t)t * 1536 + h * 192;
    float v0 = q[lane], v1 = q[64 + lane], v2 = q[128 + lane];
    float ss = wave_sum(v0 * v0 + v1 * v1 + v2 * v2);
    const float r = 1.0f / sqrtf(ss / 192.0f + EPS);
    v0 = v0 * r * gq[lane]; v1 = v1 * r * gq[64 + lane]; v2 = v2 * r * gq[128 + lane];
    const float other = __shfl_xor(v2, 32);
    const float rot = (lane < 32) ? (v2 * cs - other * sn) : (other * sn + v2 * cs);
    float* o = Qm + ((size_t)bh * S_ + s) * 192;
    o[lane] = v0; o[64 + lane] = v1; o[128 + lane] = rot;
  }
  {
    const float* kv = KVraw + (size_t)t * 2048 + h * 256;
    float v0 = kv[lane], v1 = kv[64 + lane], v2 = proj[(size_t)t * INW + OFF_KR + lane];
    float ss = wave_sum(v0 * v0 + v1 * v1 + v2 * v2);
    const float r = 1.0f / sqrtf(ss / 192.0f + EPS);
    v0 = v0 * r * gk[lane]; v1 = v1 * r * gk[64 + lane]; v2 = v2 * r * gk[128 + lane];
    const float other = __shfl_xor(v2, 32);
    const float rot = (lane < 32) ? (v2 * cs - other * sn) : (other * sn + v2 * cs);
    float* o = KmT + (size_t)bh * 192 * S_ + s;
    o[(size_t)lane * S_] = v0; o[(size_t)(64 + lane) * S_] = v1; o[(size_t)(128 + lane) * S_] = rot;
  }
}

__global__ __launch_bounds__(256) void k_dsa_prep(const float* __restrict__ proj, const float* __restrict__ gq, const float* __restrict__ gk,
                                                  float* __restrict__ Qd, float* __restrict__ KdT) {
  const int w = blockIdx.x * 4 + (threadIdx.x >> 6), lane = threadIdx.x & 63;
  const int t = w >> 3, h = w & 7, b = t / S_, s = t % S_;
  const int bh = b * 8 + h;
  const float* p = proj + (size_t)t * INW;
  {
    float v0 = p[OFF_QD + h * 128 + lane], v1 = p[OFF_QD + h * 128 + 64 + lane];
    const float r = 1.0f / sqrtf(wave_sum(v0 * v0 + v1 * v1) / 128.0f + EPS);
    float* o = Qd + ((size_t)bh * S_ + s) * 128;
    o[lane] = v0 * r * gq[lane]; o[64 + lane] = v1 * r * gq[64 + lane];
  }
  {
    float v0 = p[OFF_KD + h * 128 + lane], v1 = p[OFF_KD + h * 128 + 64 + lane];
    const float r = 1.0f / sqrtf(wave_sum(v0 * v0 + v1 * v1) / 128.0f + EPS);
    float* o = KdT + (size_t)bh * 128 * S_ + s;
    o[(size_t)lane * S_] = v0 * r * gk[lane]; o[(size_t)(64 + lane) * S_] = v1 * r * gk[64 + lane];
  }
}

__device__ __forceinline__ int t5_bucket(int rel) {
  const int n = rel < 0 ? -rel : rel;
  int bkt;
  if (n < 8) bkt = n; else if (n < 12) bkt = 8; else if (n < 16) bkt = 9; else if (n < 23) bkt = 10; else if (n < 32) bkt = 11;
  else if (n < 46) bkt = 12; else if (n < 64) bkt = 13; else if (n < 91) bkt = 14; else bkt = 15;
  return bkt + (rel > 0 ? 16 : 0);
}

template <int DQ>
__global__ __launch_bounds__(256) void k_attn(const float* __restrict__ Q, const float* __restrict__ KT, const float* __restrict__ V, int ldv, int voff, int vhs, float scale,
                                              const unsigned* __restrict__ mask, const float* __restrict__ rel_bias, float* __restrict__ Y, int ycol0) {
  __shared__ float qs[4][DQ];
  __shared__ float ps[4][64];
  const int wv = threadIdx.x >> 6, lane = threadIdx.x & 63;
  const int w = blockIdx.x * 4 + wv;
  const int bh = w / S_, s = w % S_, b = bh >> 3, h = bh & 7;
  const int t = b * S_ + s;
  const float* q = Q + ((size_t)bh * S_ + s) * DQ;
  for (int d = lane; d < DQ; d += 64) qs[wv][d] = q[d];
  __syncthreads();
  const int nt = (s >> 6) + 1;
  float m = -1e30f, l = 0.f, o0 = 0.f, o1 = 0.f;
  const float* kt = KT + (size_t)bh * DQ * S_;
  const float* vb = V + (size_t)b * S_ * ldv + voff + h * vhs;
  for (int j = 0; j < nt; ++j) {
    const int key = j * 64 + lane;
    float sc = 0.f;
    for (int d = 0; d < DQ; ++d) sc = fmaf(qs[wv][d], kt[(size_t)d * S_ + key], sc);
    sc *= scale;
    bool ok = true;
    if (mask) {
      const unsigned wd = mask[(size_t)t * 128 + 2 * j + (lane >> 5)];
      ok = (wd >> (lane & 31)) & 1u;
      sc += rel_bias[t5_bucket(key - s) * 8 + h];
    }
    if (!ok) sc = -1e30f;
    const float mn = fmaxf(m, wave_max(sc));
    const float alpha = __expf(m - mn);
    const float p = ok ? __expf(sc - mn) : 0.f;
    l = l * alpha + wave_sum(p);
    o0 *= alpha; o1 *= alpha;
    m = mn;
    ps[wv][lane] = p;
    __syncthreads();
    for (int k = 0; k < 64; ++k) {
      const float pk = ps[wv][k];
      const float* vr = vb + (size_t)(j * 64 + k) * ldv;
      o0 = fmaf(pk, vr[lane], o0); o1 = fmaf(pk, vr[64 + lane], o1);
    }
    __syncthreads();
  }
  const float inv = 1.0f / l;
  float* y = Y + (size_t)t * 2048 + ycol0 + h * 128;
  y[lane] = o0 * inv; y[64 + lane] = o1 * inv;
}

__global__ __launch_bounds__(256) void k_kit(const float* __restrict__ proj, float* __restrict__ KIT) {
  const int idx = blockIdx.x * 256 + threadIdx.x;
  const int t = idx >> 6, d = idx & 63, b = t / S_, s = t % S_;
  KIT[((size_t)b * 64 + d) * S_ + s] = proj[(size_t)t * INW + OFF_KI + d];
}

__global__ __launch_bounds__(128) void k_index(const float* __restrict__ proj, const float* __restrict__ KIT, unsigned* __restrict__ MASK) {
  __shared__ float qs[2][16 * 64];
  __shared__ float ws[2][16];
  __shared__ float scs[2][4096];
  const int wv = threadIdx.x >> 6, lane = threadIdx.x & 63;
  const int t = blockIdx.x * 2 + wv, b = t / S_, s = t % S_;
  const float* p = proj + (size_t)t * INW;
  for (int i = lane; i < 1024; i += 64) qs[wv][i] = p[OFF_QI + i];
  if (lane < 16) ws[wv][lane] = p[OFF_WI + lane];
  __syncthreads();
  const int nt = (s >> 6) + 1;
  const float* kt = KIT + (size_t)b * 64 * S_;
  for (int j = 0; j < nt; ++j) {
    const int key = j * 64 + lane;
    float kk[64];
#pragma unroll
    for (int d = 0; d < 64; ++d) kk[d] = kt[(size_t)d * S_ + key];
    float score = 0.f;
    for (int hh = 0; hh < 16; ++hh) {
      float dot = 0.f;
#pragma unroll
      for (int d = 0; d < 64; ++d) dot = fmaf(qs[wv][hh * 64 + d], kk[d], dot);
      dot *= 0.125f;
      score = fmaf(ws[wv][hh], fmaxf(dot, 0.f), score);
    }
    scs[wv][key] = score;
  }
  __syncthreads();
  unsigned u[64];
#pragma unroll
  for (int j = 0; j < 64; ++j) {
    u[j] = 0u;
    if (j < nt) { const unsigned bits = __float_as_uint(scs[wv][j * 64 + lane]); u[j] = (bits & 0x80000000u) ? ~bits : (bits | 0x80000000u); }
  }
  unsigned thr = 1u;
  if (nt * 64 > 256) {
    thr = 0u;
    for (int bit = 31; bit >= 0; --bit) {
      const unsigned cand = thr | (1u << bit);
      int cnt = 0;
#pragma unroll
      for (int j = 0; j < 64; ++j) cnt += (u[j] >= cand) ? 1 : 0;
#pragma unroll
      for (int o = 1; o < 64; o <<= 1) cnt += __shfl_xor(cnt, o);
      if (cnt >= 256) thr = cand;
    }
  }
#pragma unroll
  for (int j = 0; j < 64; ++j) {
    const unsigned long long bal = __ballot(u[j] >= thr && j < nt);
    if (lane == 0) { MASK[(size_t)t * 128 + 2 * j] = (unsigned)bal; MASK[(size_t)t * 128 + 2 * j + 1] = (unsigned)(bal >> 32); }
  }
}

__global__ __launch_bounds__(256) void k_skt(const float* __restrict__ sk, float* __restrict__ SKT) {
  const int idx = blockIdx.x * 256 + threadIdx.x;
  const int hp = idx >> 14, n = (idx >> 7) & 127, d = idx & 127;
  SKT[((size_t)hp * 128 + d) * 128 + n] = sk[idx];
}

__global__ __launch_bounds__(256) void k_peer_top(const float* __restrict__ QR, const float* __restrict__ SKT, float* __restrict__ ST, int* __restrict__ IT) {
  __shared__ float qs[4][128];
  const int wv = threadIdx.x >> 6, lane = threadIdx.x & 63;
  const int w = blockIdx.x * 4 + wv;
  const int t = w >> 4, hp = w & 15;
  const float* q = QR + (size_t)t * 2048 + hp * 128;
  qs[wv][lane] = q[lane]; qs[wv][64 + lane] = q[64 + lane];
  __syncthreads();
  const float* kt = SKT + (size_t)hp * 128 * 128;
  float s0 = 0.f, s1 = 0.f;
  for (int d = 0; d < 128; ++d) { const float qd = qs[wv][d]; s0 = fmaf(qd, kt[d * 128 + lane], s0); s1 = fmaf(qd, kt[d * 128 + 64 + lane], s1); }
  float myv = 0.f; int myi = 0;
  for (int r = 0; r < 16; ++r) {
    const float mx = wave_max(fmaxf(s0, s1));
    const unsigned long long b0 = __ballot(s0 == mx), b1 = __ballot(s1 == mx);
    int idx;
    if (b0) idx = __ffsll((long long)b0) - 1; else idx = 64 + __ffsll((long long)b1) - 1;
    if (lane == r) { myv = mx; myi = idx; }
    if (idx == lane) s0 = -INFINITY;
    if (idx == 64 + lane) s1 = -INFINITY;
  }
  if (lane < 16) { ST[(size_t)w * 16 + lane] = myv; IT[(size_t)w * 16 + lane] = myi; }
}

__global__ __launch_bounds__(256) void k_peer_comb(const float* __restrict__ ST, const int* __restrict__ IT, float* __restrict__ G, int* __restrict__ E) {
  const int wv = threadIdx.x >> 6, lane = threadIdx.x & 63;
  const int w = blockIdx.x * 4 + wv;
  const float* s0 = ST + (size_t)w * 32; const float* s1 = s0 + 16;
  const int* i0 = IT + (size_t)w * 32; const int* i1 = i0 + 16;
  float c[4];
#pragma unroll
  for (int r = 0; r < 4; ++r) c[r] = s0[lane >> 2] + s1[(lane & 3) * 4 + r];
  float myv = 0.f; int mypos = 0;
  for (int k = 0; k < 16; ++k) {
    const float mx = wave_max(fmaxf(fmaxf(c[0], c[1]), fmaxf(c[2], c[3])));
    int best = 1 << 20;
#pragma unroll
    for (int r = 3; r >= 0; --r) if (c[r] == mx) best = lane * 4 + r;
#pragma unroll
    for (int o = 1; o < 64; o <<= 1) best = min(best, __shfl_xor(best, o));
    if (lane == k) { myv = mx; mypos = best; }
#pragma unroll
    for (int r = 0; r < 4; ++r) if (best == lane * 4 + r) c[r] = -INFINITY;
  }
  float v = lane < 16 ? myv : -INFINITY;
  const float mx = wave_max(v);
  const float e = lane < 16 ? expf(v - mx) : 0.f;
  const float sum = wave_sum(e);
  if (lane < 16) {
    G[(size_t)w * 16 + lane] = e / sum;
    E[(size_t)w * 16 + lane] = i0[mypos >> 4] * 128 + i1[mypos & 15];
  }
}

__global__ __launch_bounds__(256) void k_peer_gather(const float* __restrict__ H2, const float* __restrict__ X2, const float* __restrict__ G, const int* __restrict__ E,
                                                     const float* __restrict__ U, const float* __restrict__ Vt, float* __restrict__ out) {
  const int wv = threadIdx.x >> 6, lane = threadIdx.x & 63;
  const int t = blockIdx.x * 4 + wv;
  float4 h[8], acc[8];
#pragma unroll
  for (int i = 0; i < 8; ++i) { h[i] = *(const float4*)(H2 + (size_t)t * 2048 + i * 256 + lane * 4); acc[i] = make_float4(0.f, 0.f, 0.f, 0.f); }
  for (int k = 0; k < 128; ++k) {
    const int e = E[(size_t)t * 128 + k]; const float g = G[(size_t)t * 128 + k];
    const float* ur = U + (size_t)e * 2048; const float* vr = Vt + (size_t)e * 2048;
    float d = 0.f;
#pragma unroll
    for (int i = 0; i < 8; ++i) { const float4 u4 = *(const float4*)(ur + i * 256 + lane * 4); d += u4.x * h[i].x + u4.y * h[i].y + u4.z * h[i].z + u4.w * h[i].w; }
    d = wave_sum(d);
    const float a = 0.5f * d * (1.0f + erff(d * 0.70710678118654752f));
    const float wgt = g * a;
#pragma unroll
    for (int i = 0; i < 8; ++i) { const float4 v4 = *(const float4*)(vr + i * 256 + lane * 4); acc[i].x += wgt * v4.x; acc[i].y += wgt * v4.y; acc[i].z += wgt * v4.z; acc[i].w += wgt * v4.w; }
  }
#pragma unroll
  for (int i = 0; i < 8; ++i) {
    const float4 x = *(const float4*)(X2 + (size_t)t * 2048 + i * 256 + lane * 4);
    float4 o; o.x = x.x + acc[i].x; o.y = x.y + acc[i].y; o.z = x.z + acc[i].z; o.w = x.w + acc[i].w;
    *(float4*)(out + (size_t)t * 2048 + i * 256 + lane * 4) = o;
  }
}

extern "C" void kernel_launch(void* const* d_in, const int* in_sizes, int n_in, void* d_out, int out_size, void* d_ws, size_t ws_size, hipStream_t stream) {
  const float* x = (const float*)d_in[0];
  const float* g_attn = (const float*)d_in[1];
  const float* w_in = (const float*)d_in[2];
  const float* g_cq = (const float*)d_in[3];
  const float* g_ckv = (const float*)d_in[4];
  const float* w_uq = (const float*)d_in[5];
  const float* w_ukv = (const float*)d_in[6];
  const float* g_mla_q = (const float*)d_in[7];
  const float* g_mla_k = (const float*)d_in[8];
  const float* g_dsa_q = (const float*)d_in[9];
  const float* g_dsa_k = (const float*)d_in[10];
  const float* rel_bias = (const float*)d_in[11];
  const float* w_o = (const float*)d_in[12];
  const float* g_ffn = (const float*)d_in[13];
  const float* w_pq = (const float*)d_in[14];
  const float* sub_keys = (const float*)d_in[15];
  const float* u_tab = (const float*)d_in[16];
  const float* v_tab = (const float*)d_in[17];
  float* out = (float*)d_out;

  constexpr size_t MB = 1u << 20;
  char* ws = (char*)d_ws;
  float* PROJ = (float*)(ws);
  float* X2 = (float*)(ws);
  float* QR = (float*)(ws + 64 * MB);
  float* H = (float*)(ws + 160 * MB);
  float* QRAW = H;
  float* KVRAW = (float*)(ws + 224 * MB);
  float* QD = KVRAW;
  float* KDT = (float*)(ws + 256 * MB);
  float* QM = (float*)(ws + 288 * MB);
  float* KMT = (float*)(ws + 336 * MB);
  float* CQN = (float*)(ws + 288 * MB);
  float* CKVN = (float*)(ws + 304 * MB);
  float* Y = (float*)(ws + 384 * MB);
  float* KIT = (float*)(ws + 448 * MB);
  unsigned* MASK = (unsigned*)(ws + 450 * MB);
  float* SKT = (float*)(ws + 454 * MB);
  float* ST = (float*)(ws + 455 * MB);
  int* IT = (int*)(ws + 463 * MB);
  float* G = (float*)(ws + 471 * MB);
  int* E = (int*)(ws + 475 * MB);
  if ((size_t)479 * MB > ws_size) { fprintf(stderr, "kernel_launch: workspace too small: have %zu\n", ws_size); return; }

  k_rmsnorm<<<T_ / 4, 256, 0, stream>>>(x, 2048, 2048, g_attn, H, 2048, T_);
  k_gemm<<<dim3((INW + 63) / 64, T_ / 64), 256, 0, stream>>>(H, 2048, w_in, INW, PROJ, INW, T_, INW, 2048, nullptr, 0);
  k_rmsnorm<<<T_ / 4, 256, 0, stream>>>(PROJ + OFF_CQ, INW, 512, g_cq, CQN, 512, T_);
  k_rmsnorm<<<T_ / 4, 256, 0, stream>>>(PROJ + OFF_CKV, INW, 256, g_ckv, CKVN, 256, T_);
  k_gemm<<<dim3(1536 / 64, T_ / 64), 256, 0, stream>>>(CQN, 512, w_uq, 1536, QRAW, 1536, T_, 1536, 512, nullptr, 0);
  k_gemm<<<dim3(2048 / 64, T_ / 64), 256, 0, stream>>>(CKVN, 256, w_ukv, 2048, KVRAW, 2048, T_, 2048, 256, nullptr, 0);
  k_mla_prep<<<T_ * 8 / 4, 256, 0, stream>>>(QRAW, KVRAW, PROJ, g_mla_q, g_mla_k, QM, KMT);
  k_attn<192><<<16 * S_ / 4, 256, 0, stream>>>(QM, KMT, KVRAW, 2048, 128, 256, 0.07216878364870322f, nullptr, nullptr, Y, 0);
  k_dsa_prep<<<T_ * 8 / 4, 256, 0, stream>>>(PROJ, g_dsa_q, g_dsa_k, QD, KDT);
  k_kit<<<T_ * 64 / 256, 256, 0, stream>>>(PROJ, KIT);
  k_index<<<T_ / 2, 128, 0, stream>>>(PROJ, KIT, MASK);
  k_attn<128><<<16 * S_ / 4, 256, 0, stream>>>(QD, KDT, PROJ, INW, OFF_VD, 128, 0.08838834764831845f, MASK, rel_bias, Y, 1024);
  k_gemm<<<dim3(2048 / 64, T_ / 64), 256, 0, stream>>>(Y, 2048, w_o, 2048, X2, 2048, T_, 2048, 2048, x, 2048);
  k_rmsnorm<<<T_ / 4, 256, 0, stream>>>(X2, 2048, 2048, g_ffn, H, 2048, T_);
  k_gemm<<<dim3(2048 / 64, T_ / 64), 256, 0, stream>>>(H, 2048, w_pq, 2048, QR, 2048, T_, 2048, 2048, nullptr, 0);
  k_skt<<<16 * 128 * 128 / 256, 256, 0, stream>>>(sub_keys, SKT);
  k_peer_top<<<T_ * 16 / 4, 256, 0, stream>>>(QR, SKT, ST, IT);
  k_peer_comb<<<T_ * 8 / 4, 256, 0, stream>>>(ST, IT, G, E);
  k_peer_gather<<<T_ / 4, 256, 0, stream>>>(H, X2, G, E, u_tab, v_tab, out);
}
```

```cpp
#define MK_DEBUG 0
#include <hip/hip_runtime.h>
#include <cstdio>
#include <cstdint>

#define LAS __attribute__((address_space(3)))
#define GAS __attribute__((address_space(1)))
typedef _Float16 f16;
typedef _Float16 f16x8 __attribute__((ext_vector_type(8)));
typedef _Float16 f16x4 __attribute__((ext_vector_type(4)));
typedef _Float16 f16x2 __attribute__((ext_vector_type(2)));
typedef short bf16x8 __attribute__((ext_vector_type(8)));
typedef short s16x4 __attribute__((ext_vector_type(4)));
typedef unsigned short bf16_t;
typedef float f32x2 __attribute__((ext_vector_type(2)));
typedef float f32x4 __attribute__((ext_vector_type(4)));
typedef float f32x8 __attribute__((ext_vector_type(8)));
typedef float f32x16 __attribute__((ext_vector_type(16)));
typedef unsigned u32x2 __attribute__((ext_vector_type(2)));
typedef unsigned u32x4 __attribute__((ext_vector_type(4)));

constexpr int B_ = 2, S_ = 4096, D_ = 2048, T_ = B_ * S_;
constexpr int INW = 5008;
constexpr int OFF_CQ = 0, OFF_CKV = 512, OFF_KR = 768, OFF_QD = 832, OFF_KD = 1856, OFF_VD = 2880, OFF_QI = 3904, OFF_KI = 4928, OFF_WI = 4992;
constexpr float EPS = 1e-6f;
constexpr float LOG2E = 1.4426950408889634f;
constexpr float QS_MLA = 0.07216878364870322f * LOG2E;
constexpr float QS_DSA = 0.08838834764831845f * LOG2E;
constexpr int NCU = 256, NTHR = 512, NWAVES = 8;

constexpr size_t MiB = 1u << 20;
constexpr size_t WS_CTL = 0, CTL_ZERO_BYTES = 64 * 1024;
constexpr size_t WS_WT_IN = 1 * MiB, WS_WT_UQ = 21 * MiB, WS_WT_UKV = 23 * MiB, WS_WT_O = 24 * MiB, WS_WT_PQ = 32 * MiB, WS_SK16 = 40 * MiB, WS_CS = 41 * MiB;
constexpr size_t WS_XN = 42 * MiB, WS_CQ = 74 * MiB, WS_CKV = 82 * MiB, WS_SSQ_CQ = 86 * MiB, WS_SSQ_CKV = 86 * MiB + 256 * 1024, WS_SSQ_KR = 86 * MiB + 384 * 1024;
constexpr size_t WS_SSQ2 = 87 * MiB, WS_KR = 88 * MiB, WS_WI = 90 * MiB, WS_KI = 91 * MiB, WS_QI = 92 * MiB;
constexpr size_t WS_QD = 108 * MiB, WS_KD = 124 * MiB, WS_VD = 140 * MiB, WS_QM = 156 * MiB, WS_KM = 180 * MiB, WS_VM = 204 * MiB, WS_MASK = 220 * MiB;
constexpr size_t WS_Y = 224 * MiB, WS_QR = 256 * MiB, WS_U16 = 288 * MiB, WS_V16 = 352 * MiB, WS_END = 416 * MiB;
constexpr size_t WS_DBG = 288 * MiB;

constexpr int RING_OFF = 0, RING_BYTES = 131072;
constexpr int EPI_OFF = RING_BYTES;
constexpr int R2S_OFF = EPI_OFF + 8192;
constexpr int MISC_OFF = 163840 - 256;
constexpr int LDS_BYTES = 163840;

#define LDS_WAIT() asm volatile("s_waitcnt lgkmcnt(0)" ::: "memory")
#define VM_WAIT() asm volatile("s_waitcnt vmcnt(0)" ::: "memory")
#define WG_BAR() do { asm volatile("s_waitcnt lgkmcnt(0)" ::: "memory"); __builtin_amdgcn_s_barrier(); asm volatile("" ::: "memory"); } while (0)

__device__ __forceinline__ unsigned cvt_pk_bf16(float lo, float hi) { unsigned r; asm volatile("v_cvt_pk_bf16_f32 %0, %1, %2" : "=v"(r) : "v"(lo), "v"(hi)); return r; }
__device__ __forceinline__ u32x4 pack_bf16x8(const f32x4 a, const f32x4 b) { u32x4 w; w.x = cvt_pk_bf16(a[0], a[1]); w.y = cvt_pk_bf16(a[2], a[3]); w.z = cvt_pk_bf16(b[0], b[1]); w.w = cvt_pk_bf16(b[2], b[3]); return w; }
__device__ __forceinline__ f16x8 pack_f16x8(const f32x4 a, const f32x4 b) { f16x8 w; w[0] = (f16)a[0]; w[1] = (f16)a[1]; w[2] = (f16)a[2]; w[3] = (f16)a[3]; w[4] = (f16)b[0]; w[5] = (f16)b[1]; w[6] = (f16)b[2]; w[7] = (f16)b[3]; return w; }
__device__ __forceinline__ float wave_sum(float v) {
#pragma unroll
  for (int o = 1; o < 64; o <<= 1) v += __shfl_xor(v, o);
  return v;
}
__device__ __forceinline__ float wave_max(float v) {
#pragma unroll
  for (int o = 1; o < 64; o <<= 1) v = fmaxf(v, __shfl_xor(v, o));
  return v;
}
__device__ __forceinline__ int lane_id_v() { int l; asm volatile("v_mbcnt_lo_u32_b32 %0, -1, 0\n\tv_mbcnt_hi_u32_b32 %0, -1, %0" : "=v"(l)); return l; }
__device__ __forceinline__ float sum4(const f32x4 v) { return (v[0] + v[1]) + (v[2] + v[3]); }
__device__ __forceinline__ float ssq4(const f32x4 v) { return (v[0] * v[0] + v[1] * v[1]) + (v[2] * v[2] + v[3] * v[3]); }

__device__ __forceinline__ int t5_bucket(int rel) {
  const int n = rel < 0 ? -rel : rel;
  int bkt;
  if (n < 8) bkt = n; else if (n < 12) bkt = 8; else if (n < 16) bkt = 9; else if (n < 23) bkt = 10; else if (n < 32) bkt = 11;
  else if (n < 46) bkt = 12; else if (n < 64) bkt = 13; else if (n < 91) bkt = 14; else bkt = 15;
  return bkt + (rel > 0 ? 16 : 0);
}

namespace pg8 {
constexpr int BM = 256, BK = 64, HALF = 128, HTB = HALF * BK * 2, STAGE_BYTES = 8 * HTB, NXCD = 8, WGM = 8;
__host__ __device__ __forceinline__ int lds_byte(int r, int c) { const int st = (r >> 4) * 2 + (c >> 5), rr = r & 15, cc = c & 31, ob = rr * 64 + cc * 2; return st * 1024 + (ob ^ (((ob >> 9) & 1) << 5)); }
__host__ __device__ __forceinline__ void stage_rc(int b, int& R, int& C) { const int st = b / 1024, sb = b % 1024, swz = sb ^ (((sb >> 9) & 1) << 5); R = (st >> 1) * 16 + swz / 64; C = (st & 1) * 32 + (swz % 64) / 2; }
__host__ __device__ __forceinline__ int perm32(int rho) { const int n = rho >> 4, i = rho & 15; return 8 * (i >> 2) + 4 * n + (i & 3); }
struct Unit { int pm, pn; };
struct Gemm { const f16* A; const f16* Bt; int M, N, K; };
struct StaticOrder {
    int nM, nN, nwg, G, c;
    __host__ __device__ void init(int M, int N, int G_, int c_) { nM = M / BM; nN = N / BM; nwg = nM * nN; G = G_; c = c_; }
    __host__ __device__ bool next(int i, Unit& u) const {
        const long L = (long)i * G + c; if (L >= nwg || c < 0) return false;
        int wgid = (int)L; { const int q = nwg / NXCD, r = nwg % NXCD, xcd = wgid % NXCD, off = wgid / NXCD; wgid = (xcd < r ? xcd * (q + 1) : r * (q + 1) + (xcd - r) * q) + off; }
        const int nig = WGM * nN, gid = wgid / nig, fm = gid * WGM, gsz = (nM - fm) < WGM ? (nM - fm) : WGM;
        u.pm = fm + ((wgid % nig) % gsz); u.pn = (wgid % nig) / gsz; return true;
    }
    __device__ __forceinline__ void a_ready(const Unit&) const {}
    __device__ __forceinline__ void done(const Unit&) const {}
};

template <class Epi, class Sched, bool ALIGN_EPI = true, bool SP2 = true>
__device__ __forceinline__ void gemm_phase(LAS unsigned char* lds, const Gemm g, const Sched& S, const Epi& E, int wave_sgpr) {
    const int wid = wave_sgpr, lane = lane_id_v(), tid = wid * 64 + lane, wr = wid >> 2, wc = wid & 3, fr = lane & 15, fq = lane >> 4;
    const int K = g.K, nt = K / BK;
    unsigned voffA[2], voffB[2];
#pragma unroll
    for (int i = 0; i < 2; ++i) { int R, C; stage_rc(tid * 16 + i * 8192, R, C); const int Rb = Epi::PERM ? ((R & ~31) + perm32(R & 31)) : R;
        voffA[i] = (unsigned)(R * K + C) * 2u; voffB[i] = (unsigned)(Rb * K + C) * 2u; }
    const size_t kstep = (size_t)(BK * 2);
    const size_t hstep = (size_t)HALF * K * 2;
    const size_t tstep = 2 * hstep;
    const unsigned ldsw = (unsigned)wid * 1024u;
    const int aoff = lds_byte(wr * 64 + fr, fq * 8), boff = lds_byte(wc * 32 + fr, fq * 8);
#define PG8_SA(b, h) (((b) * 2 + (h)) * HTB)
#define PG8_SB(b, h) ((4 + (b) * 2 + (h)) * HTB)
#define PG8_STAGE(bufoff, gbase, voff) do { _Pragma("unroll") for (int _i = 0; _i < 2; ++_i) \
        __builtin_amdgcn_global_load_lds((const unsigned*)((const char*)(gbase) + (voff)[_i]), (LAS unsigned*)(lds + (bufoff) + ldsw + _i * 8192), 16, 0, 0); } while (0)
#define PG8_LDA(dst, b, h) do { _Pragma("unroll") for (int m = 0; m < 4; ++m) _Pragma("unroll") for (int k = 0; k < 2; ++k) dst[m][k] = *(const LAS f16x8*)(lds + PG8_SA(b, h) + aoff + m * 2048 + k * 1024); } while (0)
#define PG8_LDB(dst, b, h) do { _Pragma("unroll") for (int n = 0; n < 2; ++n) _Pragma("unroll") for (int k = 0; k < 2; ++k) dst[n][k] = *(const LAS f16x8*)(lds + PG8_SB(b, h) + boff + n * 2048 + k * 1024); } while (0)
#define PG8_MMA(ai, bj, At, Bt) do { __builtin_amdgcn_s_setprio(1); _Pragma("unroll") for (int m = 0; m < 4; ++m) _Pragma("unroll") for (int n = 0; n < 2; ++n) _Pragma("unroll") for (int k = 0; k < 2; ++k) \
        acc[ai][bj][m][n] = __builtin_amdgcn_mfma_f32_16x16x32_f16(Bt[n][k], At[m][k], acc[ai][bj][m][n], 0, 0, 0); __builtin_amdgcn_s_setprio(0); } while (0)
#define PG8_WAIT_V(n) asm volatile("s_waitcnt vmcnt(" #n ")" ::: "memory")
#define PG8_WAIT_L(n) asm volatile("s_waitcnt lgkmcnt(" #n ")" ::: "memory")
#define PG8_BAR __builtin_amdgcn_s_barrier()
#define PG8_SCHED __builtin_amdgcn_sched_barrier(0)
    Unit cur, nxt; int ui = 0;
    if (!S.next(0, cur)) return;
    f32x4 acc[2][2][4][2];
#pragma unroll
    for (int a = 0; a < 2; ++a)
#pragma unroll
        for (int b = 0; b < 2; ++b)
#pragma unroll
            for (int m = 0; m < 4; ++m)
#pragma unroll
                for (int n = 0; n < 2; ++n) acc[a][b][m][n] = (f32x4){0.f, 0.f, 0.f, 0.f};
    f16x8 At[4][2], B0[2][2], B1[2][2];
    const char* cA = (const char*)g.A + (size_t)cur.pm * tstep; const char* cB = (const char*)g.Bt + (size_t)cur.pn * tstep;
    S.a_ready(cur);
    if constexpr (SP2) {
        PG8_STAGE(PG8_SB(0, 0), cB, voffB); PG8_STAGE(PG8_SB(0, 1), cB + hstep, voffB); PG8_STAGE(PG8_SA(0, 0), cA, voffA); PG8_STAGE(PG8_SA(0, 1), cA + hstep, voffA);
        if (wr == 1) PG8_BAR;
        PG8_WAIT_V(2); PG8_BAR;
        PG8_STAGE(PG8_SB(1, 0), cB + kstep, voffB); PG8_STAGE(PG8_SA(1, 0), cA + kstep, voffA); PG8_STAGE(PG8_SB(1, 1), cB + hstep + kstep, voffB);
        PG8_WAIT_V(6); PG8_BAR;
    } else {
        PG8_STAGE(PG8_SB(0, 0), cB, voffB); PG8_STAGE(PG8_SA(0, 0), cA, voffA); PG8_STAGE(PG8_SB(0, 1), cB + hstep, voffB); PG8_STAGE(PG8_SA(0, 1), cA + hstep, voffA);
        if (wr == 1) PG8_BAR;
        PG8_WAIT_V(4); PG8_BAR;
        PG8_STAGE(PG8_SB(1, 0), cB + kstep, voffB); PG8_STAGE(PG8_SA(1, 0), cA + kstep, voffA); PG8_STAGE(PG8_SB(1, 1), cB + hstep + kstep, voffB);
        PG8_WAIT_V(6); PG8_BAR;
    }
    for (;;) {
        const bool has_next = S.next(ui + 1, nxt);
        const char* nA = has_next ? (const char*)g.A + (size_t)nxt.pm * tstep : cA; const char* nB = has_next ? (const char*)g.Bt + (size_t)nxt.pn * tstep : cB;
#pragma unroll 1
        for (int t = 0; t < nt; t += 2) {
            const bool last = (t == nt - 2);
            const char* a1 = cA + (size_t)(t + 1) * kstep;
            const char* a2 = last ? nA : cA + (size_t)(t + 2) * kstep; const char* b2 = last ? nB : cB + (size_t)(t + 2) * kstep;
            const char* a3 = a2 + kstep; const char* b3 = b2 + kstep;
            if (last && has_next) S.a_ready(nxt);
            if constexpr (SP2) {
            PG8_LDB(B0, 0, 0); PG8_LDB(B1, 0, 1); PG8_SCHED; PG8_LDA(At, 0, 0); PG8_STAGE(PG8_SA(1, 1), a1 + hstep, voffA);
            PG8_WAIT_V(8); PG8_WAIT_L(0); PG8_BAR; PG8_MMA(0, 0, At, B0); PG8_MMA(0, 1, At, B1); PG8_BAR; PG8_SCHED;
            PG8_LDA(At, 0, 1); PG8_STAGE(PG8_SB(0, 0), b2, voffB); PG8_STAGE(PG8_SB(0, 1), b2 + hstep, voffB); PG8_STAGE(PG8_SA(0, 0), a2, voffA);
            PG8_WAIT_V(8); PG8_WAIT_L(0); PG8_BAR; PG8_MMA(1, 0, At, B0); PG8_MMA(1, 1, At, B1); PG8_BAR; PG8_SCHED;
            PG8_LDB(B0, 1, 0); PG8_LDB(B1, 1, 1); PG8_SCHED; PG8_LDA(At, 1, 0); PG8_STAGE(PG8_SA(0, 1), a2 + hstep, voffA);
            PG8_WAIT_V(8); PG8_WAIT_L(0); PG8_BAR; PG8_MMA(0, 0, At, B0); PG8_MMA(0, 1, At, B1); PG8_BAR; PG8_SCHED;
            PG8_LDA(At, 1, 1); PG8_STAGE(PG8_SB(1, 0), b3, voffB); PG8_STAGE(PG8_SB(1, 1), b3 + hstep, voffB); PG8_STAGE(PG8_SA(1, 0), a3, voffA);
            PG8_WAIT_V(8); PG8_WAIT_L(0); PG8_BAR; PG8_MMA(1, 0, At, B0); PG8_MMA(1, 1, At, B1); PG8_BAR; PG8_SCHED;
            } else {
            PG8_LDB(B0, 0, 0); PG8_SCHED; PG8_LDA(At, 0, 0); PG8_STAGE(PG8_SA(1, 1), a1 + hstep, voffA);
            PG8_WAIT_L(8); PG8_BAR; PG8_WAIT_L(0); PG8_MMA(0, 0, At, B0); PG8_BAR; PG8_SCHED;
            PG8_LDB(B1, 0, 1); PG8_STAGE(PG8_SB(0, 0), b2, voffB);
            PG8_BAR; PG8_WAIT_L(0); PG8_MMA(0, 1, At, B1); PG8_BAR;
            PG8_LDA(At, 0, 1); PG8_STAGE(PG8_SA(0, 0), a2, voffA);
            PG8_BAR; PG8_WAIT_L(0); PG8_MMA(1, 0, At, B0); PG8_BAR; PG8_SCHED;
            PG8_STAGE(PG8_SB(0, 1), b2 + hstep, voffB);
            PG8_WAIT_V(6); PG8_BAR; PG8_MMA(1, 1, At, B1); PG8_BAR;
            PG8_LDB(B0, 1, 0); PG8_SCHED; PG8_LDA(At, 1, 0); PG8_STAGE(PG8_SA(0, 1), a2 + hstep, voffA);
            PG8_WAIT_L(8); PG8_BAR; PG8_WAIT_L(0); PG8_MMA(0, 0, At, B0); PG8_BAR; PG8_SCHED;
            PG8_LDB(B1, 1, 1); PG8_STAGE(PG8_SB(1, 0), b3, voffB);
            PG8_BAR; PG8_WAIT_L(0); PG8_MMA(0, 1, At, B1); PG8_BAR;
            PG8_LDA(At, 1, 1); PG8_STAGE(PG8_SA(1, 0), a3, voffA);
            PG8_BAR; PG8_WAIT_L(0); PG8_MMA(1, 0, At, B0); PG8_BAR; PG8_SCHED;
            PG8_STAGE(PG8_SB(1, 1), b3 + hstep, voffB);
            PG8_WAIT_V(6); PG8_BAR; PG8_MMA(1, 1, At, B1); PG8_BAR;
            }
        }
        if constexpr (ALIGN_EPI) { if (wr == 0) PG8_BAR; }
        E(acc, cur, wr, wc, fr, fq);
        if (!has_next) break;
#pragma unroll
        for (int a = 0; a < 2; ++a)
#pragma unroll
            for (int b = 0; b < 2; ++b)
#pragma unroll
                for (int m = 0; m < 4; ++m)
#pragma unroll
                    for (int n = 0; n < 2; ++n) acc[a][b][m][n] = (f32x4){0.f, 0.f, 0.f, 0.f};
        cur = nxt; cA = nA; cB = nB; ++ui;
        if constexpr (ALIGN_EPI) { if (wr == 1) PG8_BAR; }
    }
    PG8_WAIT_V(0);
    if constexpr (!ALIGN_EPI) { if (wr == 0) PG8_BAR; }
    PG8_BAR;
#undef PG8_SA
#undef PG8_SB
#undef PG8_STAGE
#undef PG8_LDA
#undef PG8_LDB
#undef PG8_MMA
#undef PG8_WAIT_V
#undef PG8_WAIT_L
#undef PG8_BAR
#undef PG8_SCHED
}
}

typedef f32x4 AccT[2][2][4][2];
#define FOR_AI_M _Pragma("unroll") for (int ai = 0; ai < 2; ++ai) _Pragma("unroll") for (int m = 0; m < 4; ++m)

__device__ __forceinline__ float fq_sum(float s) { s += __shfl_xor(s, 16); s += __shfl_xor(s, 32); return s; }

struct EpiIn {
    static constexpr bool PERM = true;
    f16* CQ; f16* CKV; float* SSQ_CQ; float* SSQ_CKV; bf16_t* Qd; bf16_t* Kd; f16* QI; f16* KI; float* WI; float* KR; float* SSQ_KR;
    const float* g_dq; const float* g_dk; const float* g_mk; const float* CS;
    LAS float* P;
    __device__ __forceinline__ void operator()(const AccT& acc, const pg8::Unit& u_, int wr, int wc, int fr, int fq) const {
        pg8::Unit u = u_; asm volatile("" : "+s"(u.pm), "+s"(u.pn), "+v"(fr), "+v"(fq));
        const int pn = u.pn, row0 = u.pm * 256 + wr * 64 + fr, cl = wc * 32 + fq * 8;
        if (pn < 3) {
            FOR_AI_M { const int row = row0 + ai * 128 + m * 16; float ss = 0.f;
#pragma unroll
                for (int bj = 0; bj < 2; ++bj) { const f32x4 a = acc[ai][bj][m][0], b = acc[ai][bj][m][1]; ss += ssq4(a) + ssq4(b);
                    if (pn < 2) *(f16x8*)(CQ + (size_t)row * 512 + pn * 256 + bj * 128 + cl) = pack_f16x8(a, b);
                    else *(f16x8*)(CKV + (size_t)row * 256 + bj * 128 + cl) = pack_f16x8(a, b); }
                ss = fq_sum(ss);
                if (fq == 0) { if (pn < 2) SSQ_CQ[(size_t)row * 8 + pn * 4 + wc] = ss; else SSQ_CKV[(size_t)row * 4 + wc] = ss; } }
        } else if (pn < 11) {
            FOR_AI_M { const int rl = ai * 128 + wr * 64 + m * 16 + fr;
#pragma unroll
                for (int bj = 0; bj < 2; ++bj) { float ss = fq_sum(ssq4(acc[ai][bj][m][0]) + ssq4(acc[ai][bj][m][1])); if (fq == 0) P[(bj * 256 + rl) * 4 + wc] = ss; } }
            WG_BAR();
            const bool isq = pn < 7; const float* g = isq ? g_dq : g_dk; const float qs = isq ? QS_DSA : 1.0f;
            const f32x4 g0 = *(const f32x4*)(g + cl) * qs, g1 = *(const f32x4*)(g + cl + 4) * qs;
            bf16_t* O = isq ? Qd : Kd; const int hb = (isq ? pn - 3 : pn - 7) * 2;
            FOR_AI_M { const int rl = ai * 128 + wr * 64 + m * 16 + fr, row = u.pm * 256 + rl, b = row >> 12, s = row & 4095;
#pragma unroll
                for (int bj = 0; bj < 2; ++bj) { const f32x4 p4 = *(const LAS f32x4*)(P + (bj * 256 + rl) * 4); const float r = 1.0f / sqrtf(sum4(p4) * (1.0f / 128.0f) + EPS);
                    *(u32x4*)(O + ((size_t)(b * 8 + hb + bj) * S_ + s) * 128 + cl) = pack_bf16x8(acc[ai][bj][m][0] * r * g0, acc[ai][bj][m][1] * r * g1); } }
        } else if (pn < 15) {
            FOR_AI_M { const int row = row0 + ai * 128 + m * 16;
#pragma unroll
                for (int bj = 0; bj < 2; ++bj) *(f16x8*)(QI + (size_t)row * 1024 + (pn - 11) * 256 + bj * 128 + cl) = pack_f16x8(acc[ai][bj][m][0] * 0.125f, acc[ai][bj][m][1] * 0.125f); }
        } else {
            FOR_AI_M { const int row = row0 + ai * 128 + m * 16, s = row & 4095;
                if (wc < 2) {
                    const f32x4 a = acc[ai][0][m][0], b = acc[ai][0][m][1];
                    const float ss = fq_sum(ssq4(a) + ssq4(b)); if (fq == 0) SSQ_KR[(size_t)row * 2 + wc] = ss;
                    const int i0 = cl >> 1;
                    const f32x4 ga = *(const f32x4*)(g_mk + 128 + i0), gb = *(const f32x4*)(g_mk + 160 + i0);
                    const f32x4 c0 = *(const f32x4*)(CS + (size_t)s * 64 + 2 * i0), c1 = *(const f32x4*)(CS + (size_t)s * 64 + 2 * i0 + 4);
                    f32x4 o0, o1;
                    { const float x1 = a[0] * ga[0], x2 = a[1] * gb[0]; o0[0] = x1 * c0[0] - x2 * c0[1]; o0[1] = x1 * c0[1] + x2 * c0[0]; }
                    { const float x1 = a[2] * ga[1], x2 = a[3] * gb[1]; o0[2] = x1 * c0[2] - x2 * c0[3]; o0[3] = x1 * c0[3] + x2 * c0[2]; }
                    { const float x1 = b[0] * ga[2], x2 = b[1] * gb[2]; o1[0] = x1 * c1[0] - x2 * c1[1]; o1[1] = x1 * c1[1] + x2 * c1[0]; }
                    { const float x1 = b[2] * ga[3], x2 = b[3] * gb[3]; o1[2] = x1 * c1[2] - x2 * c1[3]; o1[3] = x1 * c1[3] + x2 * c1[2]; }
                    *(f32x4*)(KR + (size_t)row * 64 + cl) = o0; *(f32x4*)(KR + (size_t)row * 64 + cl + 4) = o1;
                } else {
                    *(f16x8*)(KI + (size_t)row * 64 + (cl - 64)) = pack_f16x8(acc[ai][0][m][0], acc[ai][0][m][1]);
                }
                if (wc == 0 && fq < 2) {
                    *(f32x4*)(WI + (size_t)row * 16 + cl) = acc[ai][1][m][0]; *(f32x4*)(WI + (size_t)row * 16 + cl + 4) = acc[ai][1][m][1];
                } }
        }
    }
};

struct EpiVd {
    static constexpr bool PERM = true;
    bf16_t* Vd;
    __device__ __forceinline__ void operator()(const AccT& acc, const pg8::Unit& u_, int wr, int wc, int fr, int fq) const {
        pg8::Unit u = u_; asm volatile("" : "+s"(u.pm), "+s"(u.pn), "+v"(fr), "+v"(fq));
        const int row0 = u.pm * 256 + wr * 64 + fr, cl = wc * 32 + fq * 8;
        FOR_AI_M { const int row = row0 + ai * 128 + m * 16, b = row >> 12, s = row & 4095;
#pragma unroll
            for (int bj = 0; bj < 2; ++bj) *(u32x4*)(Vd + ((size_t)(b * 8 + u.pn * 2 + bj) * S_ + s) * 128 + cl) = pack_bf16x8(acc[ai][bj][m][0], acc[ai][bj][m][1]); }
    }
};

struct EpiQup {
    static constexpr bool PERM = true;
    bf16_t* Qm; const float* SSQ_CQ; const float* g_mq; const float* CS; LAS float* P;
    __device__ __forceinline__ void operator()(AccT& acc, const pg8::Unit& u_, int wr, int wc, int fr, int fq) const {
        pg8::Unit u = u_; asm volatile("" : "+s"(u.pm), "+s"(u.pn), "+v"(fr), "+v"(fq));
        const int cl = wc * 32 + fq * 8, h = u.pn;
        FOR_AI_M { const int rl = ai * 128 + wr * 64 + m * 16 + fr, row = u.pm * 256 + rl;
            const f32x4 s0 = *(const f32x4*)(SSQ_CQ + (size_t)row * 8), s1 = *(const f32x4*)(SSQ_CQ + (size_t)row * 8 + 4);
            const float rq = 1.0f / sqrtf((sum4(s0) + sum4(s1)) * (1.0f / 512.0f) + EPS);
#pragma unroll
            for (int bj = 0; bj < 2; ++bj) { acc[ai][bj][m][0] *= rq; acc[ai][bj][m][1] *= rq;
                const float ss = fq_sum(ssq4(acc[ai][bj][m][0]) + ssq4(acc[ai][bj][m][1])); if (fq == 0) P[(bj * 256 + rl) * 4 + wc] = ss; } asm volatile("" ::: "memory"); }
        WG_BAR();
        const f32x4 g0 = *(const f32x4*)(g_mq + cl) * QS_MLA, g1 = *(const f32x4*)(g_mq + cl + 4) * QS_MLA;
        const int i0 = cl >> 1;
        f32x4 ga = {0.f, 0.f, 0.f, 0.f}, gb = {0.f, 0.f, 0.f, 0.f};
        if (wc < 2) { ga = *(const f32x4*)(g_mq + 128 + i0) * QS_MLA; gb = *(const f32x4*)(g_mq + 160 + i0) * QS_MLA; }
        FOR_AI_M { const int rl = ai * 128 + wr * 64 + m * 16 + fr, row = u.pm * 256 + rl, b = row >> 12, s = row & 4095;
            const f32x4 p0 = *(const LAS f32x4*)(P + rl * 4), p1 = *(const LAS f32x4*)(P + (256 + rl) * 4);
            const float r = 1.0f / sqrtf((sum4(p0) + sum4(p1)) * (1.0f / 192.0f) + EPS);
            bf16_t* o = Qm + ((size_t)(b * 8 + h) * S_ + s) * 192;
            *(u32x4*)(o + cl) = pack_bf16x8(acc[ai][0][m][0] * r * g0, acc[ai][0][m][1] * r * g1);
            if (wc < 2) {
                const f32x4 a = acc[ai][1][m][0] * r, bq = acc[ai][1][m][1] * r;
                const f32x4 c0 = *(const f32x4*)(CS + (size_t)s * 64 + 2 * i0), c1 = *(const f32x4*)(CS + (size_t)s * 64 + 2 * i0 + 4);
                f32x4 o0, o1;
                { const float x1 = a[0] * ga[0], x2 = a[1] * gb[0]; o0[0] = x1 * c0[0] - x2 * c0[1]; o0[1] = x1 * c0[1] + x2 * c0[0]; }
                { const float x1 = a[2] * ga[1], x2 = a[3] * gb[1]; o0[2] = x1 * c0[2] - x2 * c0[3]; o0[3] = x1 * c0[3] + x2 * c0[2]; }
                { const float x1 = bq[0] * ga[2], x2 = bq[1] * gb[2]; o1[0] = x1 * c1[0] - x2 * c1[1]; o1[1] = x1 * c1[1] + x2 * c1[0]; }
                { const float x1 = bq[2] * ga[3], x2 = bq[3] * gb[3]; o1[2] = x1 * c1[2] - x2 * c1[3]; o1[3] = x1 * c1[3] + x2 * c1[2]; }
                *(u32x4*)(o + 128 + cl) = pack_bf16x8(o0, o1);
            } asm volatile("" ::: "memory"); }
    }
};

struct EpiKVup {
    static constexpr bool PERM = true;
    bf16_t* Km; bf16_t* Vm; const float* SSQ_CKV; const float* SSQ_KR; const float* KR; const float* g_mk; LAS float* P;
    __device__ __forceinline__ void operator()(AccT& acc, const pg8::Unit& u_, int wr, int wc, int fr, int fq) const {
        pg8::Unit u = u_; asm volatile("" : "+s"(u.pm), "+s"(u.pn), "+v"(fr), "+v"(fq));
        const int cl = wc * 32 + fq * 8, h = u.pn;
        FOR_AI_M { const int rl = ai * 128 + wr * 64 + m * 16 + fr, row = u.pm * 256 + rl, b = row >> 12, s = row & 4095;
            const f32x4 s0 = *(const f32x4*)(SSQ_CKV + (size_t)row * 4);
            const float rkv = 1.0f / sqrtf(sum4(s0) * (1.0f / 256.0f) + EPS);
            acc[ai][0][m][0] *= rkv; acc[ai][0][m][1] *= rkv;
            const float ss = fq_sum(ssq4(acc[ai][0][m][0]) + ssq4(acc[ai][0][m][1])); if (fq == 0) P[rl * 4 + wc] = ss;
            *(u32x4*)(Vm + ((size_t)(b * 8 + h) * S_ + s) * 128 + cl) = pack_bf16x8(acc[ai][1][m][0] * rkv, acc[ai][1][m][1] * rkv); asm volatile("" ::: "memory"); }
        WG_BAR();
        const f32x4 g0 = *(const f32x4*)(g_mk + cl), g1 = *(const f32x4*)(g_mk + cl + 4);
        const int rc = wc * 16 + fq * 4;
        FOR_AI_M { const int rl = ai * 128 + wr * 64 + m * 16 + fr, row = u.pm * 256 + rl, b = row >> 12, s = row & 4095;
            const f32x4 p0 = *(const LAS f32x4*)(P + rl * 4);
            const float tot = sum4(p0) + SSQ_KR[(size_t)row * 2] + SSQ_KR[(size_t)row * 2 + 1];
            const float r = 1.0f / sqrtf(tot * (1.0f / 192.0f) + EPS);
            bf16_t* o = Km + ((size_t)(b * 8 + h) * S_ + s) * 192;
            *(u32x4*)(o + cl) = pack_bf16x8(acc[ai][0][m][0] * r * g0, acc[ai][0][m][1] * r * g1);
            const f32x4 kr = *(const f32x4*)(KR + (size_t)row * 64 + rc) * r;
            u32x2 w; w.x = cvt_pk_bf16(kr[0], kr[1]); w.y = cvt_pk_bf16(kr[2], kr[3]);
            *(u32x2*)(o + 128 + rc) = w; asm volatile("" ::: "memory"); }
    }
};

struct EpiOut {
    static constexpr bool PERM = true;
    const float* x; float* X2; f16* X2H; float* SSQ2;
    __device__ __forceinline__ void operator()(const AccT& acc, const pg8::Unit& u_, int wr, int wc, int fr, int fq) const {
        pg8::Unit u = u_; asm volatile("" : "+s"(u.pm), "+s"(u.pn), "+v"(fr), "+v"(fq));
        const int row0 = u.pm * 256 + wr * 64 + fr, cl = wc * 32 + fq * 8;
        FOR_AI_M { const int row = row0 + ai * 128 + m * 16; float ss = 0.f;
#pragma unroll
            for (int bj = 0; bj < 2; ++bj) { const size_t off = (size_t)row * 2048 + u.pn * 256 + bj * 128 + cl;
                const f32x4 a = acc[ai][bj][m][0] + *(const f32x4*)(x + off), b = acc[ai][bj][m][1] + *(const f32x4*)(x + off + 4);
                *(f32x4*)(X2 + off) = a; *(f32x4*)(X2 + off + 4) = b; *(f16x8*)(X2H + off) = pack_f16x8(a, b); ss += ssq4(a) + ssq4(b); }
            ss = fq_sum(ss); if (fq == 0) SSQ2[(size_t)row * 32 + u.pn * 4 + wc] = ss; }
    }
};

struct EpiQr {
    static constexpr bool PERM = true;
    f16* QR; const LAS float* R2s;
    __device__ __forceinline__ void operator()(const AccT& acc, const pg8::Unit& u_, int wr, int wc, int fr, int fq) const {
        pg8::Unit u = u_; asm volatile("" : "+s"(u.pm), "+s"(u.pn), "+v"(fr), "+v"(fq));
        const int cl = wc * 32 + fq * 8;
        FOR_AI_M { const int rl = ai * 128 + wr * 64 + m * 16 + fr, row = u.pm * 256 + rl; const float r = R2s[rl];
#pragma unroll
            for (int bj = 0; bj < 2; ++bj) *(f16x8*)(QR + (size_t)row * 2048 + u.pn * 256 + bj * 128 + cl) = pack_f16x8(acc[ai][bj][m][0] * r, acc[ai][bj][m][1] * r); }
    }
};

#define XB_TMO      128
#define XB_XCNT(j)  (256  + 64 * (j))
#define XB_XSUB(j)  (1280 + 64 * (j))
#define XB_XGEN(j)  (2304 + 64 * (j))
#define XB_TOP      3328
#define XB_TOPGEN   3392
#define XCD_BAR_WORDS 3456
#define XB_SPIN_CAP (1u << 22)
__device__ __forceinline__ unsigned xb_ld(unsigned* p)              { return __hip_atomic_load(p, __ATOMIC_RELAXED, __HIP_MEMORY_SCOPE_AGENT); }
__device__ __forceinline__ unsigned xb_add(unsigned* p, unsigned v) { return __hip_atomic_fetch_add(p, v, __ATOMIC_RELAXED, __HIP_MEMORY_SCOPE_AGENT); }
__device__ __forceinline__ unsigned xb_xcc_id() { return (unsigned)__builtin_amdgcn_s_getreg((3 << 11) | 20) & 0xFu; }
#define XB_SPIN(cond, bar) do { unsigned _sp = 0; while (cond) { __builtin_amdgcn_s_sleep(1); \
    if ((++_sp & 255u) == 0u) { if (xb_ld(&(bar)[XB_TMO])) break; if (_sp > XB_SPIN_CAP) { atomicAdd(&(bar)[XB_TMO], 1u); break; } } } } while (0)
struct XcdBarrier { unsigned* bar; unsigned x; volatile LAS unsigned* st; int wave; };
__device__ __forceinline__ XcdBarrier xcd_barrier_post(unsigned* bar, volatile LAS unsigned* st, int wave) {
    XcdBarrier b; b.bar = bar; b.x = xb_xcc_id(); b.st = st; b.wave = wave;
    if (wave == 0 && lane_id_v() == 0) (void)xb_add(&bar[XB_XCNT(b.x)], 1u);
    return b;
}
__device__ __forceinline__ void xcd_barrier_complete(unsigned* bar, unsigned x, unsigned& nloc, unsigned& nx) {
    const unsigned G = gridDim.x * gridDim.y * gridDim.z;
    unsigned sum, cnt, mine, sp = 0u;
    for (;;) {
        sum = 0u; cnt = 0u; mine = 0u;
#pragma unroll
        for (unsigned j = 0; j < 16; ++j) { const unsigned c = xb_ld(&bar[XB_XCNT(j)]); sum += c; cnt += (c > 0u) ? 1u : 0u; mine = (j == x) ? c : mine; }
        if (sum == G) break;
        __builtin_amdgcn_s_sleep(1);
        if ((++sp & 255u) == 0u) { if (xb_ld(&bar[XB_TMO])) break; if (sp > XB_SPIN_CAP) { atomicAdd(&bar[XB_TMO], 1u); break; } }
    }
    nloc = mine > 0u ? mine : 1u; nx = cnt > 0u ? cnt : 1u;
}
__device__ __forceinline__ void xcd_barrier(const XcdBarrier& b) {
    asm volatile("s_waitcnt vmcnt(0)" ::: "memory");
    __syncthreads();
    if (b.wave == 0 && lane_id_v() == 0) {
        unsigned* bar = b.bar;
        __builtin_amdgcn_s_waitcnt(0);
        unsigned nloc = b.st[0], nx = b.st[1];
        if (nloc == 0u) { xcd_barrier_complete(bar, b.x, nloc, nx); b.st[0] = nloc; b.st[1] = nx; }
        const unsigned old = xb_add(&bar[XB_XSUB(b.x)], 1u);
        const unsigned gen = old / nloc;
        if (old + 1u == (gen + 1u) * nloc) {
            __builtin_amdgcn_fence(__ATOMIC_RELEASE, "agent");
            asm volatile("s_waitcnt vmcnt(0)" ::: "memory");
            const unsigned og = xb_add(&bar[XB_TOP], 1u);
            const unsigned tg = og / nx;
            if (og + 1u == (tg + 1u) * nx) xb_add(&bar[XB_TOPGEN], 1u);
            else XB_SPIN(xb_ld(&bar[XB_TOPGEN]) == tg, bar);
            __builtin_amdgcn_fence(__ATOMIC_ACQUIRE, "agent");
            xb_add(&bar[XB_XGEN(b.x)], 1u);
            asm volatile("s_waitcnt vmcnt(0)" ::: "memory");
        } else {
            XB_SPIN(xb_ld(&bar[XB_XGEN(b.x)]) == gen, bar);
            __builtin_amdgcn_fence(__ATOMIC_ACQUIRE, "agent");
            asm volatile("s_waitcnt vmcnt(0)" ::: "memory");
        }
    }
    __syncthreads();
}

struct Args { const float* in[18]; float* out; unsigned char* ws; int ph_lo, ph_hi; };
enum { I_X = 0, I_GATTN, I_WIN, I_GCQ, I_GCKV, I_WUQ, I_WUKV, I_GMQ, I_GMK, I_GDQ, I_GDK, I_RELB, I_WO, I_GFFN, I_WPQ, I_SUBK, I_UTAB, I_VTAB };

__device__ __forceinline__ int map_in(int n) {
    if (n < 768) return n;
    if (n < 2816) return n + 64;
    if (n < 3840) return n + 1088;
    if (n < 3904) { const int j = n - 3840; return 768 + (j >> 1) + 32 * (j & 1); }
    if (n < 3984) return n + 1024;
    if (n < 4096) return -1;
    return n - 1216;
}
__device__ __forceinline__ int map_uq(int n) {
    const int h = n >> 8, j = n & 255;
    if (j < 128) return h * 192 + j;
    if (j < 192) { const int i = (j - 128) >> 1, par = (j - 128) & 1; return h * 192 + 128 + i + 32 * par; }
    return -1;
}
template <int MAP>
__device__ __forceinline__ void p0_transpose_item(const float* __restrict__ W, int K, int Nsrc, int Nout, f16* __restrict__ WT, const float* __restrict__ g, LAS float* scr, int item, int lane) {
    const int nblk = Nout / 32, kb = item / nblk, nb = item % nblk, k0 = 64 * kb, n0 = 32 * nb;
    const int n = n0 + (lane & 31);
    const int src = MAP == 1 ? map_in(n) : (MAP == 2 ? map_uq(n) : n);
#pragma unroll 8
    for (int i = 0; i < 32; ++i) { const int kk = 2 * i + (lane >> 5); float v = 0.f; if (src >= 0) v = W[(size_t)(k0 + kk) * Nsrc + src]; if (g) v *= g[k0 + kk]; scr[kk * 33 + (lane & 31)] = v; }
    LDS_WAIT(); asm volatile("" ::: "memory");
    const int c = lane & 7;
#pragma unroll
    for (int j = 0; j < 4; ++j) { const int nn = (lane >> 3) + 8 * j; const LAS float* s = scr + (8 * c) * 33 + nn;
        f16x8 o; o[0] = (f16)s[0 * 33]; o[1] = (f16)s[1 * 33]; o[2] = (f16)s[2 * 33]; o[3] = (f16)s[3 * 33]; o[4] = (f16)s[4 * 33]; o[5] = (f16)s[5 * 33]; o[6] = (f16)s[6 * 33]; o[7] = (f16)s[7 * 33];
        *(f16x8*)(WT + (size_t)(n0 + nn) * K + k0 + 8 * c) = o; }
    LDS_WAIT(); asm volatile("" ::: "memory");
}
__device__ __forceinline__ void p0_cvt_f16(const float* __restrict__ src, f16* __restrict__ dst, size_t n8, const float* __restrict__ g, int ncols, size_t gtid, size_t gn) {
    for (size_t i = gtid; i < n8; i += gn) {
        f32x4 a = *(const f32x4*)(src + i * 8), b = *(const f32x4*)(src + i * 8 + 4);
        if (g) { const int c = (int)((i * 8) & (size_t)(ncols - 1)); a = a * *(const f32x4*)(g + c); b = b * *(const f32x4*)(g + c + 4); }
        *(f16x8*)(dst + i * 8) = pack_f16x8(a, b);
    }
}
struct P0Args { const float* const* in; unsigned char* ws; };
__device__ __forceinline__ void p0_prologue(const Args& A, LAS unsigned char* lds, int wave, int lane, bool tables) {
    LAS float* scr = (LAS float*)(lds + RING_OFF + wave * 16384);
    const int G = gridDim.x, gw = blockIdx.x * NWAVES + wave, NGW = G * NWAVES;
    unsigned char* ws = A.ws;
    constexpr int I_IN = (2048 / 64) * (5120 / 32), I_UQ = (512 / 64) * (2048 / 32), I_UKV = (256 / 64) * (2048 / 32), I_O = (2048 / 64) * (2048 / 32), I_PQ = I_O;
    constexpr int NITEMS = I_IN + I_UQ + I_UKV + I_O + I_PQ;
    for (int it = gw; it < NITEMS; it += NGW) {
        int r = it;
        if (r < I_IN) { p0_transpose_item<1>(A.in[I_WIN], 2048, INW, 5120, (f16*)(ws + WS_WT_IN), nullptr, scr, r, lane); continue; } r -= I_IN;
        if (r < I_UQ) { p0_transpose_item<2>(A.in[I_WUQ], 512, 1536, 2048, (f16*)(ws + WS_WT_UQ), A.in[I_GCQ], scr, r, lane); continue; } r -= I_UQ;
        if (r < I_UKV) { p0_transpose_item<0>(A.in[I_WUKV], 256, 2048, 2048, (f16*)(ws + WS_WT_UKV), A.in[I_GCKV], scr, r, lane); continue; } r -= I_UKV;
        if (r < I_O) { p0_transpose_item<0>(A.in[I_WO], 2048, 2048, 2048, (f16*)(ws + WS_WT_O), nullptr, scr, r, lane); continue; } r -= I_O;
        p0_transpose_item<0>(A.in[I_WPQ], 2048, 2048, 2048, (f16*)(ws + WS_WT_PQ), A.in[I_GFFN], scr, r, lane);
    }
    {
        const float* gat = A.in[I_GATTN]; f16* XN = (f16*)(ws + WS_XN);
        for (int row = gw; row < T_; row += NGW) {
            const float* xr = A.in[I_X] + (size_t)row * 2048 + lane * 8;
            f32x4 v[8]; float ss = 0.f;
#pragma unroll
            for (int j = 0; j < 4; ++j) { v[2 * j] = *(const f32x4*)(xr + 512 * j); v[2 * j + 1] = *(const f32x4*)(xr + 512 * j + 4); ss += ssq4(v[2 * j]) + ssq4(v[2 * j + 1]); }
            const float r = 1.0f / sqrtf(wave_sum(ss) * (1.0f / 2048.0f) + EPS);
#pragma unroll
            for (int j = 0; j < 4; ++j) { const f32x4 g0 = *(const f32x4*)(gat + lane * 8 + 512 * j), g1 = *(const f32x4*)(gat + lane * 8 + 512 * j + 4);
                *(f16x8*)(XN + (size_t)row * 2048 + lane * 8 + 512 * j) = pack_f16x8(v[2 * j] * r * g0, v[2 * j + 1] * r * g1); }
        }
    }
    const size_t gtid = (size_t)blockIdx.x * NTHR + wave * 64 + lane, gn = (size_t)G * NTHR;
    { float* CS = (float*)(ws + WS_CS);
      for (size_t i = gtid; i < (size_t)S_ * 32; i += gn) { const int s = (int)(i >> 5), k = (int)(i & 31); const float freq = powf(10000.0f, -2.0f * (float)k / 64.0f); const float ang = (float)s * freq;
          CS[i * 2] = cosf(ang); CS[i * 2 + 1] = sinf(ang); } }
    p0_cvt_f16(A.in[I_SUBK], (f16*)(ws + WS_SK16), (size_t)16 * 128 * 128 / 8, nullptr, 128, gtid, gn);
    if (tables) {
        p0_cvt_f16(A.in[I_UTAB], (f16*)(ws + WS_U16), (size_t)16384 * 2048 / 8, A.in[I_GFFN], 2048, gtid, gn);
        p0_cvt_f16(A.in[I_VTAB], (f16*)(ws + WS_V16), (size_t)16384 * 2048 / 8, nullptr, 2048, gtid, gn);
    }
}

__device__ __forceinline__ unsigned sortable_u32(float f) { const unsigned b = __float_as_uint(f); return (b & 0x80000000u) ? ~b : (b | 0x80000000u); }
__device__ __forceinline__ void idx_item(LAS unsigned char* lds, const f16* __restrict__ QI, const f16* __restrict__ KI, const float* __restrict__ WI, unsigned* __restrict__ MASK,
                                         int b, int chunk, int qq, int wave, int lane) {
    const int tid = wave * 64 + lane;
    const int t0 = b * S_ + chunk * 64 + qq * 16 + wave * 2;
    const int r32 = lane & 31, hi = lane >> 5;
    const int nt32 = 2 * (chunk + 1);
    f16x8 af[4];
    { const f16* qp = QI + (size_t)(t0 + ((r32 >> 2) & 1)) * 1024 + ((r32 & 3) + 4 * (r32 >> 3)) * 64 + 8 * hi;
#pragma unroll
      for (int s = 0; s < 4; ++s) af[s] = *(const f16x8*)(qp + 16 * s); }
    float wv[16];
    { const float* wp = WI + (size_t)(t0 + hi) * 16;
#pragma unroll
      for (int i = 0; i < 4; ++i) { const f32x4 w4 = *(const f32x4*)(wp + 4 * i); wv[4 * i] = w4[0]; wv[4 * i + 1] = w4[1]; wv[4 * i + 2] = w4[2]; wv[4 * i + 3] = w4[3]; } }
    const int skey = tid >> 1, sh = tid & 1;
    const f16* klane = KI + (size_t)b * S_ * 64 + (size_t)skey * 64 + sh * 32;
    f16x8 st0, st1, st2, st3;
#define IDX_SLOAD(stage) do { int so_ = (stage) * 256 * 64; asm volatile("" : "+s"(so_)); const f16* p_ = klane + so_; st0 = *(const f16x8*)(p_); st1 = *(const f16x8*)(p_ + 8); st2 = *(const f16x8*)(p_ + 16); st3 = *(const f16x8*)(p_ + 24); } while (0)
#define IDX_SWRITE(buf) do { LAS unsigned char* d_ = lds + (buf) * 32768 + skey * 128; const int x_ = skey & 7; \
        *(LAS f16x8*)(d_ + (((sh * 4 + 0) ^ x_) << 4)) = st0; *(LAS f16x8*)(d_ + (((sh * 4 + 1) ^ x_) << 4)) = st1; *(LAS f16x8*)(d_ + (((sh * 4 + 2) ^ x_) << 4)) = st2; *(LAS f16x8*)(d_ + (((sh * 4 + 3) ^ x_) << 4)) = st3; } while (0)
    float sc[128];
#pragma unroll
    for (int i = 0; i < 128; ++i) sc[i] = 0.f;
    IDX_SLOAD(0); IDX_SWRITE(0); WG_BAR();
    const int boff = r32 * 128;
#pragma unroll
    for (int stg = 0; stg < 16; ++stg) {
      if (stg * 8 < nt32) {
        const bool more = (stg + 1) * 8 < nt32;
        if (more) IDX_SLOAD(stg + 1);
        const LAS unsigned char* kb = lds + (stg & 1) * 32768;
#pragma unroll
        for (int tl = 0; tl < 8; ++tl) {
            if (stg * 8 + tl < nt32) {
                const LAS unsigned char* kp = kb + tl * 4096 + boff;
                f32x16 acc = {0.f, 0.f, 0.f, 0.f, 0.f, 0.f, 0.f, 0.f, 0.f, 0.f, 0.f, 0.f, 0.f, 0.f, 0.f, 0.f};
#pragma unroll
                for (int s = 0; s < 4; ++s) { const f16x8 bf = *(const LAS f16x8*)(kp + (((2 * s + hi) ^ (r32 & 7)) << 4)); acc = __builtin_amdgcn_mfma_f32_32x32x16_f16(af[s], bf, acc, 0, 0, 0); }
                float s0 = 0.f, s1 = 0.f;
#pragma unroll
                for (int r = 0; r < 16; r += 2) { s0 = fmaf(wv[r], fmaxf(acc[r], 0.f), s0); s1 = fmaf(wv[r + 1], fmaxf(acc[r + 1], 0.f), s1); }
                sc[stg * 8 + tl] = s0 + s1;
            }
        }
        if (more) IDX_SWRITE((stg + 1) & 1);
        WG_BAR();
      }
    }
#undef IDX_SLOAD
#undef IDX_SWRITE
    unsigned u[128];
#pragma unroll
    for (int i = 0; i < 128; ++i) u[i] = (i < nt32) ? sortable_u32(sc[i]) : 0u;
    unsigned thr = 1u;
    if (nt32 * 32 > 256) {
        thr = 0u;
        for (int bit = 31; bit >= 0; --bit) {
            const unsigned cand = thr | (1u << bit);
            int cnt = 0;
#pragma unroll
            for (int i0 = 0; i0 < 128; i0 += 8) { if (i0 < nt32) {
#pragma unroll
                for (int i = i0; i < i0 + 8; ++i) cnt += (u[i] >= cand) ? 1 : 0; } }
            cnt += __shfl_xor(cnt, 1); cnt += __shfl_xor(cnt, 2); cnt += __shfl_xor(cnt, 4); cnt += __shfl_xor(cnt, 8); cnt += __shfl_xor(cnt, 16);
            if (cnt >= 256) thr = cand;
        }
    }
    unsigned wlo0 = 0u, whi0 = 0u, wlo1 = 0u, whi1 = 0u;
#pragma unroll
    for (int i = 0; i < 128; ++i) {
        const unsigned long long bal = __ballot(u[i] >= thr && i < nt32);
        if (i < 64) { if (lane == i) { wlo0 = (unsigned)bal; whi0 = (unsigned)(bal >> 32); } }
        else { if (lane == i - 64) { wlo1 = (unsigned)bal; whi1 = (unsigned)(bal >> 32); } }
    }
    MASK[(size_t)t0 * 128 + lane] = wlo0; MASK[(size_t)t0 * 128 + 64 + lane] = wlo1;
    MASK[(size_t)(t0 + 1) * 128 + lane] = whi0; MASK[(size_t)(t0 + 1) * 128 + 64 + lane] = whi1;
}
__device__ __forceinline__ void idx_phase(LAS unsigned char* lds, const f16* QI, const f16* KI, const float* WI, unsigned* MASK, int cu, int wave) {
    const int lane = lane_id_v();
#pragma unroll 1
    for (int k = 0; k < 2; ++k) {
        const int L = k == 0 ? cu : 511 - cu;
        idx_item(lds, QI, KI, WI, MASK, (L >> 2) & 1, L >> 3, L & 3, wave, lane);
    }
}

namespace att {
#define SBAR() __builtin_amdgcn_sched_barrier(0)
__device__ __forceinline__ int crow(int r, int hi) { return (r & 3) + 8 * (r >> 2) + 4 * hi; }
__device__ __forceinline__ int v_st(int k, int c) { const int kk = (k & ~0xC) | ((k & 4) << 1) | ((k & 8) >> 1); return ((kk >> 3) * 4 + (c >> 5)) * 512 + ((kk & 7) * 32 + (c & 31)) * 2; }
__device__ __forceinline__ int v_rd_base(int lane) { return ((lane & 3) << 3) | (((lane >> 2) & 3) << 6) | (((lane >> 4) & 1) << 5) | (((lane >> 5) & 1) << 8); }
constexpr int v_rd_off(int d0, int ks, int half) { return d0 * 512 + ks * 4096 + half * 2048; }
template <int OFF> __device__ __forceinline__ s16x4 tr_read(int vb) { s16x4 r; asm volatile("ds_read_b64_tr_b16 %0, %1 offset:%2" : "=&v"(r) : "v"(vb), "i"(OFF) : "memory"); return r; }
template <int D0> __device__ __forceinline__ void pv_one(f32x16& od, int vb, bf16x8 pa0, bf16x8 pa1, bf16x8 pa2, bf16x8 pa3) {
  const s16x4 l0 = tr_read<v_rd_off(D0, 0, 0)>(vb), h0 = tr_read<v_rd_off(D0, 0, 1)>(vb), l1 = tr_read<v_rd_off(D0, 1, 0)>(vb), h1 = tr_read<v_rd_off(D0, 1, 1)>(vb);
  const s16x4 l2 = tr_read<v_rd_off(D0, 2, 0)>(vb), h2 = tr_read<v_rd_off(D0, 2, 1)>(vb), l3 = tr_read<v_rd_off(D0, 3, 0)>(vb), h3 = tr_read<v_rd_off(D0, 3, 1)>(vb);
  asm volatile("s_waitcnt lgkmcnt(0)" ::: "memory"); SBAR();
#define PK(L, H) (bf16x8){L[0], L[1], L[2], L[3], H[0], H[1], H[2], H[3]}
  od = __builtin_amdgcn_mfma_f32_32x32x16_bf16(pa0, PK(l0, h0), od, 0, 0, 0);
  od = __builtin_amdgcn_mfma_f32_32x32x16_bf16(pa1, PK(l1, h1), od, 0, 0, 0);
  od = __builtin_amdgcn_mfma_f32_32x32x16_bf16(pa2, PK(l2, h2), od, 0, 0, 0);
  od = __builtin_amdgcn_mfma_f32_32x32x16_bf16(pa3, PK(l3, h3), od, 0, 0, 0);
#undef PK
}
__device__ __forceinline__ void pv_d0(f32x16* o, int vb, bf16x8 pa0, bf16x8 pa1, bf16x8 pa2, bf16x8 pa3) {
  pv_one<0>(o[0], vb, pa0, pa1, pa2, pa3); pv_one<1>(o[1], vb, pa0, pa1, pa2, pa3); pv_one<2>(o[2], vb, pa0, pa1, pa2, pa3); pv_one<3>(o[3], vb, pa0, pa1, pa2, pa3);
}
template <bool DSA> __device__ __forceinline__ void exp16(f32x16& p, unsigned bits, bool near, const LAS float* bt) {
  if (DSA) { if (near) {
#pragma unroll
    for (int r = 0; r < 16; ++r) p[r] += bt[(r & 3) + 8 * (r >> 2)]; } }
#pragma unroll
  for (int r = 0; r < 16; ++r) {
    float v = p[r];
    v = __builtin_amdgcn_exp2f(v);
    if (DSA) { const int m = ((int)(bits << (31 - ((r & 3) + 8 * (r >> 2))))) >> 31; v = __uint_as_float(__float_as_uint(v) & (unsigned)m); }
    p[r] = v;
  }
}
__device__ __forceinline__ void pack_p(const f32x16& p0, const f32x16& p1, float& l_reg, bf16x8& pa0, bf16x8& pa1, bf16x8& pa2, bf16x8& pa3) {
  float ps = 0.f;
#pragma unroll
  for (int r = 0; r < 16; ++r) ps += p0[r];
#pragma unroll
  for (int r = 0; r < 16; ++r) ps += p1[r];
  l_reg += ps;
#define PK4(P, BASE, OUT) do { unsigned a0 = cvt_pk_bf16(P[BASE + 0], P[BASE + 1]), a1 = cvt_pk_bf16(P[BASE + 2], P[BASE + 3]);   \
    unsigned b0 = cvt_pk_bf16(P[BASE + 4], P[BASE + 5]), b1 = cvt_pk_bf16(P[BASE + 6], P[BASE + 7]);                              \
    auto r0 = __builtin_amdgcn_permlane32_swap(a0, b0, false, false); auto r1 = __builtin_amdgcn_permlane32_swap(a1, b1, false, false); \
    u32x4 w = {r0[0], r1[0], r0[1], r1[1]}; OUT = *reinterpret_cast<bf16x8*>(&w); } while (0)
  PK4(p0, 0, pa0); PK4(p0, 8, pa1); PK4(p1, 0, pa2); PK4(p1, 8, pa3);
#undef PK4
}

constexpr int SHM_V = 64 * 128 * 2;
template <int DQK> struct Cfg { static constexpr int ND0 = DQK / 16, RB = DQK * 2, SHM_K = 64 * RB, NJ = DQK / 64, K_OFF = 2 * SHM_V, WS_OFF = K_OFF + 2 * SHM_K, BT_OFF = WS_OFF + 8 * 64 * 4; };

template <int DQK, bool DSA>
__device__ __forceinline__ void attn_item(LAS unsigned char* lds, const bf16_t* __restrict__ Qg, const bf16_t* __restrict__ Kg, const bf16_t* __restrict__ Vg, f16* __restrict__ Y, int ycol0,
                                          const unsigned* __restrict__ MASK, const float* __restrict__ rel_bias, int b, int h, int qb, int wave, int lane) {
  using C = Cfg<DQK>;
  const int tid = wave * 64 + lane, r32 = lane & 31, hi = lane >> 5;
  const int i0 = qb * 256, r0 = i0 + wave * 32;
  const int NT = 4 * (qb + 1), mychunk = 4 * qb + (wave >> 1);
  const bf16_t* Kh = Kg + (size_t)(b * 8 + h) * S_ * DQK;
  const bf16_t* Vh = Vg + (size_t)(b * 8 + h) * S_ * 128;
  LAS unsigned char* V_lds = lds; LAS unsigned char* K_lds = lds + C::K_OFF;
  LAS float* li_l = (LAS float*)(lds + C::WS_OFF) + wave * 64;
  LAS float* BT = (LAS float*)(lds + C::BT_OFF);
  bf16x8 qr[C::ND0];
  { const bf16_t* Qw = Qg + ((size_t)(b * 8 + h) * S_ + r0 + r32) * DQK + hi * 8;
#pragma unroll
    for (int d0 = 0; d0 < C::ND0; ++d0) qr[d0] = *(const bf16x8*)(Qw + d0 * 16); }
  float bias_far = 0.f;
  if (DSA) bias_far = rel_bias[15 * 8 + h] * LOG2E;
  const int sk = tid >> 3, c0 = tid & 7;
  const int xs_s = (DQK == 192) ? ((sk >> 1) & 7) : (sk & 7);
  const int kst = sk * C::RB + ((c0 ^ xs_s) << 4);
  const int sr = tid >> 4, sc = (tid & 15) * 8, vst0 = v_st(sr, sc), vst1 = v_st(32 + sr, sc);
  const int vb0 = (int)(uintptr_t)V_lds + v_rd_base(lane);
  const int xs_r = (DQK == 192) ? ((r32 >> 1) & 7) : (r32 & 7);
  int kb[4];
#pragma unroll
  for (int q = 0; q < 4; ++q) kb[q] = r32 * C::RB + ((((2 * q + hi) & 7) ^ xs_r) << 4);
  bf16x8 ks[C::NJ], vs0, vs1; u32x2 mwA = {0u, 0u}, mwB = {0u, 0u}, mwN = {0u, 0u};
  const unsigned* mrow = DSA ? MASK + (size_t)(b * S_ + r0 + r32) * 128 : nullptr;
#define SLOAD(k0) do { const int k0_ = (k0); _Pragma("unroll") for (int jj_ = 0; jj_ < C::NJ; ++jj_) ks[jj_] = *(const bf16x8*)(Kh + (size_t)(k0_ + sk) * DQK + (c0 + 8 * jj_) * 8); \
    vs0 = *(const bf16x8*)(Vh + (size_t)(k0_ + sr) * 128 + sc); vs1 = *(const bf16x8*)(Vh + (size_t)(k0_ + 32 + sr) * 128 + sc); \
    if (DSA) mwN = *(const u32x2*)(mrow + 2 * (k0_ >> 6)); } while (0)
#define SWRITE(bf) do { const int bf_ = (bf); _Pragma("unroll") for (int jj_ = 0; jj_ < C::NJ; ++jj_) *(LAS bf16x8*)(K_lds + bf_ * C::SHM_K + kst + jj_ * 128) = ks[jj_]; \
    *(LAS bf16x8*)(V_lds + bf_ * SHM_V + vst0) = vs0; *(LAS bf16x8*)(V_lds + bf_ * SHM_V + vst1) = vs1; } while (0)
#define TILE_OFF(j) ((DSA) ? (((64 * (j) + 154) <= r0) ? bias_far : 0.f) : (((j) <= mychunk) ? 0.f : -1e30f))
#define TILE_NEAR(j) ((64 * (j) + 154) > r0)
#define QKT(P0, P1, bf, j) do { const float off_ = TILE_OFF(j); \
    _Pragma("unroll") for (int rr_ = 0; rr_ < 16; ++rr_) { P0[rr_] = off_; P1[rr_] = off_; } \
    const LAS unsigned char* Kp = K_lds + (bf) * C::SHM_K; \
    _Pragma("unroll") for (int d0 = 0; d0 < C::ND0; ++d0) { \
      const bf16x8 b0 = *(const LAS bf16x8*)(Kp + kb[d0 & 3] + (d0 >> 2) * 128); const bf16x8 b1 = *(const LAS bf16x8*)(Kp + kb[d0 & 3] + (d0 >> 2) * 128 + 32 * C::RB); \
      P0 = __builtin_amdgcn_mfma_f32_32x32x16_bf16(b0, qr[d0], P0, 0, 0, 0); P1 = __builtin_amdgcn_mfma_f32_32x32x16_bf16(b1, qr[d0], P1, 0, 0, 0); } } while (0)
#define BTP(j) (BT + (64 * (j) - r0 - r32 + 4 * hi + 256))
#define MWFIX(mw, j) do { if (DSA) { if ((j) > mychunk) { mw.x = 0u; mw.y = 0u; } mw.x >>= (4 * hi); mw.y >>= (4 * hi); } } while (0)
  f32x16 o[4];
#pragma unroll
  for (int d = 0; d < 4; ++d)
#pragma unroll
    for (int r = 0; r < 16; ++r) o[d][r] = 0.f;
  float l_reg = 0.f;
  f32x16 p0, p1; bf16x8 pa0, pa1, pa2, pa3; u32x2 mw = {0u, 0u};
  __syncthreads();
  if (DSA) { if (tid < 320) BT[tid] = rel_bias[t5_bucket(tid - 256) * 8 + h] * LOG2E; }
  SLOAD(0); asm volatile("s_waitcnt vmcnt(0)" ::: "memory"); SWRITE(0); __syncthreads();
#pragma unroll 1
  for (int j = 0; j < NT; ++j) {
    const int bf = j & 1;
    mw = mwN; MWFIX(mw, j);
    if (j + 1 < NT) SLOAD((j + 1) * 64);
    SBAR(); QKT(p0, p1, bf, j);
    exp16<DSA>(p0, mw.x, TILE_NEAR(j), BTP(j)); exp16<DSA>(p1, mw.y, TILE_NEAR(j), BTP(j) + 32);
    pack_p(p0, p1, l_reg, pa0, pa1, pa2, pa3); SBAR();
    pv_d0(o, vb0 + bf * SHM_V, pa0, pa1, pa2, pa3);
    if (j + 1 < NT) { asm volatile("s_waitcnt vmcnt(0)" ::: "memory"); SWRITE(bf ^ 1); }
    __syncthreads();
  }
  { auto rr = __builtin_amdgcn_permlane32_swap(__float_as_uint(l_reg), __float_as_uint(l_reg), false, false); l_reg = __uint_as_float(rr[0]) + __uint_as_float(rr[1]); }
  if (hi == 0) li_l[r32] = l_reg;
  asm volatile("s_waitcnt lgkmcnt(0)" ::: "memory");
  float rli[16];
#pragma unroll
  for (int r = 0; r < 16; ++r) rli[r] = __builtin_amdgcn_rcpf(li_l[crow(r, hi)]);
  f16* Yw = Y + (size_t)(b * S_ + r0) * 2048 + ycol0 + h * 128 + r32;
#pragma unroll
  for (int r = 0; r < 16; ++r) { const int orow = crow(r, hi);
#pragma unroll
    for (int d0 = 0; d0 < 4; ++d0) Yw[(size_t)orow * 2048 + d0 * 32] = (f16)(o[d0][r] * rli[r]); }
#undef SLOAD
#undef SWRITE
#undef TILE_OFF
#undef TILE_NEAR
#undef QKT
#undef BTP
#undef MWFIX
}
#undef SBAR
}

__device__ __forceinline__ void attn_phase(LAS unsigned char* lds, unsigned char* ws, const float* rel_bias, int cu, int wave) {
  const int lane = lane_id_v();
  const int bh = cu >> 4, qb = cu & 15, b = bh >> 3, h = bh & 7;
  att::attn_item<192, false>(lds, (const bf16_t*)(ws + WS_QM), (const bf16_t*)(ws + WS_KM), (const bf16_t*)(ws + WS_VM), (f16*)(ws + WS_Y), 0, nullptr, nullptr, b, h, qb, wave, lane);
  att::attn_item<128, true>(lds, (const bf16_t*)(ws + WS_QD), (const bf16_t*)(ws + WS_KD), (const bf16_t*)(ws + WS_VD), (f16*)(ws + WS_Y), 1024, (const unsigned*)(ws + WS_MASK), rel_bias, b, h, 15 - qb, wave, lane);
}

namespace peer {
__device__ __forceinline__ unsigned row_ror(unsigned x, int n) {
  switch (n) { case 1: return (unsigned)__builtin_amdgcn_update_dpp(0, (int)x, 0x121, 0xf, 0xf, false); case 2: return (unsigned)__builtin_amdgcn_update_dpp(0, (int)x, 0x122, 0xf, 0xf, false);
               case 4: return (unsigned)__builtin_amdgcn_update_dpp(0, (int)x, 0x124, 0xf, 0xf, false); default: return (unsigned)__builtin_amdgcn_update_dpp(0, (int)x, 0x128, 0xf, 0xf, false); }
}
__device__ __forceinline__ unsigned row_max_u32(unsigned x) { x = max(x, row_ror(x, 1)); x = max(x, row_ror(x, 2)); x = max(x, row_ror(x, 4)); x = max(x, row_ror(x, 8)); return x; }
__device__ __forceinline__ float row_sum_f32(float x) {
  x += __uint_as_float(row_ror(__float_as_uint(x), 1)); x += __uint_as_float(row_ror(__float_as_uint(x), 2)); x += __uint_as_float(row_ror(__float_as_uint(x), 4)); x += __uint_as_float(row_ror(__float_as_uint(x), 8)); return x; }
__device__ __forceinline__ float unsort_f32(unsigned u) { return __uint_as_float((u & 0x80000000u) ? (u & 0x7fffffffu) : ~u); }

__device__ __forceinline__ void top16_of_128(unsigned (&pk)[8][4], unsigned (&top)[4], int c) {
#pragma unroll
  for (int reg = 0; reg < 4; ++reg) {
    unsigned t = 0u;
#pragma unroll 1
    for (int round = 0; round < 16; ++round) {
      unsigned m = max(max(max(pk[0][reg], pk[1][reg]), max(pk[2][reg], pk[3][reg])), max(max(pk[4][reg], pk[5][reg]), max(pk[6][reg], pk[7][reg])));
      m = row_max_u32(m);
      if (c == round) t = m;
#pragma unroll
      for (int nt = 0; nt < 8; ++nt) pk[nt][reg] = (pk[nt][reg] == m) ? 0u : pk[nt][reg];
    }
    top[reg] = t;
  }
}

__device__ __forceinline__ void select_task(const f16* __restrict__ QR, const f16* __restrict__ SK16, LAS u32x2* EG, int t0, int tg, int h, int lane) {
  const int c = lane & 15, q = lane >> 4, rowbase = lane & 48;
  unsigned top[2][4];
#pragma unroll
  for (int p = 0; p < 2; ++p) {
    f16x8 af[4];
    { const f16* qp = QR + (size_t)(t0 + 16 * tg + c) * 2048 + h * 256 + p * 128 + 8 * q;
#pragma unroll
      for (int s = 0; s < 4; ++s) af[s] = *(const f16x8*)(qp + 32 * s); }
    const f16* kp = SK16 + (size_t)((h * 2 + p) * 128 + c) * 128 + 8 * q;
    unsigned pk[8][4];
#pragma unroll
    for (int nt = 0; nt < 8; ++nt) {
      f32x4 acc = {0.f, 0.f, 0.f, 0.f};
#pragma unroll
      for (int s = 0; s < 4; ++s) { const f16x8 bf = *(const f16x8*)(kp + (size_t)nt * 16 * 128 + 32 * s); acc = __builtin_amdgcn_mfma_f32_16x16x32_f16(af[s], bf, acc, 0, 0, 0); }
#pragma unroll
      for (int reg = 0; reg < 4; ++reg) pk[nt][reg] = (sortable_u32(acc[reg]) & ~0x7Fu) | (unsigned)(127 - (16 * nt + c));
    }
    top16_of_128(pk, top[p], c);
  }
  int ci[4], cj[4];
#pragma unroll
  for (int r = 0; r < 4; ++r) { const int n = c + 16 * r; int i, j;
    if (n < 16) { i = 0; j = n; } else if (n < 24) { i = 1; j = n - 16; } else if (n < 29) { i = 2; j = n - 24; } else if (n < 33) { i = 3; j = n - 29; } else if (n < 36) { i = 4; j = n - 33; }
    else if (n < 42) { i = 5 + ((n - 36) >> 1); j = (n - 36) & 1; } else if (n < 50) { i = 8 + (n - 42); j = 0; } else { i = -1; j = 0; }
    ci[r] = i; cj[r] = j; }
#pragma unroll
  for (int reg = 0; reg < 4; ++reg) {
    unsigned ck[4];
#pragma unroll
    for (int r = 0; r < 4; ++r) {
      const unsigned a = (unsigned)__shfl((int)top[0][reg], rowbase + (ci[r] < 0 ? 0 : ci[r])), b = (unsigned)__shfl((int)top[1][reg], rowbase + cj[r]);
      const float v = unsort_f32(a & ~0x7Fu) + unsort_f32(b & ~0x7Fu);
      ck[r] = (ci[r] < 0) ? 0u : ((sortable_u32(v) & ~0xFFu) | (unsigned)(255 - (ci[r] * 16 + cj[r])));
    }
    unsigned t = 0u;
#pragma unroll 1
    for (int round = 0; round < 16; ++round) {
      unsigned m = max(max(ck[0], ck[1]), max(ck[2], ck[3]));
      m = row_max_u32(m);
      if (c == round) t = m;
#pragma unroll
      for (int r = 0; r < 4; ++r) ck[r] = (ck[r] == m) ? 0u : ck[r];
    }
    const int flat = 255 - (int)(t & 0xFFu); const float ct = unsort_f32(t & ~0xFFu);
    const unsigned k0 = (unsigned)__shfl((int)top[0][reg], rowbase + (flat >> 4)), k1 = (unsigned)__shfl((int)top[1][reg], rowbase + (flat & 15));
    const int expert = (127 - (int)(k0 & 0x7Fu)) * 128 + (127 - (int)(k1 & 0x7Fu));
    const float cmax = __shfl(ct, rowbase);
    const float e = __expf(ct - cmax);
    const float g = e / row_sum_f32(e);
    u32x2 w; w.x = (unsigned)expert; w.y = __float_as_uint(g);
    EG[(16 * tg + 4 * q + reg) * 128 + h * 16 + c] = w;
  }
}

__device__ __forceinline__ void gather_token(const f16* __restrict__ U16, const f16* __restrict__ V16, const f16* __restrict__ X2H, const float* __restrict__ SSQ2, float* __restrict__ out,
                                             const LAS u32x2* EG, int t, int tl, int lane) {
  typedef _Float16 h2 __attribute__((ext_vector_type(2)));
  f16x8 xh[4];
#pragma unroll
  for (int i = 0; i < 4; ++i) xh[i] = *(const f16x8*)(X2H + (size_t)t * 2048 + 8 * lane + 512 * i);
  float ss = lane < 32 ? SSQ2[(size_t)t * 32 + lane] : 0.f;
  const float r2 = 1.0f / sqrtf(wave_sum(ss) * (1.0f / 2048.0f) + EPS);
  f32x4 acc[8];
#pragma unroll
  for (int i = 0; i < 8; ++i) acc[i] = (f32x4){0.f, 0.f, 0.f, 0.f};
  const LAS u32x2* eg = EG + tl * 128;
  const size_t lo = (size_t)8 * lane;
#define LOADROW(dst, tab, e) do { const f16* rp_ = (tab) + (size_t)(e) * 2048 + lo; _Pragma("unroll") for (int i_ = 0; i_ < 4; ++i_) dst[i_] = *(const f16x8*)(rp_ + 512 * i_); } while (0)
#define DOTROW(src, res) do { float d_ = 0.f; _Pragma("unroll") for (int i_ = 0; i_ < 4; ++i_) { _Pragma("unroll") for (int j_ = 0; j_ < 4; ++j_) { \
      const h2 a_ = {src[i_][2 * j_], src[i_][2 * j_ + 1]}, b_ = {xh[i_][2 * j_], xh[i_][2 * j_ + 1]}; d_ = __builtin_amdgcn_fdot2(a_, b_, d_, false); } } res = wave_sum(d_); } while (0)
#define ACCROW(src, w) do { _Pragma("unroll") for (int i_ = 0; i_ < 4; ++i_) { _Pragma("unroll") for (int j_ = 0; j_ < 4; ++j_) { acc[2 * i_][j_] = fmaf((float)src[i_][j_], (w), acc[2 * i_][j_]); acc[2 * i_ + 1][j_] = fmaf((float)src[i_][4 + j_], (w), acc[2 * i_ + 1][j_]); } } } while (0)
#define GELU_W(d, g) ({ const float a_ = (d) * r2; (g) * 0.5f * a_ * (1.0f + erff(a_ * 0.70710678118654752f)); })
  f16x8 ua0[4], ua1[4], ub0[4], ub1[4], va0[4], va1[4];
  u32x2 ea0 = eg[0], ea1 = eg[1], eb0, eb1;
  LOADROW(ua0, U16, ea0.x); LOADROW(ua1, U16, ea1.x);
#pragma unroll 1
  for (int k = 0; k < 128; k += 4) {
    eb0 = eg[k + 2]; eb1 = eg[k + 3];
    LOADROW(va0, V16, ea0.x); LOADROW(va1, V16, ea1.x);
    LOADROW(ub0, U16, eb0.x); LOADROW(ub1, U16, eb1.x);
    { float d0, d1; DOTROW(ua0, d0); DOTROW(ua1, d1);
      const float w0 = GELU_W(d0, __uint_as_float(ea0.y)), w1 = GELU_W(d1, __uint_as_float(ea1.y));
      ACCROW(va0, w0); ACCROW(va1, w1); }
    const int kn = (k + 4 < 128) ? k + 4 : 0;
    ea0 = eg[kn]; ea1 = eg[kn + 1];
    LOADROW(va0, V16, eb0.x); LOADROW(va1, V16, eb1.x);
    LOADROW(ua0, U16, ea0.x); LOADROW(ua1, U16, ea1.x);
    { float d0, d1; DOTROW(ub0, d0); DOTROW(ub1, d1);
      const float w0 = GELU_W(d0, __uint_as_float(eb0.y)), w1 = GELU_W(d1, __uint_as_float(eb1.y));
      ACCROW(va0, w0); ACCROW(va1, w1); }
  }
#undef LOADROW
#undef DOTROW
#undef ACCROW
#undef GELU_W
  float* op = out + (size_t)t * 2048 + 8 * lane;
#pragma unroll
  for (int i = 0; i < 4; ++i) { const f32x4 a = *(const f32x4*)(op + 512 * i), b = *(const f32x4*)(op + 512 * i + 4);
    *(f32x4*)(op + 512 * i) = a + acc[2 * i]; *(f32x4*)(op + 512 * i + 4) = b + acc[2 * i + 1]; }
}
}

__device__ __forceinline__ void peer_phase(LAS unsigned char* lds, unsigned char* ws, float* out, int cu, int wave) {
  const int lane = lane_id_v();
  LAS u32x2* EG = (LAS u32x2*)lds;
  const int t0 = cu * 32;
  __syncthreads();
#pragma unroll 1
  for (int k = 0; k < 2; ++k) { const int task = wave + 8 * k; peer::select_task((const f16*)(ws + WS_QR), (const f16*)(ws + WS_SK16), EG, t0, task & 1, task >> 1, lane); }
  WG_BAR();
#pragma unroll 1
  for (int k = 0; k < 4; ++k) { const int tl = wave + 8 * k; peer::gather_token((const f16*)(ws + WS_U16), (const f16*)(ws + WS_V16), (const f16*)(ws + WS_XN), (const float*)(ws + WS_SSQ2), out, EG, t0 + tl, tl, lane); }
}
#define PHASE2_EXTRA idx_phase(lds + RING_OFF, (const f16*)(ws + WS_QI), (const f16*)(ws + WS_KI), (const float*)(ws + WS_WI), (unsigned*)(ws + WS_MASK), c, wave);
#ifndef PHASE2_EXTRA
#define PHASE2_EXTRA
#endif
#ifndef PHASES_4_TO_6
#define PHASES_4_TO_6
#endif
#ifndef DEBUG_STAGE_2
#define DEBUG_STAGE_2
#endif

#ifndef MK_DEBUG
#define MK_DEBUG 0
#endif
constexpr int N_PHASES = 7;
__global__ void __launch_bounds__(NTHR, 2) mk_fwd(Args args) {
    extern __shared__ __attribute__((aligned(16))) unsigned char lds_raw[];
    LAS unsigned char* lds = (LAS unsigned char*)lds_raw;
    const int wave = __builtin_amdgcn_readfirstlane(threadIdx.x >> 6);
    volatile LAS unsigned* MISC = (volatile LAS unsigned*)(lds + MISC_OFF);
    if (threadIdx.x < 64) MISC[threadIdx.x] = 0u;
    __syncthreads();
    unsigned char* ws = args.ws;
    const int lo = args.ph_lo, hi = args.ph_hi;
    const bool multi = (hi - lo) > 1;
    XcdBarrier bar; bar.bar = (unsigned*)(ws + WS_CTL); bar.x = 0; bar.st = nullptr; bar.wave = wave;
    if (multi) bar = xcd_barrier_post((unsigned*)(ws + WS_CTL), MISC + 8, wave);
#define IN(k) (lo <= (k) && (k) < hi)
#define SEAM(k) do { if (IN(k) && IN((k) + 1)) xcd_barrier(bar); } while (0)
    const int c = blockIdx.x;
    LAS float* P = (LAS float*)(lds + EPI_OFF);

    if (IN(0)) { p0_prologue(args, lds, wave, lane_id_v(), MK_DEBUG == 0 || MK_DEBUG >= 6); __syncthreads(); }
    SEAM(0);
    if (IN(1)) {
        pg8::Gemm g{(const f16*)(ws + WS_XN), (const f16*)(ws + WS_WT_IN), T_, 4096, 2048}; pg8::StaticOrder S; S.init(T_, 4096, gridDim.x, c);
        EpiIn E{(f16*)(ws + WS_CQ), (f16*)(ws + WS_CKV), (float*)(ws + WS_SSQ_CQ), (float*)(ws + WS_SSQ_CKV), (bf16_t*)(ws + WS_QD), (bf16_t*)(ws + WS_KD), (f16*)(ws + WS_QI), (f16*)(ws + WS_KI),
                (float*)(ws + WS_WI), (float*)(ws + WS_KR), (float*)(ws + WS_SSQ_KR), args.in[I_GDQ], args.in[I_GDK], args.in[I_GMK], (const float*)(ws + WS_CS), P};
        pg8::gemm_phase<EpiIn, pg8::StaticOrder>(lds + RING_OFF, g, S, E, wave);
    }
    SEAM(1);
    if (IN(2)) {
        const int half = gridDim.x / 2;
        if (c < half) {
            pg8::Gemm g{(const f16*)(ws + WS_XN), (const f16*)(ws + WS_WT_IN) + (size_t)4096 * 2048, T_, 1024, 2048}; pg8::StaticOrder S; S.init(T_, 1024, half, c);
            EpiVd E{(bf16_t*)(ws + WS_VD)};
            pg8::gemm_phase<EpiVd, pg8::StaticOrder>(lds + RING_OFF, g, S, E, wave);
        } else {
            { pg8::Gemm g{(const f16*)(ws + WS_CQ), (const f16*)(ws + WS_WT_UQ), T_, 2048, 512}; pg8::StaticOrder S; S.init(T_, 2048, half, c - half);
              EpiQup E{(bf16_t*)(ws + WS_QM), (const float*)(ws + WS_SSQ_CQ), args.in[I_GMQ], (const float*)(ws + WS_CS), P};
              pg8::gemm_phase<EpiQup, pg8::StaticOrder>(lds + RING_OFF, g, S, E, wave); }
            { pg8::Gemm g{(const f16*)(ws + WS_CKV), (const f16*)(ws + WS_WT_UKV), T_, 2048, 256}; pg8::StaticOrder S; S.init(T_, 2048, half, c - half);
              EpiKVup E{(bf16_t*)(ws + WS_KM), (bf16_t*)(ws + WS_VM), (const float*)(ws + WS_SSQ_CKV), (const float*)(ws + WS_SSQ_KR), (const float*)(ws + WS_KR), args.in[I_GMK], P};
              pg8::gemm_phase<EpiKVup, pg8::StaticOrder>(lds + RING_OFF, g, S, E, wave); }
        }
        PHASE2_EXTRA
    }
    SEAM(2);
    if (IN(3)) { attn_phase(lds + RING_OFF, ws, args.in[I_RELB], c, wave); }
    SEAM(3);
    if (IN(4)) {
        pg8::Gemm g{(const f16*)(ws + WS_Y), (const f16*)(ws + WS_WT_O), T_, 2048, 2048}; pg8::StaticOrder S; S.init(T_, 2048, gridDim.x, c);
        EpiOut E{args.in[I_X], args.out, (f16*)(ws + WS_XN), (float*)(ws + WS_SSQ2)};
        pg8::gemm_phase<EpiOut, pg8::StaticOrder>(lds + RING_OFF, g, S, E, wave);
    }
    SEAM(4);
    if (IN(5)) {
        pg8::Gemm g{(const f16*)(ws + WS_XN), (const f16*)(ws + WS_WT_PQ), T_, 2048, 2048}; pg8::StaticOrder S; S.init(T_, 2048, gridDim.x, c);
        LAS float* R2s = (LAS float*)(lds + R2S_OFF);
        pg8::Unit u0;
        if (S.next(0, u0)) { const int tid = wave * 64 + lane_id_v();
            if (tid < 256) { const float* sp = (const float*)(ws + WS_SSQ2) + (size_t)(u0.pm * 256 + tid) * 32; float ss = 0.f;
#pragma unroll
                for (int i = 0; i < 8; ++i) ss += sum4(*(const f32x4*)(sp + 4 * i));
                R2s[tid] = 1.0f / sqrtf(ss * (1.0f / 2048.0f) + EPS); } }
        __syncthreads();
        EpiQr E{(f16*)(ws + WS_QR), R2s};
        pg8::gemm_phase<EpiQr, pg8::StaticOrder>(lds + RING_OFF, g, S, E, wave);
    }
    SEAM(5);
    if (IN(6)) { peer_phase(lds + RING_OFF, ws, args.out, c, wave); }
#undef IN
#undef SEAM
}

extern "C" void kernel_launch(void* const* d_in, const int* in_sizes, int n_in, void* d_out, int out_size, void* d_ws, size_t ws_size, hipStream_t stream) {
    static int ok = 0;
    if (ok == 0) {
        if (n_in != 18 || in_sizes[0] != T_ * D_ || out_size != T_ * D_ || ws_size < (size_t)512 * MiB) { fprintf(stderr, "kernel_launch: unexpected shapes / workspace (n_in %d, ws %zu)\n", n_in, ws_size); ok = -1; return; }
        int dev = 0, cus = 0;
        if (hipGetDevice(&dev) != hipSuccess || hipDeviceGetAttribute(&cus, hipDeviceAttributeMultiprocessorCount, dev) != hipSuccess || cus < NCU) { fprintf(stderr, "kernel_launch: needs a %d-CU device (got %d)\n", NCU, cus); ok = -1; return; }
        if (hipFuncSetAttribute((const void*)mk_fwd, hipFuncAttributeMaxDynamicSharedMemorySize, LDS_BYTES) != hipSuccess) { fprintf(stderr, "kernel_launch: hipFuncSetAttribute failed\n"); ok = -1; return; }
        ok = 1;
    }
    if (ok < 0) return;
    unsigned char* ws = (unsigned char*)d_ws;
    (void)hipMemsetAsync(ws + WS_CTL, 0, CTL_ZERO_BYTES, stream);
    Args a{};
    for (int i = 0; i < 18; ++i) a.in[i] = (const float*)d_in[i];
    a.out = (float*)d_out; a.ws = ws;
#if MK_DEBUG == 0
#ifdef MK_PER_PHASE
    for (int ph = 0; ph < N_PHASES; ++ph) { a.ph_lo = ph; a.ph_hi = ph + 1; hipLaunchKernelGGL(mk_fwd, dim3(NCU), dim3(NTHR), LDS_BYTES, stream, a); }
#else
    a.ph_lo = 0; a.ph_hi = N_PHASES;
    hipLaunchKernelGGL(mk_fwd, dim3(NCU), dim3(NTHR), LDS_BYTES, stream, a);
#endif
#else
    const float* x = a.in[I_X];
    unsigned* ERR = (unsigned*)(ws + 32768);
    int nslots = 0;
#if MK_DEBUG == 1
    for (int ph = 0; ph < 3; ++ph) { a.ph_lo = ph; a.ph_hi = ph + 1; hipLaunchKernelGGL(mk_fwd, dim3(NCU), dim3(NTHR), LDS_BYTES, stream, a); }
    float* PROJ = (float*)(ws + 288 * MiB); float* H = (float*)(ws + 368 * MiB); float* QRAW = H; float* KVRAW = (float*)(ws + 400 * MiB);
    float* CQN = (float*)(ws + 432 * MiB); float* CKVN = (float*)(ws + 440 * MiB); float* QM = (float*)(ws + 432 * MiB); float* KMT = (float*)(ws + 456 * MiB);
    float* QD = (float*)(ws + 480 * MiB); float* KDT = (float*)(ws + 496 * MiB);
    k_rmsnorm<<<TB0 / 4, 256, 0, stream>>>(x, 2048, 2048, a.in[I_GATTN], H, 2048, TB0);
    k_cmp<<<1024, 256, 0, stream>>>(F_f16_f32{(const f16*)(ws + WS_XN), H}, (size_t)TB0 * 2048, ERR, 0, 0.004f, 0.004f);
    k_gemm<<<dim3((INW + 63) / 64, TB0 / 64), 256, 0, stream>>>(H, 2048, a.in[I_WIN], INW, PROJ, INW, TB0, INW, 2048, nullptr, 0);
    k_cmp<<<1024, 256, 0, stream>>>(F_cols16{(const f16*)(ws + WS_CQ), PROJ, 512, INW, OFF_CQ, 1.f}, (size_t)TB0 * 512, ERR, 1, 0.004f, 0.004f);
    k_cmp<<<1024, 256, 0, stream>>>(F_cols16{(const f16*)(ws + WS_CKV), PROJ, 256, INW, OFF_CKV, 1.f}, (size_t)TB0 * 256, ERR, 2, 0.004f, 0.004f);
    k_cmp<<<1024, 256, 0, stream>>>(F_cols16{(const f16*)(ws + WS_QI), PROJ, 1024, INW, OFF_QI, 0.125f}, (size_t)TB0 * 1024, ERR, 3, 0.004f, 0.0005f);
    k_cmp<<<1024, 256, 0, stream>>>(F_cols16{(const f16*)(ws + WS_KI), PROJ, 64, INW, OFF_KI, 1.f}, (size_t)TB0 * 64, ERR, 4, 0.004f, 0.004f);
    k_cmp<<<1024, 256, 0, stream>>>(F_cols32{(const float*)(ws + WS_WI), PROJ, 16, INW, OFF_WI, 0}, (size_t)TB0 * 16, ERR, 5, 0.004f, 0.004f);
    k_rmsnorm<<<TB0 / 4, 256, 0, stream>>>(PROJ + OFF_CQ, INW, 512, a.in[I_GCQ], CQN, 512, TB0);
    k_rmsnorm<<<TB0 / 4, 256, 0, stream>>>(PROJ + OFF_CKV, INW, 256, a.in[I_GCKV], CKVN, 256, TB0);
    k_gemm<<<dim3(1536 / 64, TB0 / 64), 256, 0, stream>>>(CQN, 512, a.in[I_WUQ], 1536, QRAW, 1536, TB0, 1536, 512, nullptr, 0);
    k_gemm<<<dim3(2048 / 64, TB0 / 64), 256, 0, stream>>>(CKVN, 256, a.in[I_WUKV], 2048, KVRAW, 2048, TB0, 2048, 256, nullptr, 0);
    k_mla_prep<<<TB0 * 8 / 4, 256, 0, stream>>>(QRAW, KVRAW, PROJ, a.in[I_GMQ], a.in[I_GMK], QM, KMT);
    k_dsa_prep<<<TB0 * 8 / 4, 256, 0, stream>>>(PROJ, a.in[I_GDQ], a.in[I_GDK], QD, KDT);
    k_cmp<<<1024, 256, 0, stream>>>(F_heads{(const bf16_t*)(ws + WS_QD), QD, 128, QS_DSA, 0, 0}, (size_t)8 * S_ * 128, ERR, 6, 0.008f, 0.006f * QS_DSA);
    k_cmp<<<1024, 256, 0, stream>>>(F_heads{(const bf16_t*)(ws + WS_KD), KDT, 128, 1.f, 1, 0}, (size_t)8 * S_ * 128, ERR, 7, 0.008f, 0.006f);
    k_cmp<<<1024, 256, 0, stream>>>(F_headcols{(const bf16_t*)(ws + WS_VD), PROJ, INW, OFF_VD, 128, 0}, (size_t)8 * S_ * 128, ERR, 8, 0.008f, 0.006f);
    k_cmp<<<1024, 256, 0, stream>>>(F_heads{(const bf16_t*)(ws + WS_QM), QM, 192, QS_MLA, 0, 1}, (size_t)8 * S_ * 192, ERR, 9, 0.008f, 0.006f * QS_MLA);
    k_cmp<<<1024, 256, 0, stream>>>(F_heads{(const bf16_t*)(ws + WS_KM), KMT, 192, 1.f, 1, 1}, (size_t)8 * S_ * 192, ERR, 10, 0.008f, 0.006f);
    k_cmp<<<1024, 256, 0, stream>>>(F_headcols{(const bf16_t*)(ws + WS_VM), KVRAW, 2048, 128, 256, 0}, (size_t)8 * S_ * 128, ERR, 11, 0.008f, 0.006f);
    nslots = 12;
#endif
#if MK_DEBUG == 2
    for (int ph = 0; ph < 3; ++ph) { a.ph_lo = ph; a.ph_hi = ph + 1; hipLaunchKernelGGL(mk_fwd, dim3(NCU), dim3(NTHR), LDS_BYTES, stream, a); }
    { float* PROJ = (float*)(ws + 288 * MiB); float* H = (float*)(ws + 368 * MiB); float* KIT = (float*)(ws + 400 * MiB); unsigned* MASKN = (unsigned*)(ws + 402 * MiB);
      k_rmsnorm<<<TB0 / 4, 256, 0, stream>>>(x, 2048, 2048, a.in[I_GATTN], H, 2048, TB0);
      k_gemm<<<dim3((INW + 63) / 64, TB0 / 64), 256, 0, stream>>>(H, 2048, a.in[I_WIN], INW, PROJ, INW, TB0, INW, 2048, nullptr, 0);
      k_kit<<<TB0 * 64 / 256, 256, 0, stream>>>(PROJ, KIT);
      k_index<<<TB0 / 2, 128, 0, stream>>>(PROJ, KIT, MASKN);
      k_cmp<<<1024, 256, 0, stream>>>(F_mask{(const unsigned*)(ws + WS_MASK), MASKN}, (size_t)TB0 * 128, ERR, 0, 0.f, 4.0f);
      nslots = 1; }
#endif
#if MK_DEBUG == 3
    for (int ph = 0; ph < 4; ++ph) { a.ph_lo = ph; a.ph_hi = ph + 1; hipLaunchKernelGGL(mk_fwd, dim3(NCU), dim3(NTHR), LDS_BYTES, stream, a); }
    { float* PROJ = (float*)(ws + 288 * MiB); float* H = (float*)(ws + 368 * MiB); float* QRAW = H; float* KVRAW = (float*)(ws + 400 * MiB);
      float* CQN = (float*)(ws + 432 * MiB); float* CKVN = (float*)(ws + 440 * MiB); float* QM = (float*)(ws + 432 * MiB); float* KMT = (float*)(ws + 456 * MiB);
      float* QD = (float*)(ws + 480 * MiB); float* KDT = (float*)(ws + 496 * MiB); float* KIT = (float*)(ws + 368 * MiB); unsigned* MASKN = (unsigned*)(ws + 370 * MiB); float* YN = a.out;
      k_rmsnorm<<<TB0 / 4, 256, 0, stream>>>(x, 2048, 2048, a.in[I_GATTN], H, 2048, TB0);
      k_gemm<<<dim3((INW + 63) / 64, TB0 / 64), 256, 0, stream>>>(H, 2048, a.in[I_WIN], INW, PROJ, INW, TB0, INW, 2048, nullptr, 0);
      k_rmsnorm<<<TB0 / 4, 256, 0, stream>>>(PROJ + OFF_CQ, INW, 512, a.in[I_GCQ], CQN, 512, TB0);
      k_rmsnorm<<<TB0 / 4, 256, 0, stream>>>(PROJ + OFF_CKV, INW, 256, a.in[I_GCKV], CKVN, 256, TB0);
      k_gemm<<<dim3(1536 / 64, TB0 / 64), 256, 0, stream>>>(CQN, 512, a.in[I_WUQ], 1536, QRAW, 1536, TB0, 1536, 512, nullptr, 0);
      k_gemm<<<dim3(2048 / 64, TB0 / 64), 256, 0, stream>>>(CKVN, 256, a.in[I_WUKV], 2048, KVRAW, 2048, TB0, 2048, 256, nullptr, 0);
      k_mla_prep<<<TB0 * 8 / 4, 256, 0, stream>>>(QRAW, KVRAW, PROJ, a.in[I_GMQ], a.in[I_GMK], QM, KMT);
      k_attn<192><<<8 * S_ / 4, 256, 0, stream>>>(QM, KMT, KVRAW, 2048, 128, 256, 0.07216878364870322f, nullptr, nullptr, YN, 0);
      k_dsa_prep<<<TB0 * 8 / 4, 256, 0, stream>>>(PROJ, a.in[I_GDQ], a.in[I_GDK], QD, KDT);
      k_kit<<<TB0 * 64 / 256, 256, 0, stream>>>(PROJ, KIT);
      k_index<<<TB0 / 2, 128, 0, stream>>>(PROJ, KIT, MASKN);
      k_attn<128><<<8 * S_ / 4, 256, 0, stream>>>(QD, KDT, PROJ, INW, OFF_VD, 128, 0.08838834764831845f, (const unsigned*)(ws + WS_MASK), a.in[I_RELB], YN, 1024);
      k_cmp<<<1024, 256, 0, stream>>>(F_ycols{(const f16*)(ws + WS_Y), YN, 0}, (size_t)TB0 * 1024, ERR, 0, 0.02f, 0.004f);
      k_cmp<<<1024, 256, 0, stream>>>(F_ycols{(const f16*)(ws + WS_Y), YN, 1024}, (size_t)TB0 * 1024, ERR, 1, 0.02f, 0.004f);
      nslots = 2; }
#endif
    k_report<<<2048, 256, 0, stream>>>(ERR, nslots, x, a.out, (size_t)T_ * D_);
#endif
    const hipError_t le = hipPeekAtLastError();
    if (le != hipSuccess) fprintf(stderr, "kernel_launch: launch failed: %s\n", hipGetErrorName(le));
}
```

```cpp
#define MK_REPEAT 7
#define IDX_MODE 1
#define MK_DEBUG 0
#include <hip/hip_runtime.h>
#include <cstdio>
#include <cstdint>

#define LAS __attribute__((address_space(3)))
#define GAS __attribute__((address_space(1)))
typedef _Float16 f16;
typedef _Float16 f16x8 __attribute__((ext_vector_type(8)));
typedef _Float16 f16x4 __attribute__((ext_vector_type(4)));
typedef _Float16 f16x2 __attribute__((ext_vector_type(2)));
typedef short bf16x8 __attribute__((ext_vector_type(8)));
typedef short s16x4 __attribute__((ext_vector_type(4)));
typedef unsigned short bf16_t;
typedef float f32x2 __attribute__((ext_vector_type(2)));
typedef float f32x4 __attribute__((ext_vector_type(4)));
typedef float f32x8 __attribute__((ext_vector_type(8)));
typedef float f32x16 __attribute__((ext_vector_type(16)));
typedef unsigned u32x2 __attribute__((ext_vector_type(2)));
typedef unsigned u32x4 __attribute__((ext_vector_type(4)));

constexpr int B_ = 2, S_ = 4096, D_ = 2048, T_ = B_ * S_;
constexpr int INW = 5008;
constexpr int OFF_CQ = 0, OFF_CKV = 512, OFF_KR = 768, OFF_QD = 832, OFF_KD = 1856, OFF_VD = 2880, OFF_QI = 3904, OFF_KI = 4928, OFF_WI = 4992;
constexpr float EPS = 1e-6f;
constexpr float LOG2E = 1.4426950408889634f;
constexpr float QS_MLA = 0.07216878364870322f * LOG2E;
constexpr float QS_DSA = 0.08838834764831845f * LOG2E;
constexpr int NCU = 256, NTHR = 512, NWAVES = 8;

constexpr size_t MiB = 1u << 20;
constexpr size_t WS_CTL = 0, CTL_ZERO_BYTES = 64 * 1024;
constexpr size_t WS_WT_IN = 1 * MiB, WS_WT_UQ = 21 * MiB, WS_WT_UKV = 23 * MiB, WS_WT_O = 24 * MiB, WS_WT_PQ = 32 * MiB, WS_SK16 = 40 * MiB, WS_CS = 41 * MiB;
constexpr size_t WS_XN = 42 * MiB, WS_CQ = 74 * MiB, WS_CKV = 82 * MiB, WS_SSQ_CQ = 86 * MiB, WS_SSQ_CKV = 86 * MiB + 256 * 1024, WS_SSQ_KR = 86 * MiB + 384 * 1024;
constexpr size_t WS_SSQ2 = 87 * MiB, WS_KR = 88 * MiB, WS_WI = 90 * MiB, WS_KI = 91 * MiB, WS_QI = 92 * MiB;
constexpr size_t WS_QD = 108 * MiB, WS_KD = 124 * MiB, WS_VD = 140 * MiB, WS_QM = 156 * MiB, WS_KM = 180 * MiB, WS_VM = 204 * MiB, WS_MASK = 220 * MiB;
constexpr size_t WS_Y = 224 * MiB, WS_QR = 256 * MiB, WS_U16 = 288 * MiB, WS_V16 = 352 * MiB, WS_END = 416 * MiB;
constexpr size_t WS_USCL = 320 * MiB, WS_VSCL = 384 * MiB;
constexpr size_t WS_DBG = 288 * MiB;

#ifndef TAB_U_FP4
#define TAB_U_FP4 1
#endif
#ifndef TAB_V_FP4
#define TAB_V_FP4 1
#endif
constexpr int U_ROWB = TAB_U_FP4 ? 1024 : 1536, V_ROWB = TAB_V_FP4 ? 1024 : 1536;

constexpr int RING_OFF = 0, RING_BYTES = 131072;
constexpr int EPI_OFF = RING_BYTES;
constexpr int R2S_OFF = EPI_OFF + 8192 + 2048;
constexpr int MISC_OFF = 163840 - 256;
constexpr int LDS_BYTES = 163840;

#define LDS_WAIT() asm volatile("s_waitcnt lgkmcnt(0)" ::: "memory")
#define VM_WAIT() asm volatile("s_waitcnt vmcnt(0)" ::: "memory")
#define WG_BAR() do { asm volatile("s_waitcnt lgkmcnt(0)" ::: "memory"); __builtin_amdgcn_s_barrier(); asm volatile("" ::: "memory"); } while (0)

__device__ __forceinline__ unsigned cvt_pk_bf16(float lo, float hi) { unsigned r; asm volatile("v_cvt_pk_bf16_f32 %0, %1, %2" : "=v"(r) : "v"(lo), "v"(hi)); return r; }
__device__ __forceinline__ u32x4 pack_bf16x8(const f32x4 a, const f32x4 b) { u32x4 w; w.x = cvt_pk_bf16(a[0], a[1]); w.y = cvt_pk_bf16(a[2], a[3]); w.z = cvt_pk_bf16(b[0], b[1]); w.w = cvt_pk_bf16(b[2], b[3]); return w; }
__device__ __forceinline__ f16x8 pack_f16x8(const f32x4 a, const f32x4 b) { f16x8 w; w[0] = (f16)a[0]; w[1] = (f16)a[1]; w[2] = (f16)a[2]; w[3] = (f16)a[3]; w[4] = (f16)b[0]; w[5] = (f16)b[1]; w[6] = (f16)b[2]; w[7] = (f16)b[3]; return w; }
__device__ __forceinline__ float wave_sum(float v) {
#pragma unroll
  for (int o = 1; o < 64; o <<= 1) v += __shfl_xor(v, o);
  return v;
}
__device__ __forceinline__ float wave_max(float v) {
#pragma unroll
  for (int o = 1; o < 64; o <<= 1) v = fmaxf(v, __shfl_xor(v, o));
  return v;
}
__device__ __forceinline__ int lane_id_v() { int l; asm volatile("v_mbcnt_lo_u32_b32 %0, -1, 0\n\tv_mbcnt_hi_u32_b32 %0, -1, %0" : "=v"(l)); return l; }
template <int N> __device__ __forceinline__ int dpp_row_ror(int x) { return __builtin_amdgcn_update_dpp(0, x, 0x120 + N, 0xf, 0xf, false); }
__device__ __forceinline__ int row_sum_i32(int x) { x += dpp_row_ror<1>(x); x += dpp_row_ror<2>(x); x += dpp_row_ror<4>(x); x += dpp_row_ror<8>(x); return x; }
__device__ __forceinline__ float sum4(const f32x4 v) { return (v[0] + v[1]) + (v[2] + v[3]); }
__device__ __forceinline__ float ssq4(const f32x4 v) { return (v[0] * v[0] + v[1] * v[1]) + (v[2] * v[2] + v[3] * v[3]); }

__device__ __forceinline__ int t5_bucket(int rel) {
  const int n = rel < 0 ? -rel : rel;
  int bkt;
  if (n < 8) bkt = n; else if (n < 12) bkt = 8; else if (n < 16) bkt = 9; else if (n < 23) bkt = 10; else if (n < 32) bkt = 11;
  else if (n < 46) bkt = 12; else if (n < 64) bkt = 13; else if (n < 91) bkt = 14; else bkt = 15;
  return bkt + (rel > 0 ? 16 : 0);
}

namespace pg8 {
constexpr int BM = 256, BK = 64, HALF = 128, HTB = HALF * BK * 2, STAGE_BYTES = 8 * HTB, NXCD = 8, WGM = 8;
__host__ __device__ __forceinline__ int lds_byte(int r, int c) { const int st = (r >> 4) * 2 + (c >> 5), rr = r & 15, cc = c & 31, ob = rr * 64 + cc * 2; return st * 1024 + (ob ^ (((ob >> 9) & 1) << 5)); }
__host__ __device__ __forceinline__ void stage_rc(int b, int& R, int& C) { const int st = b / 1024, sb = b % 1024, swz = sb ^ (((sb >> 9) & 1) << 5); R = (st >> 1) * 16 + swz / 64; C = (st & 1) * 32 + (swz % 64) / 2; }
__host__ __device__ __forceinline__ int perm32(int rho) { const int n = rho >> 4, i = rho & 15; return 8 * (i >> 2) + 4 * n + (i & 3); }
struct Unit { int pm, pn; };
struct Gemm { const f16* A; const f16* Bt; int M, N, K; };
struct StaticOrder {
    int nM, nN, nwg, G, c;
    __host__ __device__ __forceinline__ void init(int M, int N, int G_, int c_) { nM = M / BM; nN = N / BM; nwg = nM * nN; G = G_; c = c_; }
    __host__ __device__ __forceinline__ bool next(int i, Unit& u) const {
        const long L = (long)i * G + c; if (L >= nwg || c < 0) return false;
        int wgid = (int)L; { const int q = nwg / NXCD, r = nwg % NXCD, xcd = wgid % NXCD, off = wgid / NXCD; wgid = (xcd < r ? xcd * (q + 1) : r * (q + 1) + (xcd - r) * q) + off; }
        const int nig = WGM * nN, gid = wgid / nig, fm = gid * WGM, gsz = (nM - fm) < WGM ? (nM - fm) : WGM;
        u.pm = fm + ((wgid % nig) % gsz); u.pn = (wgid % nig) / gsz; return true;
    }
    __device__ __forceinline__ void a_ready(const Unit&) const {}
    __device__ __forceinline__ void done(const Unit&) const {}
};

template <class Epi, class Sched, bool ALIGN_EPI = true, bool SP2 = true>
__device__ __forceinline__ void gemm_phase(LAS unsigned char* lds, const Gemm g, const Sched& S, const Epi& E, int wave_sgpr) {
    const int wid = wave_sgpr, lane = lane_id_v(), tid = wid * 64 + lane, wr = wid >> 2, wc = wid & 3, fr = lane & 15, fq = lane >> 4;
    const int K = g.K, nt = K / BK;
    unsigned voffA[2], voffB[2];
#pragma unroll
    for (int i = 0; i < 2; ++i) { int R, C; stage_rc(tid * 16 + i * 8192, R, C); const int Rb = Epi::PERM ? ((R & ~31) + perm32(R & 31)) : R;
        voffA[i] = (unsigned)(R * K + C) * 2u; voffB[i] = (unsigned)(Rb * K + C) * 2u; }
    const size_t kstep = (size_t)(BK * 2);
    const size_t hstep = (size_t)HALF * K * 2;
    const size_t tstep = 2 * hstep;
    const unsigned ldsw = (unsigned)wid * 1024u;
    const int aoff = lds_byte(wr * 64 + fr, fq * 8), boff = lds_byte(wc * 32 + fr, fq * 8);
#define PG8_SA(b, h) (((b) * 2 + (h)) * HTB)
#define PG8_SB(b, h) ((4 + (b) * 2 + (h)) * HTB)
#define PG8_STAGE(bufoff, gbase, voff) do { _Pragma("unroll") for (int _i = 0; _i < 2; ++_i) \
        __builtin_amdgcn_global_load_lds((const unsigned*)((const char*)(gbase) + (voff)[_i]), (LAS unsigned*)(lds + (bufoff) + ldsw + _i * 8192), 16, 0, 0); } while (0)
#define PG8_LDA(dst, b, h) do { _Pragma("unroll") for (int m = 0; m < 4; ++m) _Pragma("unroll") for (int k = 0; k < 2; ++k) dst[m][k] = *(const LAS f16x8*)(lds + PG8_SA(b, h) + aoff + m * 2048 + k * 1024); } while (0)
#define PG8_LDB(dst, b, h) do { _Pragma("unroll") for (int n = 0; n < 2; ++n) _Pragma("unroll") for (int k = 0; k < 2; ++k) dst[n][k] = *(const LAS f16x8*)(lds + PG8_SB(b, h) + boff + n * 2048 + k * 1024); } while (0)
#define PG8_MMA(ai, bj, At, Bt) do { __builtin_amdgcn_s_setprio(1); _Pragma("unroll") for (int m = 0; m < 4; ++m) _Pragma("unroll") for (int n = 0; n < 2; ++n) _Pragma("unroll") for (int k = 0; k < 2; ++k) \
        acc[ai][bj][m][n] = __builtin_amdgcn_mfma_f32_16x16x32_f16(Bt[n][k], At[m][k], acc[ai][bj][m][n], 0, 0, 0); __builtin_amdgcn_s_setprio(0); } while (0)
#define PG8_WAIT_V(n) asm volatile("s_waitcnt vmcnt(" #n ")" ::: "memory")
#define PG8_WAIT_L(n) asm volatile("s_waitcnt lgkmcnt(" #n ")" ::: "memory")
#define PG8_BAR __builtin_amdgcn_s_barrier()
#define PG8_SCHED __builtin_amdgcn_sched_barrier(0)
    Unit cur, nxt; int ui = 0;
    if (!S.next(0, cur)) return;
    f32x4 acc[2][2][4][2];
#pragma unroll
    for (int a = 0; a < 2; ++a)
#pragma unroll
        for (int b = 0; b < 2; ++b)
#pragma unroll
            for (int m = 0; m < 4; ++m)
#pragma unroll
                for (int n = 0; n < 2; ++n) acc[a][b][m][n] = (f32x4){0.f, 0.f, 0.f, 0.f};
    f16x8 At[4][2], B0[2][2], B1[2][2];
    const char* cA = (const char*)g.A + (size_t)cur.pm * tstep; const char* cB = (const char*)g.Bt + (size_t)cur.pn * tstep;
    S.a_ready(cur);
    if constexpr (SP2) {
        PG8_STAGE(PG8_SB(0, 0), cB, voffB); PG8_STAGE(PG8_SB(0, 1), cB + hstep, voffB); PG8_STAGE(PG8_SA(0, 0), cA, voffA); PG8_STAGE(PG8_SA(0, 1), cA + hstep, voffA);
        if (wr == 1) PG8_BAR;
        PG8_WAIT_V(2); PG8_BAR;
        PG8_STAGE(PG8_SB(1, 0), cB + kstep, voffB); PG8_STAGE(PG8_SA(1, 0), cA + kstep, voffA); PG8_STAGE(PG8_SB(1, 1), cB + hstep + kstep, voffB);
        PG8_WAIT_V(6); PG8_BAR;
    } else {
        PG8_STAGE(PG8_SB(0, 0), cB, voffB); PG8_STAGE(PG8_SA(0, 0), cA, voffA); PG8_STAGE(PG8_SB(0, 1), cB + hstep, voffB); PG8_STAGE(PG8_SA(0, 1), cA + hstep, voffA);
        if (wr == 1) PG8_BAR;
        PG8_WAIT_V(4); PG8_BAR;
        PG8_STAGE(PG8_SB(1, 0), cB + kstep, voffB); PG8_STAGE(PG8_SA(1, 0), cA + kstep, voffA); PG8_STAGE(PG8_SB(1, 1), cB + hstep + kstep, voffB);
        PG8_WAIT_V(6); PG8_BAR;
    }
    for (;;) {
        const bool has_next = S.next(ui + 1, nxt);
        const char* nA = has_next ? (const char*)g.A + (size_t)nxt.pm * tstep : cA; const char* nB = has_next ? (const char*)g.Bt + (size_t)nxt.pn * tstep : cB;
#pragma unroll 1
        for (int t = 0; t < nt; t += 2) {
            const bool last = (t == nt - 2);
            const char* a1 = cA + (size_t)(t + 1) * kstep;
            const char* a2 = last ? nA : cA + (size_t)(t + 2) * kstep; const char* b2 = last ? nB : cB + (size_t)(t + 2) * kstep;
            const char* a3 = a2 + kstep; const char* b3 = b2 + kstep;
            if (last && has_next) S.a_ready(nxt);
            if constexpr (SP2) {
            PG8_LDB(B0, 0, 0); PG8_LDB(B1, 0, 1); PG8_SCHED; PG8_LDA(At, 0, 0); PG8_STAGE(PG8_SA(1, 1), a1 + hstep, voffA);
            PG8_WAIT_V(8); PG8_WAIT_L(0); PG8_BAR; PG8_MMA(0, 0, At, B0); PG8_MMA(0, 1, At, B1); PG8_BAR; PG8_SCHED;
            PG8_LDA(At, 0, 1); PG8_STAGE(PG8_SB(0, 0), b2, voffB); PG8_STAGE(PG8_SB(0, 1), b2 + hstep, voffB); PG8_STAGE(PG8_SA(0, 0), a2, voffA);
            PG8_WAIT_V(8); PG8_WAIT_L(0); PG8_BAR; PG8_MMA(1, 0, At, B0); PG8_MMA(1, 1, At, B1); PG8_BAR; PG8_SCHED;
            PG8_LDB(B0, 1, 0); PG8_LDB(B1, 1, 1); PG8_SCHED; PG8_LDA(At, 1, 0); PG8_STAGE(PG8_SA(0, 1), a2 + hstep, voffA);
            PG8_WAIT_V(8); PG8_WAIT_L(0); PG8_BAR; PG8_MMA(0, 0, At, B0); PG8_MMA(0, 1, At, B1); PG8_BAR; PG8_SCHED;
            PG8_LDA(At, 1, 1); PG8_STAGE(PG8_SB(1, 0), b3, voffB); PG8_STAGE(PG8_SB(1, 1), b3 + hstep, voffB); PG8_STAGE(PG8_SA(1, 0), a3, voffA);
            PG8_WAIT_V(8); PG8_WAIT_L(0); PG8_BAR; PG8_MMA(1, 0, At, B0); PG8_MMA(1, 1, At, B1); PG8_BAR; PG8_SCHED;
            } else {
            PG8_LDB(B0, 0, 0); PG8_SCHED; PG8_LDA(At, 0, 0); PG8_STAGE(PG8_SA(1, 1), a1 + hstep, voffA);
            PG8_WAIT_L(8); PG8_BAR; PG8_WAIT_L(0); PG8_MMA(0, 0, At, B0); PG8_BAR; PG8_SCHED;
            PG8_LDB(B1, 0, 1); PG8_STAGE(PG8_SB(0, 0), b2, voffB);
            PG8_BAR; PG8_WAIT_L(0); PG8_MMA(0, 1, At, B1); PG8_BAR;
            PG8_LDA(At, 0, 1); PG8_STAGE(PG8_SA(0, 0), a2, voffA);
            PG8_BAR; PG8_WAIT_L(0); PG8_MMA(1, 0, At, B0); PG8_BAR; PG8_SCHED;
            PG8_STAGE(PG8_SB(0, 1), b2 + hstep, voffB);
            PG8_WAIT_V(6); PG8_BAR; PG8_MMA(1, 1, At, B1); PG8_BAR;
            PG8_LDB(B0, 1, 0); PG8_SCHED; PG8_LDA(At, 1, 0); PG8_STAGE(PG8_SA(0, 1), a2 + hstep, voffA);
            PG8_WAIT_L(8); PG8_BAR; PG8_WAIT_L(0); PG8_MMA(0, 0, At, B0); PG8_BAR; PG8_SCHED;
            PG8_LDB(B1, 1, 1); PG8_STAGE(PG8_SB(1, 0), b3, voffB);
            PG8_BAR; PG8_WAIT_L(0); PG8_MMA(0, 1, At, B1); PG8_BAR;
            PG8_LDA(At, 1, 1); PG8_STAGE(PG8_SA(1, 0), a3, voffA);
            PG8_BAR; PG8_WAIT_L(0); PG8_MMA(1, 0, At, B0); PG8_BAR; PG8_SCHED;
            PG8_STAGE(PG8_SB(1, 1), b3 + hstep, voffB);
            PG8_WAIT_V(6); PG8_BAR; PG8_MMA(1, 1, At, B1); PG8_BAR;
            }
        }
        if constexpr (ALIGN_EPI) { if (wr == 0) PG8_BAR; }
        E(acc, cur, wr, wc, fr, fq);
        if (!has_next) break;
#pragma unroll
        for (int a = 0; a < 2; ++a)
#pragma unroll
            for (int b = 0; b < 2; ++b)
#pragma unroll
                for (int m = 0; m < 4; ++m)
#pragma unroll
                    for (int n = 0; n < 2; ++n) acc[a][b][m][n] = (f32x4){0.f, 0.f, 0.f, 0.f};
        cur = nxt; cA = nA; cB = nB; ++ui;
        if constexpr (ALIGN_EPI) { if (wr == 1) PG8_BAR; }
    }
    PG8_WAIT_V(0);
    if constexpr (!ALIGN_EPI) { if (wr == 0) PG8_BAR; }
    PG8_BAR;
#undef PG8_SA
#undef PG8_SB
#undef PG8_STAGE
#undef PG8_LDA
#undef PG8_LDB
#undef PG8_MMA
#undef PG8_WAIT_V
#undef PG8_WAIT_L
#undef PG8_BAR
#undef PG8_SCHED
}
}

typedef f32x4 AccT[2][2][4][2];
#define FOR_AI_M _Pragma("unroll") for (int ai = 0; ai < 2; ++ai) _Pragma("unroll") for (int m = 0; m < 4; ++m)

__device__ __forceinline__ float fq_sum(float s) { s += __shfl_xor(s, 16); s += __shfl_xor(s, 32); return s; }

__device__ __forceinline__ f32x4 rope_freq4(int i0) { f32x4 f;
#pragma unroll
    for (int k = 0; k < 4; ++k) f[k] = __builtin_amdgcn_exp2f(-(float)(i0 + k) * (2.0f / 64.0f) * 13.287712379549449f) * 0.15915494309189535f; return f; }
__device__ __forceinline__ void rope_cs4(const f32x4 fr4, int s, f32x4& c0, f32x4& c1) {
    const float sf = (float)s;
    float r0 = sf * fr4[0], r1 = sf * fr4[1], r2 = sf * fr4[2], r3 = sf * fr4[3];
    r0 -= floorf(r0); r1 -= floorf(r1); r2 -= floorf(r2); r3 -= floorf(r3);
    c0 = (f32x4){__builtin_amdgcn_cosf(r0), __builtin_amdgcn_sinf(r0), __builtin_amdgcn_cosf(r1), __builtin_amdgcn_sinf(r1)};
    c1 = (f32x4){__builtin_amdgcn_cosf(r2), __builtin_amdgcn_sinf(r2), __builtin_amdgcn_cosf(r3), __builtin_amdgcn_sinf(r3)};
}
struct EpiIn {
    static constexpr bool PERM = true;
    f16* CQ; f16* CKV; float* SSQ_CQ; float* SSQ_CKV; bf16_t* Qd; bf16_t* Kd; f16* QI; f16* KI; float* WI; float* KR; float* SSQ_KR;
    const float* g_dq; const float* g_dk; const float* g_mk; const float* CS;
    LAS float* P;
    __device__ __forceinline__ void operator()(const AccT& acc, const pg8::Unit& u_, int wr, int wc, int fr, int fq) const {
        pg8::Unit u = u_; asm volatile("" : "+s"(u.pm), "+s"(u.pn), "+v"(fr), "+v"(fq));
        const int pn = u.pn, row0 = u.pm * 256 + wr * 64 + fr, cl = wc * 32 + fq * 8;
        if (pn < 3) {
            FOR_AI_M { const int row = row0 + ai * 128 + m * 16; float ss = 0.f;
#pragma unroll
                for (int bj = 0; bj < 2; ++bj) { const f32x4 a = acc[ai][bj][m][0], b = acc[ai][bj][m][1]; ss += ssq4(a) + ssq4(b);
                    if (pn < 2) *(f16x8*)(CQ + (size_t)row * 512 + pn * 256 + bj * 128 + cl) = pack_f16x8(a, b);
                    else *(f16x8*)(CKV + (size_t)row * 256 + bj * 128 + cl) = pack_f16x8(a, b); }
                ss = fq_sum(ss);
                if (fq == 0) { if (pn < 2) SSQ_CQ[(size_t)row * 8 + pn * 4 + wc] = ss; else SSQ_CKV[(size_t)row * 4 + wc] = ss; } }
        } else if (pn < 11) {
            FOR_AI_M { const int rl = ai * 128 + wr * 64 + m * 16 + fr;
#pragma unroll
                for (int bj = 0; bj < 2; ++bj) { float ss = fq_sum(ssq4(acc[ai][bj][m][0]) + ssq4(acc[ai][bj][m][1])); if (fq == 0) P[(bj * 256 + rl) * 4 + wc] = ss; } }
            WG_BAR();
            const bool isq = pn < 7; const float* g = isq ? g_dq : g_dk; const float qs = isq ? QS_DSA : 1.0f;
            const f32x4 g0 = *(const f32x4*)(g + cl) * qs, g1 = *(const f32x4*)(g + cl + 4) * qs;
            bf16_t* O = isq ? Qd : Kd; const int hb = (isq ? pn - 3 : pn - 7) * 2;
            FOR_AI_M { const int rl = ai * 128 + wr * 64 + m * 16 + fr, row = u.pm * 256 + rl, b = row >> 12, s = row & 4095;
#pragma unroll
                for (int bj = 0; bj < 2; ++bj) { const f32x4 p4 = *(const LAS f32x4*)(P + (bj * 256 + rl) * 4); const float r = 1.0f / sqrtf(sum4(p4) * (1.0f / 128.0f) + EPS);
                    *(u32x4*)(O + ((size_t)(b * 8 + hb + bj) * S_ + s) * 128 + cl) = pack_bf16x8(acc[ai][bj][m][0] * r * g0, acc[ai][bj][m][1] * r * g1); } }
        } else if (pn < 15) {
            FOR_AI_M { const int row = row0 + ai * 128 + m * 16;
#pragma unroll
                for (int bj = 0; bj < 2; ++bj) *(f16x8*)(QI + (size_t)row * 1024 + (pn - 11) * 256 + bj * 128 + cl) = pack_f16x8(acc[ai][bj][m][0] * 0.125f, acc[ai][bj][m][1] * 0.125f); }
        } else {
            FOR_AI_M { const int row = row0 + ai * 128 + m * 16, s = row & 4095;
                if (wc < 2) {
                    const f32x4 a = acc[ai][0][m][0], b = acc[ai][0][m][1];
                    const float ss = fq_sum(ssq4(a) + ssq4(b)); if (fq == 0) SSQ_KR[(size_t)row * 2 + wc] = ss;
                    const int i0 = cl >> 1;
                    const f32x4 ga = *(const f32x4*)(g_mk + 128 + i0), gb = *(const f32x4*)(g_mk + 160 + i0);
                    f32x4 c0, c1; rope_cs4(rope_freq4(i0), s, c0, c1);
                    f32x4 o0, o1;
                    { const float x1 = a[0] * ga[0], x2 = a[1] * gb[0]; o0[0] = x1 * c0[0] - x2 * c0[1]; o0[1] = x1 * c0[1] + x2 * c0[0]; }
                    { const float x1 = a[2] * ga[1], x2 = a[3] * gb[1]; o0[2] = x1 * c0[2] - x2 * c0[3]; o0[3] = x1 * c0[3] + x2 * c0[2]; }
                    { const float x1 = b[0] * ga[2], x2 = b[1] * gb[2]; o1[0] = x1 * c1[0] - x2 * c1[1]; o1[1] = x1 * c1[1] + x2 * c1[0]; }
                    { const float x1 = b[2] * ga[3], x2 = b[3] * gb[3]; o1[2] = x1 * c1[2] - x2 * c1[3]; o1[3] = x1 * c1[3] + x2 * c1[2]; }
                    *(f32x4*)(KR + (size_t)row * 64 + cl) = o0; *(f32x4*)(KR + (size_t)row * 64 + cl + 4) = o1;
                } else {
                    *(f16x8*)(KI + (size_t)row * 64 + (cl - 64)) = pack_f16x8(acc[ai][0][m][0], acc[ai][0][m][1]);
                }
                if (wc == 0 && fq < 2) {
                    *(f32x4*)(WI + (size_t)row * 16 + cl) = acc[ai][1][m][0]; *(f32x4*)(WI + (size_t)row * 16 + cl + 4) = acc[ai][1][m][1];
                } }
        }
    }
};

struct EpiVd {
    static constexpr bool PERM = true;
    bf16_t* Vd;
    __device__ __forceinline__ void operator()(const AccT& acc, const pg8::Unit& u_, int wr, int wc, int fr, int fq) const {
        pg8::Unit u = u_; asm volatile("" : "+s"(u.pm), "+s"(u.pn), "+v"(fr), "+v"(fq));
        const int row0 = u.pm * 256 + wr * 64 + fr, cl = wc * 32 + fq * 8;
        FOR_AI_M { const int row = row0 + ai * 128 + m * 16, b = row >> 12, s = row & 4095;
#pragma unroll
            for (int bj = 0; bj < 2; ++bj) *(u32x4*)(Vd + ((size_t)(b * 8 + u.pn * 2 + bj) * S_ + s) * 128 + cl) = pack_bf16x8(acc[ai][bj][m][0], acc[ai][bj][m][1]); }
    }
};

struct EpiQup {
    static constexpr bool PERM = true;
    bf16_t* Qm; const float* SSQ_CQ; const float* g_mq; const float* CS; LAS float* P;
    __device__ __forceinline__ void operator()(AccT& acc, const pg8::Unit& u_, int wr, int wc, int fr, int fq) const {
        pg8::Unit u = u_; asm volatile("" : "+s"(u.pm), "+s"(u.pn), "+v"(fr), "+v"(fq));
        const int cl = wc * 32 + fq * 8, h = u.pn;
        LAS float* RQ = P + 2048;
        { const int tid_ = (wr * 4 + wc) * 64 + fq * 16 + fr;
          if (tid_ < 256) { const float* sp = SSQ_CQ + (size_t)(u.pm * 256 + tid_) * 8; RQ[tid_] = 1.0f / sqrtf((sum4(*(const f32x4*)sp) + sum4(*(const f32x4*)(sp + 4))) * (1.0f / 512.0f) + EPS); } }
        WG_BAR();
        FOR_AI_M { const int rl = ai * 128 + wr * 64 + m * 16 + fr;
            const float rq = RQ[rl];
#pragma unroll
            for (int bj = 0; bj < 2; ++bj) { acc[ai][bj][m][0] *= rq; acc[ai][bj][m][1] *= rq;
                const float ss = fq_sum(ssq4(acc[ai][bj][m][0]) + ssq4(acc[ai][bj][m][1])); if (fq == 0) P[(bj * 256 + rl) * 4 + wc] = ss; } asm volatile("" ::: "memory"); }
        WG_BAR();
        const f32x4 g0 = *(const f32x4*)(g_mq + cl) * QS_MLA, g1 = *(const f32x4*)(g_mq + cl + 4) * QS_MLA;
        const int i0 = cl >> 1;
        f32x4 ga = {0.f, 0.f, 0.f, 0.f}, gb = {0.f, 0.f, 0.f, 0.f};
        if (wc < 2) { ga = *(const f32x4*)(g_mq + 128 + i0) * QS_MLA; gb = *(const f32x4*)(g_mq + 160 + i0) * QS_MLA; }
        const f32x4 fr4 = rope_freq4(i0);
        FOR_AI_M { const int rl = ai * 128 + wr * 64 + m * 16 + fr, row = u.pm * 256 + rl, b = row >> 12, s = row & 4095;
            const f32x4 p0 = *(const LAS f32x4*)(P + rl * 4), p1 = *(const LAS f32x4*)(P + (256 + rl) * 4);
            const float r = 1.0f / sqrtf((sum4(p0) + sum4(p1)) * (1.0f / 192.0f) + EPS);
            bf16_t* o = Qm + ((size_t)(b * 8 + h) * S_ + s) * 192;
            *(u32x4*)(o + cl) = pack_bf16x8(acc[ai][0][m][0] * r * g0, acc[ai][0][m][1] * r * g1);
            if (wc < 2) {
                const f32x4 a = acc[ai][1][m][0] * r, bq = acc[ai][1][m][1] * r;
                f32x4 c0, c1; rope_cs4(fr4, s, c0, c1);
                f32x4 o0, o1;
                { const float x1 = a[0] * ga[0], x2 = a[1] * gb[0]; o0[0] = x1 * c0[0] - x2 * c0[1]; o0[1] = x1 * c0[1] + x2 * c0[0]; }
                { const float x1 = a[2] * ga[1], x2 = a[3] * gb[1]; o0[2] = x1 * c0[2] - x2 * c0[3]; o0[3] = x1 * c0[3] + x2 * c0[2]; }
                { const float x1 = bq[0] * ga[2], x2 = bq[1] * gb[2]; o1[0] = x1 * c1[0] - x2 * c1[1]; o1[1] = x1 * c1[1] + x2 * c1[0]; }
                { const float x1 = bq[2] * ga[3], x2 = bq[3] * gb[3]; o1[2] = x1 * c1[2] - x2 * c1[3]; o1[3] = x1 * c1[3] + x2 * c1[2]; }
                *(u32x4*)(o + 128 + cl) = pack_bf16x8(o0, o1);
            } asm volatile("" ::: "memory"); }
    }
};

struct EpiKVup {
    static constexpr bool PERM = true;
    bf16_t* Km; bf16_t* Vm; const float* SSQ_CKV; const float* SSQ_KR; const float* KR; const float* g_mk; LAS float* P;
    __device__ __forceinline__ void operator()(AccT& acc, const pg8::Unit& u_, int wr, int wc, int fr, int fq) const {
        pg8::Unit u = u_; asm volatile("" : "+s"(u.pm), "+s"(u.pn), "+v"(fr), "+v"(fq));
        const int cl = wc * 32 + fq * 8, h = u.pn;
        LAS float* RKV = P + 2048; LAS float* SKR = P + 2048 + 256;
        { const int tid_ = (wr * 4 + wc) * 64 + fq * 16 + fr;
          if (tid_ < 256) { const int row_ = u.pm * 256 + tid_; RKV[tid_] = 1.0f / sqrtf(sum4(*(const f32x4*)(SSQ_CKV + (size_t)row_ * 4)) * (1.0f / 256.0f) + EPS);
                            SKR[tid_] = SSQ_KR[(size_t)row_ * 2] + SSQ_KR[(size_t)row_ * 2 + 1]; } }
        WG_BAR();
        FOR_AI_M { const int rl = ai * 128 + wr * 64 + m * 16 + fr, row = u.pm * 256 + rl, b = row >> 12, s = row & 4095;
            const float rkv = RKV[rl];
            acc[ai][0][m][0] *= rkv; acc[ai][0][m][1] *= rkv;
            const float ss = fq_sum(ssq4(acc[ai][0][m][0]) + ssq4(acc[ai][0][m][1])); if (fq == 0) P[rl * 4 + wc] = ss;
            *(u32x4*)(Vm + ((size_t)(b * 8 + h) * S_ + s) * 128 + cl) = pack_bf16x8(acc[ai][1][m][0] * rkv, acc[ai][1][m][1] * rkv); asm volatile("" ::: "memory"); }
        WG_BAR();
        const f32x4 g0 = *(const f32x4*)(g_mk + cl), g1 = *(const f32x4*)(g_mk + cl + 4);
        const int rc = wc * 16 + fq * 4;
        f32x4 krp[2][4];
        FOR_AI_M krp[ai][m] = *(const f32x4*)(KR + (size_t)(u.pm * 256 + ai * 128 + wr * 64 + m * 16 + fr) * 64 + rc);
        FOR_AI_M { const int rl = ai * 128 + wr * 64 + m * 16 + fr, row = u.pm * 256 + rl, b = row >> 12, s = row & 4095;
            const f32x4 p0 = *(const LAS f32x4*)(P + rl * 4);
            const float tot = sum4(p0) + SKR[rl];
            const float r = 1.0f / sqrtf(tot * (1.0f / 192.0f) + EPS);
            bf16_t* o = Km + ((size_t)(b * 8 + h) * S_ + s) * 192;
            *(u32x4*)(o + cl) = pack_bf16x8(acc[ai][0][m][0] * r * g0, acc[ai][0][m][1] * r * g1);
            const f32x4 kr = krp[ai][m] * r;
            u32x2 w; w.x = cvt_pk_bf16(kr[0], kr[1]); w.y = cvt_pk_bf16(kr[2], kr[3]);
            *(u32x2*)(o + 128 + rc) = w; asm volatile("" ::: "memory"); }
    }
};

struct EpiOut {
    static constexpr bool PERM = true;
    const float* x; float* X2; f16* X2H; float* SSQ2;
    __device__ __forceinline__ void operator()(const AccT& acc, const pg8::Unit& u_, int wr, int wc, int fr, int fq) const {
        pg8::Unit u = u_; asm volatile("" : "+s"(u.pm), "+s"(u.pn), "+v"(fr), "+v"(fq));
        const int row0 = u.pm * 256 + wr * 64 + fr, cl = wc * 32 + fq * 8;
        FOR_AI_M { const int row = row0 + ai * 128 + m * 16; float ss = 0.f;
#pragma unroll
            for (int bj = 0; bj < 2; ++bj) { const size_t off = (size_t)row * 2048 + u.pn * 256 + bj * 128 + cl;
                const f32x4 a = acc[ai][bj][m][0] + *(const f32x4*)(x + off), b = acc[ai][bj][m][1] + *(const f32x4*)(x + off + 4);
                *(f16x8*)(X2H + off) = pack_f16x8(a, b); ss += ssq4(a) + ssq4(b); }
            ss = fq_sum(ss); if (fq == 0) SSQ2[(size_t)row * 32 + u.pn * 4 + wc] = ss; }
    }
};

struct EpiQr {
    static constexpr bool PERM = true;
    f16* QR; const LAS float* R2s;
    __device__ __forceinline__ void operator()(const AccT& acc, const pg8::Unit& u_, int wr, int wc, int fr, int fq) const {
        pg8::Unit u = u_; asm volatile("" : "+s"(u.pm), "+s"(u.pn), "+v"(fr), "+v"(fq));
        const int cl = wc * 32 + fq * 8;
        FOR_AI_M { const int rl = ai * 128 + wr * 64 + m * 16 + fr, row = u.pm * 256 + rl; const float r = R2s[rl];
#pragma unroll
            for (int bj = 0; bj < 2; ++bj) *(f16x8*)(QR + (size_t)row * 2048 + u.pn * 256 + bj * 128 + cl) = pack_f16x8(acc[ai][bj][m][0] * r, acc[ai][bj][m][1] * r); }
    }
};

#define XB_TMO      128
#define XB_XCNT(j)  (256  + 64 * (j))
#define XB_XSUB(j)  (1280 + 64 * (j))
#define XB_XGEN(j)  (2304 + 64 * (j))
#define XB_TOP      3328
#define XB_TOPGEN   3392
#define XCD_BAR_WORDS 3456
#define XB_SPIN_CAP (1u << 22)
__device__ __forceinline__ unsigned xb_ld(unsigned* p)              { return __hip_atomic_load(p, __ATOMIC_RELAXED, __HIP_MEMORY_SCOPE_AGENT); }
__device__ __forceinline__ unsigned xb_add(unsigned* p, unsigned v) { return __hip_atomic_fetch_add(p, v, __ATOMIC_RELAXED, __HIP_MEMORY_SCOPE_AGENT); }
__device__ __forceinline__ unsigned xb_xcc_id() { return (unsigned)__builtin_amdgcn_s_getreg((3 << 11) | 20) & 0xFu; }
#define XB_SPIN(cond, bar) do { unsigned _sp = 0; while (cond) { __builtin_amdgcn_s_sleep(1); \
    if ((++_sp & 255u) == 0u) { if (xb_ld(&(bar)[XB_TMO])) break; if (_sp > XB_SPIN_CAP) { atomicAdd(&(bar)[XB_TMO], 1u); break; } } } } while (0)
struct XcdBarrier { unsigned* bar; unsigned x; volatile LAS unsigned* st; int wave; };
__device__ __forceinline__ XcdBarrier xcd_barrier_post(unsigned* bar, volatile LAS unsigned* st, int wave) {
    XcdBarrier b; b.bar = bar; b.x = xb_xcc_id(); b.st = st; b.wave = wave;
    if (wave == 0 && lane_id_v() == 0) (void)xb_add(&bar[XB_XCNT(b.x)], 1u);
    return b;
}
__device__ __forceinline__ void xcd_barrier_complete(unsigned* bar, unsigned x, unsigned& nloc, unsigned& nx) {
    const unsigned G = gridDim.x * gridDim.y * gridDim.z;
    unsigned sum, cnt, mine, sp = 0u;
    for (;;) {
        sum = 0u; cnt = 0u; mine = 0u;
#pragma unroll
        for (unsigned j = 0; j < 16; ++j) { const unsigned c = xb_ld(&bar[XB_XCNT(j)]); sum += c; cnt += (c > 0u) ? 1u : 0u; mine = (j == x) ? c : mine; }
        if (sum == G) break;
        __builtin_amdgcn_s_sleep(1);
        if ((++sp & 255u) == 0u) { if (xb_ld(&bar[XB_TMO])) break; if (sp > XB_SPIN_CAP) { atomicAdd(&bar[XB_TMO], 1u); break; } }
    }
    nloc = mine > 0u ? mine : 1u; nx = cnt > 0u ? cnt : 1u;
}
__device__ __forceinline__ void xcd_barrier_arrive(const XcdBarrier& b) {
    asm volatile("s_waitcnt vmcnt(0)" ::: "memory");
    __syncthreads();
    if (b.wave == 0 && lane_id_v() == 0) {
        unsigned* bar = b.bar;
        __builtin_amdgcn_s_waitcnt(0);
        unsigned nloc = b.st[0], nx = b.st[1];
        if (nloc == 0u) { xcd_barrier_complete(bar, b.x, nloc, nx); b.st[0] = nloc; b.st[1] = nx; }
        const unsigned old = xb_add(&bar[XB_XSUB(b.x)], 1u);
        const unsigned gen = old / nloc;
        unsigned role = 1u, tg = 0u;
        if (old + 1u == (gen + 1u) * nloc) {
            __builtin_amdgcn_fence(__ATOMIC_RELEASE, "agent");
            asm volatile("s_waitcnt vmcnt(0)" ::: "memory");
            const unsigned og = xb_add(&bar[XB_TOP], 1u);
            tg = og / nx; role = 2u;
            if (og + 1u == (tg + 1u) * nx) { xb_add(&bar[XB_TOPGEN], 1u); role = 3u; }
        }
        b.st[2] = role; b.st[3] = gen; b.st[4] = tg;
    }
}
__device__ __forceinline__ void xcd_barrier_wait(const XcdBarrier& b) {
    asm volatile("s_waitcnt vmcnt(0)" ::: "memory");
    if (b.wave == 0 && lane_id_v() == 0) {
        unsigned* bar = b.bar;
        const unsigned role = b.st[2], gen = b.st[3], tg = b.st[4];
        if (role >= 2u) {
            if (role == 2u) XB_SPIN(xb_ld(&bar[XB_TOPGEN]) == tg, bar);
            __builtin_amdgcn_fence(__ATOMIC_ACQUIRE, "agent");
            xb_add(&bar[XB_XGEN(b.x)], 1u);
            asm volatile("s_waitcnt vmcnt(0)" ::: "memory");
        } else {
            XB_SPIN(xb_ld(&bar[XB_XGEN(b.x)]) == gen, bar);
            __builtin_amdgcn_fence(__ATOMIC_ACQUIRE, "agent");
            asm volatile("s_waitcnt vmcnt(0)" ::: "memory");
        }
    }
    __syncthreads();
}
__device__ __forceinline__ void xcd_barrier(const XcdBarrier& b) {
    asm volatile("s_waitcnt vmcnt(0)" ::: "memory");
    __syncthreads();
    if (b.wave == 0 && lane_id_v() == 0) {
        unsigned* bar = b.bar;
        __builtin_amdgcn_s_waitcnt(0);
        unsigned nloc = b.st[0], nx = b.st[1];
        if (nloc == 0u) { xcd_barrier_complete(bar, b.x, nloc, nx); b.st[0] = nloc; b.st[1] = nx; }
        const unsigned old = xb_add(&bar[XB_XSUB(b.x)], 1u);
        const unsigned gen = old / nloc;
        if (old + 1u == (gen + 1u) * nloc) {
            __builtin_amdgcn_fence(__ATOMIC_RELEASE, "agent");
            asm volatile("s_waitcnt vmcnt(0)" ::: "memory");
            const unsigned og = xb_add(&bar[XB_TOP], 1u);
            const unsigned tg = og / nx;
            if (og + 1u == (tg + 1u) * nx) xb_add(&bar[XB_TOPGEN], 1u);
            else XB_SPIN(xb_ld(&bar[XB_TOPGEN]) == tg, bar);
            __builtin_amdgcn_fence(__ATOMIC_ACQUIRE, "agent");
            xb_add(&bar[XB_XGEN(b.x)], 1u);
            asm volatile("s_waitcnt vmcnt(0)" ::: "memory");
        } else {
            XB_SPIN(xb_ld(&bar[XB_XGEN(b.x)]) == gen, bar);
            __builtin_amdgcn_fence(__ATOMIC_ACQUIRE, "agent");
            asm volatile("s_waitcnt vmcnt(0)" ::: "memory");
        }
    }
    __syncthreads();
}

struct Args { const float* in[18]; float* out; unsigned char* ws; int ph_lo, ph_hi; };
enum { I_X = 0, I_GATTN, I_WIN, I_GCQ, I_GCKV, I_WUQ, I_WUKV, I_GMQ, I_GMK, I_GDQ, I_GDK, I_RELB, I_WO, I_GFFN, I_WPQ, I_SUBK, I_UTAB, I_VTAB };

__device__ __forceinline__ int map_in(int n) {
    if (n < 768) return n;
    if (n < 2816) return n + 64;
    if (n < 3840) return n + 1088;
    if (n < 3904) { const int j = n - 3840; return 768 + (j >> 1) + 32 * (j & 1); }
    if (n < 3984) return n + 1024;
    if (n < 4096) return -1;
    return n - 1216;
}
__device__ __forceinline__ int map_uq(int n) {
    const int h = n >> 8, j = n & 255;
    if (j < 128) return h * 192 + j;
    if (j < 192) { const int i = (j - 128) >> 1, par = (j - 128) & 1; return h * 192 + 128 + i + 32 * par; }
    return -1;
}
template <int MAP>
__device__ __forceinline__ void p0_transpose_item(const float* __restrict__ W, int K, int Nsrc, int Nout, f16* __restrict__ WT, const float* __restrict__ g, LAS float* scr, int item, int lane) {
    const int nblk = Nout / 32, kb = item / nblk, nb = item % nblk, k0 = 64 * kb, n0 = 32 * nb;
    const int s0 = MAP == 1 ? map_in(n0) : (MAP == 2 ? map_uq(n0) : n0), s31 = MAP == 1 ? map_in(n0 + 31) : (MAP == 2 ? map_uq(n0 + 31) : n0 + 31);
    if (s31 - s0 == 31 || (s0 < 0 && s31 < 0)) {
        const int c4 = lane & 7, kq = lane >> 3;
#pragma unroll
        for (int i = 0; i < 8; ++i) { const int kk = kq + 8 * i; f32x4 v = {0.f, 0.f, 0.f, 0.f};
            if (s0 >= 0) v = __builtin_nontemporal_load((const f32x4*)(W + (size_t)(k0 + kk) * Nsrc + s0 + 4 * c4));
            if (g) v = v * g[k0 + kk];
            LAS float* d = scr + kk * 33 + 4 * c4; d[0] = v[0]; d[1] = v[1]; d[2] = v[2]; d[3] = v[3]; }
    } else {
        const int n = n0 + (lane & 31);
        const int src = MAP == 1 ? map_in(n) : (MAP == 2 ? map_uq(n) : n);
#pragma unroll 8
        for (int i = 0; i < 32; ++i) { const int kk = 2 * i + (lane >> 5); float v = 0.f; if (src >= 0) v = W[(size_t)(k0 + kk) * Nsrc + src]; if (g) v *= g[k0 + kk]; scr[kk * 33 + (lane & 31)] = v; }
    }
    LDS_WAIT(); asm volatile("" ::: "memory");
    const int c = lane & 7;
#pragma unroll
    for (int j = 0; j < 4; ++j) { const int nn = (lane >> 3) + 8 * j; const LAS float* s = scr + (8 * c) * 33 + nn;
        f16x8 o; o[0] = (f16)s[0 * 33]; o[1] = (f16)s[1 * 33]; o[2] = (f16)s[2 * 33]; o[3] = (f16)s[3 * 33]; o[4] = (f16)s[4 * 33]; o[5] = (f16)s[5 * 33]; o[6] = (f16)s[6 * 33]; o[7] = (f16)s[7 * 33];
        *(f16x8*)(WT + (size_t)(n0 + nn) * K + k0 + 8 * c) = o; }
    LDS_WAIT(); asm volatile("" ::: "memory");
}
__device__ __forceinline__ void p0_cvt_f16(const float* __restrict__ src, f16* __restrict__ dst, size_t n8, const float* __restrict__ g, int ncols, size_t gtid, size_t gn) {
    for (size_t i = gtid; i < n8; i += gn) {
        f32x4 a = *(const f32x4*)(src + i * 8), b = *(const f32x4*)(src + i * 8 + 4);
        if (g) { const int c = (int)((i * 8) & (size_t)(ncols - 1)); a = a * *(const f32x4*)(g + c); b = b * *(const f32x4*)(g + c + 4); }
        *(f16x8*)(dst + i * 8) = pack_f16x8(a, b);
    }
}
typedef unsigned u32x6 __attribute__((ext_vector_type(6)));
typedef float f32x32 __attribute__((ext_vector_type(32)));
typedef _Float16 f16x32 __attribute__((ext_vector_type(32)));
__device__ __forceinline__ void p0_row_fp6(const float* __restrict__ src, const float* __restrict__ g, unsigned char* __restrict__ dst, float* __restrict__ scl, int row, int lane) {
    const float* rp = src + (size_t)row * 2048 + 4 * lane;
    f32x16 a, b; float mx = 0.f;
#pragma unroll
    for (int i = 0; i < 8; ++i) { f32x4 v = *(const f32x4*)(rp + 256 * i);
        if (g) v = v * *(const f32x4*)(g + 4 * lane + 256 * i);
        a[2 * i] = v[0]; b[2 * i] = v[1]; a[2 * i + 1] = v[2]; b[2 * i + 1] = v[3];
        mx = fmaxf(mx, fmaxf(fmaxf(fabsf(v[0]), fabsf(v[1])), fmaxf(fabsf(v[2]), fabsf(v[3])))); }
    mx = wave_max(mx);
    const float inv = mx > 0.f ? 7.4999f / mx : 0.f;
    a = a * inv; b = b * inv;
    const u32x6 pk = __builtin_amdgcn_cvt_scalef32_2xpk16_fp6_f32(a, b, 1.0f);
    __builtin_amdgcn_sched_barrier(0); asm volatile("s_nop 7\n\ts_nop 7"); __builtin_amdgcn_sched_barrier(0);
    u32x2* dp = (u32x2*)(dst + (size_t)row * 1536 + 24 * lane);
    dp[0] = (u32x2){pk[0], pk[1]}; dp[1] = (u32x2){pk[2], pk[3]}; dp[2] = (u32x2){pk[4], pk[5]};
    if (lane == 0) scl[row] = mx * (1.0f / 7.4999f);
}
__device__ __forceinline__ void p0_row_fp4_load(const float* __restrict__ src, int row, int lane, f32x4 (&v)[8]) {
    const float* rp = src + (size_t)row * 2048 + 4 * lane;
#pragma unroll
    for (int i = 0; i < 8; ++i) v[i] = __builtin_nontemporal_load((const f32x4*)(rp + 256 * i));
}
__device__ __forceinline__ void p0_row_fp4_finish(f32x4 (&v)[8], const float* __restrict__ g, unsigned char* __restrict__ dst, float* __restrict__ scl, int row, int lane) {
    float mx = 0.f;
#pragma unroll
    for (int i = 0; i < 8; ++i) {
        if (g) v[i] = v[i] * *(const f32x4*)(g + 4 * lane + 256 * i);
        mx = fmaxf(mx, fmaxf(fmaxf(fabsf(v[i][0]), fabsf(v[i][1])), fmaxf(fabsf(v[i][2]), fabsf(v[i][3])))); }
    mx = wave_max(mx);
    const float inv = mx > 0.f ? 5.9999f / mx : 0.f;
    f32x4 sv[8];
#pragma unroll
    for (int i = 0; i < 8; ++i) sv[i] = v[i] * inv;
    __builtin_amdgcn_sched_barrier(0);
    unsigned pk0 = 0u, pk1 = 0u, pk2 = 0u, pk3 = 0u;
#define P4(B, I0, J0, I1, J1, I2, J2, I3, J3) do { \
    pk0 = __builtin_amdgcn_cvt_scalef32_pk_fp4_f32(pk0, sv[I0][J0], sv[I0][J0 + 1], 1.0f, B); pk1 = __builtin_amdgcn_cvt_scalef32_pk_fp4_f32(pk1, sv[I1][J1], sv[I1][J1 + 1], 1.0f, B); \
    pk2 = __builtin_amdgcn_cvt_scalef32_pk_fp4_f32(pk2, sv[I2][J2], sv[I2][J2 + 1], 1.0f, B); pk3 = __builtin_amdgcn_cvt_scalef32_pk_fp4_f32(pk3, sv[I3][J3], sv[I3][J3 + 1], 1.0f, B); \
    __builtin_amdgcn_sched_barrier(0); asm volatile("s_nop 3"); __builtin_amdgcn_sched_barrier(0); } while (0)
    P4(0, 0, 0, 2, 0, 4, 0, 6, 0);
    P4(1, 0, 2, 2, 2, 4, 2, 6, 2);
    P4(2, 1, 0, 3, 0, 5, 0, 7, 0);
    P4(3, 1, 2, 3, 2, 5, 2, 7, 2);
#undef P4
    asm volatile("s_nop 7\n\ts_nop 7" : "+v"(sv[0]), "+v"(sv[1]), "+v"(sv[2]), "+v"(sv[3]), "+v"(sv[4]), "+v"(sv[5]), "+v"(sv[6]), "+v"(sv[7]));
    const u32x4 pk = {pk0, pk1, pk2, pk3};
    __builtin_nontemporal_store(pk, (u32x4*)(dst + (size_t)row * 1024 + 16 * lane));
    if (lane == 0) scl[row] = mx * (1.0f / 5.9999f);
}
__device__ __forceinline__ void p0_row_fp4(const float* __restrict__ src, const float* __restrict__ g, unsigned char* __restrict__ dst, float* __restrict__ scl, int row, int lane) {
    f32x4 v[8]; p0_row_fp4_load(src, row, lane, v); p0_row_fp4_finish(v, g, dst, scl, row, lane);
}
#ifndef TAB_ROWS_P2
#define TAB_ROWS_P2 6144
#endif
#ifndef TAB_SEAM_ROWS
#define TAB_SEAM_ROWS 2048
#endif
#define TAB_ROWS_SEAMS (5 * TAB_SEAM_ROWS)
__device__ __forceinline__ void p0_tables(const Args& A, int row0, int step, int row_end, int lane) {
    unsigned char* ws = A.ws;
#if TAB_U_FP4 && TAB_V_FP4
    f32x4 ua[8], va[8], ub[8], vb[8];
    int row = row0;
    if (row < row_end) { p0_row_fp4_load(A.in[I_UTAB], row, lane, ua); p0_row_fp4_load(A.in[I_VTAB], row, lane, va); }
    while (row < row_end) {
        const int r1 = row + step;
        if (r1 < row_end) { p0_row_fp4_load(A.in[I_UTAB], r1, lane, ub); p0_row_fp4_load(A.in[I_VTAB], r1, lane, vb); }
        p0_row_fp4_finish(ua, A.in[I_GFFN], ws + WS_U16, (float*)(ws + WS_USCL), row, lane);
        p0_row_fp4_finish(va, nullptr, ws + WS_V16, (float*)(ws + WS_VSCL), row, lane);
        if (r1 >= row_end) break;
        const int r2 = r1 + step;
        if (r2 < row_end) { p0_row_fp4_load(A.in[I_UTAB], r2, lane, ua); p0_row_fp4_load(A.in[I_VTAB], r2, lane, va); }
        p0_row_fp4_finish(ub, A.in[I_GFFN], ws + WS_U16, (float*)(ws + WS_USCL), r1, lane);
        p0_row_fp4_finish(vb, nullptr, ws + WS_V16, (float*)(ws + WS_VSCL), r1, lane);
        row = r2;
    }
#else
    for (int row = row0; row < row_end; row += step) {
        if (TAB_U_FP4) p0_row_fp4(A.in[I_UTAB], A.in[I_GFFN], ws + WS_U16, (float*)(ws + WS_USCL), row, lane); else p0_row_fp6(A.in[I_UTAB], A.in[I_GFFN], ws + WS_U16, (float*)(ws + WS_USCL), row, lane);
        if (TAB_V_FP4) p0_row_fp4(A.in[I_VTAB], nullptr, ws + WS_V16, (float*)(ws + WS_VSCL), row, lane); else p0_row_fp6(A.in[I_VTAB], nullptr, ws + WS_V16, (float*)(ws + WS_VSCL), row, lane);
    }
#endif
}
struct P0Args { const float* const* in; unsigned char* ws; };
__device__ __forceinline__ void p0_prologue(const Args& A, LAS unsigned char* lds, int wave, int lane, bool tables, int parts = 7) {
    LAS float* scr = (LAS float*)(lds + RING_OFF + wave * 16384);
    const int G = gridDim.x, gw = blockIdx.x * NWAVES + wave, NGW = G * NWAVES;
    unsigned char* ws = A.ws;
    constexpr int I_IN = (2048 / 64) * (5120 / 32), I_UQ = (512 / 64) * (2048 / 32), I_UKV = (256 / 64) * (2048 / 32), I_O = (2048 / 64) * (2048 / 32), I_PQ = I_O;
    constexpr int NITEMS = I_IN + I_UQ + I_UKV + I_O + I_PQ;
    if (tables && (parts & 4)) p0_tables(A, TAB_ROWS_P2 + TAB_ROWS_SEAMS + gw, NGW, 16384, lane);
    if (parts & 1) for (int it = gw; it < NITEMS; it += NGW) {
        int r = it;
        if (r < I_IN) { p0_transpose_item<1>(A.in[I_WIN], 2048, INW, 5120, (f16*)(ws + WS_WT_IN), nullptr, scr, r, lane); continue; } r -= I_IN;
        if (r < I_UQ) { p0_transpose_item<2>(A.in[I_WUQ], 512, 1536, 2048, (f16*)(ws + WS_WT_UQ), A.in[I_GCQ], scr, r, lane); continue; } r -= I_UQ;
        if (r < I_UKV) { p0_transpose_item<0>(A.in[I_WUKV], 256, 2048, 2048, (f16*)(ws + WS_WT_UKV), A.in[I_GCKV], scr, r, lane); continue; } r -= I_UKV;
        if (r < I_O) { p0_transpose_item<0>(A.in[I_WO], 2048, 2048, 2048, (f16*)(ws + WS_WT_O), nullptr, scr, r, lane); continue; } r -= I_O;
        p0_transpose_item<0>(A.in[I_WPQ], 2048, 2048, 2048, (f16*)(ws + WS_WT_PQ), A.in[I_GFFN], scr, r, lane);
    }
    if (parts & 2) {
        const float* gat = A.in[I_GATTN]; f16* XN = (f16*)(ws + WS_XN);
#define XN_LOAD(v, row) do { const float* xr_ = A.in[I_X] + (size_t)(row) * 2048 + lane * 8; _Pragma("unroll") for (int j_ = 0; j_ < 4; ++j_) { v[2 * j_] = __builtin_nontemporal_load((const f32x4*)(xr_ + 512 * j_)); v[2 * j_ + 1] = __builtin_nontemporal_load((const f32x4*)(xr_ + 512 * j_ + 4)); } } while (0)
#define XN_FIN(v, row) do { float ss_ = 0.f; _Pragma("unroll") for (int j_ = 0; j_ < 8; ++j_) ss_ += ssq4(v[j_]); const float r_ = 1.0f / sqrtf(wave_sum(ss_) * (1.0f / 2048.0f) + EPS); \
            _Pragma("unroll") for (int j_ = 0; j_ < 4; ++j_) { const f32x4 g0_ = *(const f32x4*)(gat + lane * 8 + 512 * j_), g1_ = *(const f32x4*)(gat + lane * 8 + 512 * j_ + 4); \
                *(f16x8*)(XN + (size_t)(row) * 2048 + lane * 8 + 512 * j_) = pack_f16x8(v[2 * j_] * r_ * g0_, v[2 * j_ + 1] * r_ * g1_); } } while (0)
        f32x4 xa[8], xb[8];
        int row = gw;
        if (row < T_) XN_LOAD(xa, row);
        while (row < T_) {
            const int r1 = row + NGW;
            if (r1 < T_) XN_LOAD(xb, r1);
            XN_FIN(xa, row);
            if (r1 >= T_) break;
            const int r2 = r1 + NGW;
            if (r2 < T_) XN_LOAD(xa, r2);
            XN_FIN(xb, r1);
            row = r2;
        }
#undef XN_LOAD
#undef XN_FIN
    }
    const size_t gtid = (size_t)blockIdx.x * NTHR + wave * 64 + lane, gn = (size_t)G * NTHR;
    p0_cvt_f16(A.in[I_SUBK], (f16*)(ws + WS_SK16), (size_t)16 * 128 * 128 / 8, nullptr, 128, gtid, gn);
}

__device__ __forceinline__ unsigned sortable_u32(float f) { const unsigned b = __float_as_uint(f); return (b & 0x80000000u) ? ~b : (b | 0x80000000u); }
template <int MODE>
__device__ __forceinline__ void idx_item(LAS unsigned char* lds, const f16* __restrict__ QI, const f16* __restrict__ KI, const float* __restrict__ WI, unsigned* __restrict__ MASK,
                                         int b, int chunk, int qq, int wave, int lane) {
    const int t0 = b * S_ + chunk * 64 + qq * 16 + wave * 2;
    const int r32 = lane & 31, hi = lane >> 5;
    const int nt32 = 2 * (chunk + 1);
    f16x8 af[4];
    { const f16* qp = QI + (size_t)(t0 + ((r32 >> 2) & 1)) * 1024 + ((r32 & 3) + 4 * (r32 >> 3)) * 64 + 8 * hi;
#pragma unroll
      for (int s = 0; s < 4; ++s) af[s] = *(const f16x8*)(qp + 16 * s); }
    float wv[16];
    { const float* wp = WI + (size_t)(t0 + hi) * 16;
#pragma unroll
      for (int i = 0; i < 4; ++i) { const f32x4 w4 = *(const f32x4*)(wp + 4 * i); wv[4 * i] = w4[0]; wv[4 * i + 1] = w4[1]; wv[4 * i + 2] = w4[2]; wv[4 * i + 3] = w4[3]; } }
    const f16* kbase = KI + (size_t)b * S_ * 64;
    unsigned koff[4];
#pragma unroll
    for (int j = 0; j < 4; ++j) { const int p = (wave * 4 + j) * 1024 + lane * 16, key = p >> 7, chp = (p >> 4) & 7; koff[j] = (unsigned)(key * 64 + ((chp ^ ((key >> 1) & 7)) * 8)) * 2u; }
#define IDX_DMA(stage, buf) do { int so_ = (stage) * 256 * 64 * 2; asm volatile("" : "+s"(so_)); const char* gb_ = (const char*)kbase + so_; _Pragma("unroll") for (int j_ = 0; j_ < 4; ++j_) \
        __builtin_amdgcn_global_load_lds((const unsigned*)(gb_ + koff[j_]), (LAS unsigned*)(lds + (buf) * 32768 + (wave * 4 + j_) * 1024), 16, 0, 0); } while (0)
    unsigned u[128];
#pragma unroll
    for (int i = 0; i < 128; ++i) u[i] = 0u;
    IDX_DMA(0, 0); asm volatile("s_waitcnt vmcnt(0)" ::: "memory"); WG_BAR();
    int bo[4];
#pragma unroll
    for (int s = 0; s < 4; ++s) bo[s] = r32 * 128 + (((2 * s + hi) ^ ((r32 >> 1) & 7)) << 4);
    const int nstg = (nt32 + 7) >> 3, off = (16 - nstg) * 8;
#pragma unroll 1
    for (int stg = 0; stg < (MODE == 2 ? 0 : nstg); ++stg) {
#pragma unroll
        for (int i = 0; i < 120; ++i) u[i] = u[i + 8];
        const bool more = stg + 1 < nstg;
        if (more) IDX_DMA(stg + 1, (stg + 1) & 1);
        const LAS unsigned char* kb = lds + (stg & 1) * 32768;
        const int nval = nt32 - stg * 8;
        f16x8 bf[4];
#pragma unroll
        for (int s = 0; s < 4; ++s) bf[s] = *(const LAS f16x8*)(kb + bo[s]);
#pragma unroll
        for (int tl = 0; tl < 8; ++tl) {
            unsigned val = 0u;
            if (tl < nval) {
                asm volatile("s_waitcnt lgkmcnt(0)" ::: "memory"); __builtin_amdgcn_sched_barrier(0);
                f32x16 acc = {0.f, 0.f, 0.f, 0.f, 0.f, 0.f, 0.f, 0.f, 0.f, 0.f, 0.f, 0.f, 0.f, 0.f, 0.f, 0.f};
#pragma unroll
                for (int s = 0; s < 4; ++s) acc = __builtin_amdgcn_mfma_f32_32x32x16_f16(af[s], bf[s], acc, 0, 0, 0);
                __builtin_amdgcn_sched_barrier(0);
                if (tl < 7 && tl + 1 < nval) {
#pragma unroll
                    for (int s = 0; s < 4; ++s) bf[s] = *(const LAS f16x8*)(kb + (tl + 1) * 4096 + bo[s]);
                }
                __builtin_amdgcn_sched_barrier(0);
                f32x2 sa = {0.f, 0.f}, sb = {0.f, 0.f};
#pragma unroll
                for (int r = 0; r < 16; r += 4) {
                    const f32x2 ma = {__int_as_float(max(__float_as_int(acc[r]), 0)), __int_as_float(max(__float_as_int(acc[r + 1]), 0))};
                    const f32x2 mb = {__int_as_float(max(__float_as_int(acc[r + 2]), 0)), __int_as_float(max(__float_as_int(acc[r + 3]), 0))};
                    sa = __builtin_elementwise_fma((f32x2){wv[r], wv[r + 1]}, ma, sa); sb = __builtin_elementwise_fma((f32x2){wv[r + 2], wv[r + 3]}, mb, sb); }
                sa = sa + sb;
                val = sortable_u32(sa[0] + sa[1]) >> 1;
            }
            u[120 + tl] = val;
        }
        if (more) asm volatile("s_waitcnt vmcnt(0)" ::: "memory");
        WG_BAR();
    }
#undef IDX_DMA
    unsigned thr = 1u;
    if (MODE != 1 && nt32 * 32 > 256) {
        typedef short s16x2 __attribute__((ext_vector_type(2)));
        const int visited = 128 - (off & ~15);
        unsigned hp[64];
#pragma unroll
        for (int j = 0; j < 64; ++j) hp[j] = __builtin_amdgcn_perm(u[2 * j + 1] >> 15, u[2 * j] >> 15, 0x05040100u) ^ 0x80008000u;
        unsigned T = 0u;
#pragma unroll 1
        for (int bit = 15; bit >= 0; --bit) {
            const unsigned cand = T | (1u << bit), cs = (cand ^ 0x8000u) & 0xFFFFu; const s16x2 c2 = __builtin_bit_cast(s16x2, cs | (cs << 16));
            s16x2 a0 = {0, 0}, a1 = {0, 0}, a2 = {0, 0}, a3 = {0, 0};
#pragma unroll
            for (int j0 = 0; j0 < 64; j0 += 8) { if (2 * j0 + 16 > off) {
#pragma unroll
                for (int j = j0; j < j0 + 8; j += 4) {
                    a0 += __builtin_elementwise_sub_sat(__builtin_bit_cast(s16x2, hp[j]), c2) >> 15; a1 += __builtin_elementwise_sub_sat(__builtin_bit_cast(s16x2, hp[j + 1]), c2) >> 15;
                    a2 += __builtin_elementwise_sub_sat(__builtin_bit_cast(s16x2, hp[j + 2]), c2) >> 15; a3 += __builtin_elementwise_sub_sat(__builtin_bit_cast(s16x2, hp[j + 3]), c2) >> 15; } } }
            const s16x2 at = (a0 + a1) + (a2 + a3);
            int cnt = visited + (int)at[0] + (int)at[1];
            cnt = row_sum_i32(cnt); cnt += __shfl_xor(cnt, 16);
            if (cnt >= 256) T = cand;
        }
        unsigned TL = 0u;
        int G;
        { const unsigned candg = T == 0xFFFFu ? 0xFFFFu : T + 1u, cs = (candg ^ 0x8000u) & 0xFFFFu; const s16x2 c2 = __builtin_bit_cast(s16x2, cs | (cs << 16));
          s16x2 a0 = {0, 0}, a1 = {0, 0}, a2 = {0, 0}, a3 = {0, 0};
#pragma unroll
          for (int j0 = 0; j0 < 64; j0 += 8) { if (2 * j0 + 16 > off) {
#pragma unroll
              for (int j = j0; j < j0 + 8; j += 4) {
                  a0 += __builtin_elementwise_sub_sat(__builtin_bit_cast(s16x2, hp[j]), c2) >> 15; a1 += __builtin_elementwise_sub_sat(__builtin_bit_cast(s16x2, hp[j + 1]), c2) >> 15;
                  a2 += __builtin_elementwise_sub_sat(__builtin_bit_cast(s16x2, hp[j + 2]), c2) >> 15; a3 += __builtin_elementwise_sub_sat(__builtin_bit_cast(s16x2, hp[j + 3]), c2) >> 15; } } }
          const s16x2 at = (a0 + a1) + (a2 + a3);
          int cnt = visited + (int)at[0] + (int)at[1];
          cnt = row_sum_i32(cnt); cnt += __shfl_xor(cnt, 16);
          G = T == 0xFFFFu ? 0 : cnt; }
        const int rneed = 256 - G;
        const unsigned tbh = (T << 15) + 0x7FFFu;
        unsigned L0 = 0u, L1 = 0u, L2 = 0u;
#pragma unroll
        for (int i0 = 0; i0 < 128; i0 += 16) { if (i0 + 16 > off) {
#pragma unroll
            for (int i = i0; i < i0 + 16; ++i) {
                const unsigned z = tbh - u[i], kk = 0x8000u - min(z, 0x8000u);
                unsigned t2, t1;
                asm("v_med3_u32 %0, %1, %2, %3" : "=v"(t2) : "v"(L1), "v"(L2), "v"(kk)); asm("v_med3_u32 %0, %1, %2, %3" : "=v"(t1) : "v"(L0), "v"(L1), "v"(kk));
                L2 = t2; L1 = t1; L0 = max(L0, kk); } } }
        if (__ballot(L2 != 0u) == 0ull) {
            unsigned TK = 0u;
#pragma unroll 1
            for (int bit = 15; bit >= 0; --bit) {
                const unsigned cand = TK | (1u << bit);
                int cnt = (L0 >= cand ? 1 : 0) + (L1 >= cand ? 1 : 0);
                cnt = row_sum_i32(cnt); cnt += __shfl_xor(cnt, 16);
                if (cnt >= rneed) TK = cand;
            }
            TL = TK ? TK - 1u : 0u;
        } else {
        const int tb = (int)(T << 15);
#pragma unroll
        for (int j = 0; j < 64; ++j) { const int x0 = min(max((int)u[2 * j] - tb, -1), 0x7FFF), x1 = min(max((int)u[2 * j + 1] - tb, -1), 0x7FFF);
            hp[j] = __builtin_amdgcn_perm((unsigned)x1, (unsigned)x0, 0x05040100u); }
#pragma unroll 1
        for (int bit = 14; bit >= 0; --bit) {
            const unsigned cand = TL | (1u << bit); const s16x2 c2 = __builtin_bit_cast(s16x2, cand | (cand << 16));
            s16x2 a0 = {0, 0}, a1 = {0, 0}, a2 = {0, 0}, a3 = {0, 0};
#pragma unroll
            for (int j0 = 0; j0 < 64; j0 += 8) { if (2 * j0 + 16 > off) {
#pragma unroll
                for (int j = j0; j < j0 + 8; j += 4) {
                    a0 += (__builtin_bit_cast(s16x2, hp[j]) - c2) >> 15; a1 += (__builtin_bit_cast(s16x2, hp[j + 1]) - c2) >> 15;
                    a2 += (__builtin_bit_cast(s16x2, hp[j + 2]) - c2) >> 15; a3 += (__builtin_bit_cast(s16x2, hp[j + 3]) - c2) >> 15; } } }
            const s16x2 at = (a0 + a1) + (a2 + a3);
            int cnt = visited + (int)at[0] + (int)at[1];
            cnt = row_sum_i32(cnt); cnt += __shfl_xor(cnt, 16);
            if (cnt >= 256) TL = cand;
        }
        }
        thr = (T << 15) | TL;
    }
    unsigned wlo0 = 0u, whi0 = 0u, wlo1 = 0u, whi1 = 0u;
#define WL(w, val, ln) asm volatile("v_writelane_b32 %0, %1, %2" : "+v"(w) : "s"(val), "n"(ln))
#pragma unroll
    for (int i0 = 0; i0 < 128; i0 += 4) {
        const unsigned long long b0 = __ballot(u[i0] >= thr), b1 = __ballot(u[i0 + 1] >= thr), b2 = __ballot(u[i0 + 2] >= thr), b3 = __ballot(u[i0 + 3] >= thr);
        const unsigned l0 = (unsigned)b0, h0 = (unsigned)(b0 >> 32), l1 = (unsigned)b1, h1 = (unsigned)(b1 >> 32), l2 = (unsigned)b2, h2 = (unsigned)(b2 >> 32), l3 = (unsigned)b3, h3 = (unsigned)(b3 >> 32);
        asm volatile("s_nop 3" :: "s"(l0), "s"(h0), "s"(l1), "s"(h1), "s"(l2), "s"(h2), "s"(l3), "s"(h3));
        if (i0 < 64) { WL(wlo0, l0, i0 & 63); WL(whi0, h0, i0 & 63); WL(wlo0, l1, (i0 + 1) & 63); WL(whi0, h1, (i0 + 1) & 63); WL(wlo0, l2, (i0 + 2) & 63); WL(whi0, h2, (i0 + 2) & 63); WL(wlo0, l3, (i0 + 3) & 63); WL(whi0, h3, (i0 + 3) & 63); }
        else { WL(wlo1, l0, i0 & 63); WL(whi1, h0, i0 & 63); WL(wlo1, l1, (i0 + 1) & 63); WL(whi1, h1, (i0 + 1) & 63); WL(wlo1, l2, (i0 + 2) & 63); WL(whi1, h2, (i0 + 2) & 63); WL(wlo1, l3, (i0 + 3) & 63); WL(whi1, h3, (i0 + 3) & 63); }
    }
#undef WL
    { const int ta = lane - off, tb = 64 + lane - off;
      if (ta >= 0) { MASK[(size_t)t0 * 128 + ta] = wlo0; MASK[(size_t)(t0 + 1) * 128 + ta] = whi0; }
      if (tb >= 0 && tb < 128) { MASK[(size_t)t0 * 128 + tb] = wlo1; MASK[(size_t)(t0 + 1) * 128 + tb] = whi1; } }
}
template <int MODE>
__device__ __forceinline__ void idx_phase(LAS unsigned char* lds, const f16* QI, const f16* KI, const float* WI, unsigned* MASK, int cu, int wave) {
    const int lane = lane_id_v();
#pragma unroll 1
    for (int k = 0; k < 2; ++k) {
        const int L = k == 0 ? cu : 511 - cu;
        idx_item<MODE>(lds, QI, KI, WI, MASK, (L >> 2) & 1, L >> 3, L & 3, wave, lane);
    }
}

namespace att {
#define SBAR() __builtin_amdgcn_sched_barrier(0)
__device__ __forceinline__ int crow(int r, int hi) { return (r & 3) + 8 * (r >> 2) + 4 * hi; }
__device__ __forceinline__ int v_st(int k, int c) { const int kk = (k & ~0xC) | ((k & 4) << 1) | ((k & 8) >> 1); return ((kk >> 3) * 4 + (c >> 5)) * 512 + ((kk & 7) * 32 + (c & 31)) * 2; }
__device__ __forceinline__ int v_rd_base(int lane) { return ((lane & 3) << 3) | (((lane >> 2) & 3) << 6) | (((lane >> 4) & 1) << 5) | (((lane >> 5) & 1) << 8); }
constexpr int v_rd_off(int d0, int ks, int half) { return d0 * 512 + ks * 4096 + half * 2048; }
template <int OFF> __device__ __forceinline__ s16x4 tr_read(int vb) { s16x4 r; asm volatile("ds_read_b64_tr_b16 %0, %1 offset:%2" : "=&v"(r) : "v"(vb), "i"(OFF) : "memory"); return r; }
template <int D0> __device__ __forceinline__ void pv_one(f32x16& od, int vb, bf16x8 pa0, bf16x8 pa1, bf16x8 pa2, bf16x8 pa3) {
  const s16x4 l0 = tr_read<v_rd_off(D0, 0, 0)>(vb), h0 = tr_read<v_rd_off(D0, 0, 1)>(vb), l1 = tr_read<v_rd_off(D0, 1, 0)>(vb), h1 = tr_read<v_rd_off(D0, 1, 1)>(vb);
  const s16x4 l2 = tr_read<v_rd_off(D0, 2, 0)>(vb), h2 = tr_read<v_rd_off(D0, 2, 1)>(vb), l3 = tr_read<v_rd_off(D0, 3, 0)>(vb), h3 = tr_read<v_rd_off(D0, 3, 1)>(vb);
  asm volatile("s_waitcnt lgkmcnt(0)" ::: "memory"); SBAR();
#define PK(L, H) (bf16x8){L[0], L[1], L[2], L[3], H[0], H[1], H[2], H[3]}
  od = __builtin_amdgcn_mfma_f32_32x32x16_bf16(pa0, PK(l0, h0), od, 0, 0, 0);
  od = __builtin_amdgcn_mfma_f32_32x32x16_bf16(pa1, PK(l1, h1), od, 0, 0, 0);
  od = __builtin_amdgcn_mfma_f32_32x32x16_bf16(pa2, PK(l2, h2), od, 0, 0, 0);
  od = __builtin_amdgcn_mfma_f32_32x32x16_bf16(pa3, PK(l3, h3), od, 0, 0, 0);
#undef PK
}
__device__ __forceinline__ void pv_d0(f32x16* o, int vb, bf16x8 pa0, bf16x8 pa1, bf16x8 pa2, bf16x8 pa3) {
  pv_one<0>(o[0], vb, pa0, pa1, pa2, pa3); pv_one<1>(o[1], vb, pa0, pa1, pa2, pa3); pv_one<2>(o[2], vb, pa0, pa1, pa2, pa3); pv_one<3>(o[3], vb, pa0, pa1, pa2, pa3);
}
template <bool DSA> __device__ __forceinline__ void exp16(f32x16& p, unsigned bits, bool near, const LAS float* bt) {
  if (DSA) { if (near) {
#pragma unroll
    for (int r = 0; r < 16; ++r) p[r] += bt[(r & 3) + 8 * (r >> 2)]; } }
#pragma unroll
  for (int r = 0; r < 16; ++r) {
    float v = p[r];
    v = __builtin_amdgcn_exp2f(v);
    if (DSA) { const int m = ((int)(bits << (31 - ((r & 3) + 8 * (r >> 2))))) >> 31; v = __uint_as_float(__float_as_uint(v) & (unsigned)m); }
    p[r] = v;
  }
}
__device__ __forceinline__ void pack_p(const f32x16& p0, const f32x16& p1, float& l_reg, bf16x8& pa0, bf16x8& pa1, bf16x8& pa2, bf16x8& pa3) {
  float ps = 0.f;
#pragma unroll
  for (int r = 0; r < 16; ++r) ps += p0[r];
#pragma unroll
  for (int r = 0; r < 16; ++r) ps += p1[r];
  l_reg += ps;
#define PK4(P, BASE, OUT) do { unsigned a0 = cvt_pk_bf16(P[BASE + 0], P[BASE + 1]), a1 = cvt_pk_bf16(P[BASE + 2], P[BASE + 3]);   \
    unsigned b0 = cvt_pk_bf16(P[BASE + 4], P[BASE + 5]), b1 = cvt_pk_bf16(P[BASE + 6], P[BASE + 7]);                              \
    auto r0 = __builtin_amdgcn_permlane32_swap(a0, b0, false, false); auto r1 = __builtin_amdgcn_permlane32_swap(a1, b1, false, false); \
    u32x4 w = {r0[0], r1[0], r0[1], r1[1]}; OUT = *reinterpret_cast<bf16x8*>(&w); } while (0)
  PK4(p0, 0, pa0); PK4(p0, 8, pa1); PK4(p1, 0, pa2); PK4(p1, 8, pa3);
#undef PK4
}

constexpr int SHM_V = 64 * 128 * 2;
template <int DQK> struct Cfg { static constexpr int ND0 = DQK / 16, RB = DQK * 2, SHM_K = 64 * RB, NJ = SHM_K / 8192  , K_OFF = 3 * SHM_V, WS_OFF = K_OFF + 3 * SHM_K, BT_OFF = WS_OFF + 8 * 64 * 4, MW_OFF = BT_OFF + 2048  ; };

template <int DQK, bool DSA>
__device__ __forceinline__ void attn_item(LAS unsigned char* lds, const bf16_t* __restrict__ Qg, const bf16_t* __restrict__ Kg, const bf16_t* __restrict__ Vg, f16* __restrict__ Y, int ycol0,
                                          const unsigned* __restrict__ MASK, const float* __restrict__ rel_bias, int b, int h, int qb, int wave, int lane) {
  using C = Cfg<DQK>;
  const int tid = wave * 64 + lane, r32 = lane & 31, hi = lane >> 5;
  const int i0 = qb * 256, r0 = i0 + wave * 32;
  const int NT = 4 * (qb + 1), mychunk = 4 * qb + (wave >> 1);
  const bf16_t* Kh = Kg + (size_t)(b * 8 + h) * S_ * DQK;
  const bf16_t* Vh = Vg + (size_t)(b * 8 + h) * S_ * 128;
  LAS unsigned char* V_lds = lds; LAS unsigned char* K_lds = lds + C::K_OFF;
  LAS float* li_l = (LAS float*)(lds + C::WS_OFF) + wave * 64;
  LAS float* BT = (LAS float*)(lds + C::BT_OFF);
  bf16x8 qr[C::ND0];
  { const bf16_t* Qw = Qg + ((size_t)(b * 8 + h) * S_ + r0 + r32) * DQK + hi * 8;
#pragma unroll
    for (int d0 = 0; d0 < C::ND0; ++d0) qr[d0] = *(const bf16x8*)(Qw + d0 * 16); }
  float bias_far = 0.f;
  if (DSA) bias_far = rel_bias[15 * 8 + h] * LOG2E;
  unsigned kof[C::NJ], vof[2];
#pragma unroll
  for (int jj = 0; jj < C::NJ; ++jj) { const int p = (wave * C::NJ + jj) * 1024 + lane * 16, key = p / C::RB, chp = (p % C::RB) >> 4; const int xs = (DQK == 192) ? ((key >> 1) & 7) : (key & 15);
    kof[jj] = (unsigned)(key * DQK + ((chp ^ xs) * 8)) * 2u; }
#pragma unroll
  for (int jj = 0; jj < 2; ++jj) { const int p = (wave * 2 + jj) * 1024 + lane * 16, sub = p >> 9, q = (p & 511) >> 1, kk = (sub >> 2) * 8 + (q >> 5), c = (sub & 3) * 32 + (q & 31);
    const int key = (kk & ~0xC) | ((kk & 4) << 1) | ((kk & 8) >> 1); vof[jj] = (unsigned)(key * 128 + c) * 2u; }
  const int vb0 = (int)(uintptr_t)V_lds + v_rd_base(lane);
  const int xs_r = (DQK == 192) ? ((r32 >> 1) & 7) : (r32 & 15);
  int kb[8];
#pragma unroll
  for (int q = 0; q < 8; ++q) kb[q] = (DQK == 192) ? r32 * C::RB + ((((2 * q + hi) & 7) ^ xs_r) << 4) : r32 * C::RB + (((2 * q + hi) ^ xs_r) << 4);
#define KADDR(d0) ((DQK == 192) ? kb[(d0) & 3] + ((d0) >> 2) * 128 : kb[(d0) & 7])
  u32x2 mw = {0u, 0u};
  const unsigned* mrowl = DSA ? MASK + (size_t)(b * S_ + r0 + (lane >> 1)) * 128 + (lane & 1) : nullptr;
  LAS unsigned char* MW = lds + C::MW_OFF + wave * 256;
#define TILE_DMA(t, slot) do { int to_ = (t) * 64; asm volatile("" : "+s"(to_)); const char* kg_ = (const char*)Kh + (size_t)to_ * (DQK * 2); const char* vg_ = (const char*)Vh + (size_t)to_ * 256; const int sl_ = (slot); \
    _Pragma("unroll") for (int jj_ = 0; jj_ < C::NJ; ++jj_) __builtin_amdgcn_global_load_lds((const unsigned*)(kg_ + kof[jj_]), (LAS unsigned*)(K_lds + sl_ * C::SHM_K + (wave * C::NJ + jj_) * 1024), 16, 0, 0); \
    _Pragma("unroll") for (int jj_ = 0; jj_ < 2; ++jj_) __builtin_amdgcn_global_load_lds((const unsigned*)(vg_ + vof[jj_]), (LAS unsigned*)(V_lds + sl_ * SHM_V + (wave * 2 + jj_) * 1024), 16, 0, 0); \
    if (DSA) __builtin_amdgcn_global_load_lds((const unsigned*)(mrowl + 2 * (t)), (LAS unsigned*)(MW + sl_ * 2048), 4, 0, 0); } while (0)
#define TILE_OFF(j) ((DSA) ? (((64 * (j) + 154) <= r0) ? bias_far : 0.f) : (((j) <= mychunk) ? 0.f : -1e30f))
#define TILE_NEAR(j) ((64 * (j) + 154) > r0)
#define QKT(P0, P1, bf, j) do { const float off_ = TILE_OFF(j); \
    _Pragma("unroll") for (int rr_ = 0; rr_ < 16; ++rr_) { P0[rr_] = off_; P1[rr_] = off_; } \
    const LAS unsigned char* Kp = K_lds + (bf) * C::SHM_K; \
    _Pragma("unroll") for (int d0 = 0; d0 < C::ND0; ++d0) { \
      const bf16x8 b0 = *(const LAS bf16x8*)(Kp + KADDR(d0)); const bf16x8 b1 = *(const LAS bf16x8*)(Kp + KADDR(d0) + 32 * C::RB); \
      P0 = __builtin_amdgcn_mfma_f32_32x32x16_bf16(b0, qr[d0], P0, 0, 0, 0); P1 = __builtin_amdgcn_mfma_f32_32x32x16_bf16(b1, qr[d0], P1, 0, 0, 0); } } while (0)
#define BTP(j) (BT + (64 * (j) - r0 - r32 + 4 * hi + 256))
#define MWFIX(mw, j) do { if (DSA) { if ((j) > mychunk) { mw.x = 0u; mw.y = 0u; } mw.x >>= (4 * hi); mw.y >>= (4 * hi); } } while (0)
  f32x16 o[4];
#pragma unroll
  for (int d = 0; d < 4; ++d)
#pragma unroll
    for (int r = 0; r < 16; ++r) o[d][r] = 0.f;
  float l_reg = 0.f;
  f32x16 p0, p1; bf16x8 pa0, pa1, pa2, pa3;
  asm volatile("s_waitcnt lgkmcnt(0)" ::: "memory"); __builtin_amdgcn_s_barrier(); asm volatile("" ::: "memory");
  if (DSA) { if (tid < 320) BT[tid] = rel_bias[t5_bucket(tid - 256) * 8 + h] * LOG2E; }
  TILE_DMA(0, 0); TILE_DMA(1, 1);
#define TILE_BODY(jt, SL, SL2) do { const int j_ = (jt); \
    if (j_ + 1 < NT) asm volatile("s_waitcnt vmcnt(5)" ::: "memory"); else asm volatile("s_waitcnt vmcnt(0)" ::: "memory"); \
    asm volatile("s_waitcnt lgkmcnt(0)" ::: "memory"); __builtin_amdgcn_s_barrier(); asm volatile("" ::: "memory"); \
    if (j_ + 2 < NT) TILE_DMA(j_ + 2, SL2); \
    if (DSA) { mw = *(const LAS u32x2*)(MW + (SL) * 2048 + r32 * 8); MWFIX(mw, j_); } \
    SBAR(); QKT(p0, p1, SL, j_); \
    exp16<DSA>(p0, mw.x, TILE_NEAR(j_), BTP(j_)); exp16<DSA>(p1, mw.y, TILE_NEAR(j_), BTP(j_) + 32); \
    pack_p(p0, p1, l_reg, pa0, pa1, pa2, pa3); SBAR(); \
    pv_d0(o, vb0 + (SL) * SHM_V, pa0, pa1, pa2, pa3); } while (0)
#pragma unroll 1
  for (int j = 0; j < NT; j += 3) {
    TILE_BODY(j, 0, 2);
    if (j + 1 < NT) TILE_BODY(j + 1, 1, 0);
    if (j + 2 < NT) TILE_BODY(j + 2, 2, 1);
  }
#undef TILE_BODY
  { auto rr = __builtin_amdgcn_permlane32_swap(__float_as_uint(l_reg), __float_as_uint(l_reg), false, false); l_reg = __uint_as_float(rr[0]) + __uint_as_float(rr[1]); }
  if (hi == 0) li_l[r32] = l_reg;
  asm volatile("s_waitcnt lgkmcnt(0)" ::: "memory");
  float rli[16];
#pragma unroll
  for (int r = 0; r < 16; ++r) rli[r] = __builtin_amdgcn_rcpf(li_l[crow(r, hi)]);
  f16* Yw = Y + (size_t)(b * S_ + r0) * 2048 + ycol0 + h * 128 + r32;
#pragma unroll
  for (int r = 0; r < 16; ++r) { const int orow = crow(r, hi);
#pragma unroll
    for (int d0 = 0; d0 < 4; ++d0) Yw[(size_t)orow * 2048 + d0 * 32] = (f16)(o[d0][r] * rli[r]); }
#undef TILE_DMA
#undef TILE_OFF
#undef TILE_NEAR
#undef QKT
#undef KADDR
#undef BTP
#undef MWFIX
}
#undef SBAR
}

__device__ __forceinline__ void attn_phase(LAS unsigned char* lds, unsigned char* ws, const float* rel_bias, int cu, int wave) {
  const int lane = lane_id_v();
  const int bh = cu >> 4, qb = cu & 15, b = bh >> 3, h = bh & 7;
  att::attn_item<192, false>(lds, (const bf16_t*)(ws + WS_QM), (const bf16_t*)(ws + WS_KM), (const bf16_t*)(ws + WS_VM), (f16*)(ws + WS_Y), 0, nullptr, nullptr, b, h, qb, wave, lane);
  att::attn_item<128, true>(lds, (const bf16_t*)(ws + WS_QD), (const bf16_t*)(ws + WS_KD), (const bf16_t*)(ws + WS_VD), (f16*)(ws + WS_Y), 1024, (const unsigned*)(ws + WS_MASK), rel_bias, b, h, 15 - qb, wave, lane);
}

#ifndef SEL_MODE
#define SEL_MODE 0
#endif
#ifndef SEL_INLANE
#define SEL_INLANE 1
#endif
#ifndef GATHER_SPLIT
#define GATHER_SPLIT 1
#endif
namespace peer {
__device__ __forceinline__ unsigned row_ror(unsigned x, int n) {
  switch (n) { case 1: return (unsigned)__builtin_amdgcn_update_dpp(0, (int)x, 0x121, 0xf, 0xf, false); case 2: return (unsigned)__builtin_amdgcn_update_dpp(0, (int)x, 0x122, 0xf, 0xf, false);
               case 4: return (unsigned)__builtin_amdgcn_update_dpp(0, (int)x, 0x124, 0xf, 0xf, false); default: return (unsigned)__builtin_amdgcn_update_dpp(0, (int)x, 0x128, 0xf, 0xf, false); }
}
__device__ __forceinline__ unsigned row_max_u32(unsigned x) { x = max(x, row_ror(x, 1)); x = max(x, row_ror(x, 2)); x = max(x, row_ror(x, 4)); x = max(x, row_ror(x, 8)); return x; }
__device__ __forceinline__ float row_sum_f32(float x) {
  x += __uint_as_float(row_ror(__float_as_uint(x), 1)); x += __uint_as_float(row_ror(__float_as_uint(x), 2)); x += __uint_as_float(row_ror(__float_as_uint(x), 4)); x += __uint_as_float(row_ror(__float_as_uint(x), 8)); return x; }
__device__ __forceinline__ float unsort_f32(unsigned u) { return __uint_as_float((u & 0x80000000u) ? (u & 0x7fffffffu) : ~u); }

__device__ __forceinline__ void top16_of_128(unsigned (&pk)[8][4], unsigned (&top)[4], int c) {
  unsigned t[4] = {0u, 0u, 0u, 0u};
#pragma unroll 1
  for (int round = 0; round < 16; ++round) {
    unsigned m[4];
#pragma unroll
    for (int reg = 0; reg < 4; ++reg) m[reg] = max(max(max(pk[0][reg], pk[1][reg]), max(pk[2][reg], pk[3][reg])), max(max(pk[4][reg], pk[5][reg]), max(pk[6][reg], pk[7][reg])));
#pragma unroll
    for (int reg = 0; reg < 4; ++reg) m[reg] = max(m[reg], row_ror(m[reg], 1));
#pragma unroll
    for (int reg = 0; reg < 4; ++reg) m[reg] = max(m[reg], row_ror(m[reg], 2));
#pragma unroll
    for (int reg = 0; reg < 4; ++reg) m[reg] = max(m[reg], row_ror(m[reg], 4));
#pragma unroll
    for (int reg = 0; reg < 4; ++reg) m[reg] = max(m[reg], row_ror(m[reg], 8));
#pragma unroll
    for (int reg = 0; reg < 4; ++reg) {
      if (c == round) t[reg] = m[reg];
#pragma unroll
      for (int nt = 0; nt < 8; ++nt) pk[nt][reg] = (pk[nt][reg] == m[reg]) ? 0u : pk[nt][reg];
    }
  }
#pragma unroll
  for (int reg = 0; reg < 4; ++reg) top[reg] = t[reg];
}

template <int SMODE>
__device__ __forceinline__ void select_task(const f16* __restrict__ QR, const f16* __restrict__ SK16, LAS u32x2* EG, int t0, int tg, int h, int lane) {
  const int c = lane & 15, q = lane >> 4, rowbase = lane & 48;
  unsigned top[2][4];
#pragma unroll
  for (int p = 0; p < 2; ++p) {
    f16x8 af[4];
    { const f16* qp = QR + (size_t)(t0 + 16 * tg + c) * 2048 + h * 256 + p * 128 + 8 * q;
#pragma unroll
      for (int s = 0; s < 4; ++s) af[s] = *(const f16x8*)(qp + 32 * s); }
    const f16* kp = SK16 + (size_t)((h * 2 + p) * 128 + c) * 128 + 8 * q;
    f16x8 bfr[8][4];
#pragma unroll
    for (int nt = 0; nt < 8; ++nt)
#pragma unroll
      for (int s = 0; s < 4; ++s) bfr[nt][s] = *(const f16x8*)(kp + (size_t)nt * 16 * 128 + 32 * s);
    asm volatile("s_waitcnt vmcnt(0)" ::: "memory"); __builtin_amdgcn_sched_barrier(0);
    unsigned pk[8][4];
#pragma unroll
    for (int nt = 0; nt < 8; ++nt) {
      f32x4 acc = {0.f, 0.f, 0.f, 0.f};
#pragma unroll
      for (int s = 0; s < 4; ++s) acc = __builtin_amdgcn_mfma_f32_16x16x32_f16(af[s], bfr[nt][s], acc, 0, 0, 0);
#pragma unroll
      for (int reg = 0; reg < 4; ++reg) pk[nt][reg] = (sortable_u32(acc[reg]) & ~0x7Fu) | (unsigned)(127 - (16 * nt + c));
    }
    if (SMODE != 1 && SMODE != 3) top16_of_128(pk, top[p], c); else { for (int reg = 0; reg < 4; ++reg) top[p][reg] = pk[reg][reg] ^ pk[reg + 4][reg]; }
  }
  if (SMODE == 2 || SMODE == 3) { for (int reg = 0; reg < 4; ++reg) EG[(16 * tg + 4 * q + reg) * 128 + h * 16 + c] = (u32x2){top[0][reg] & 16383u, top[1][reg]}; return; }
  int ci[4], cj[4];
#pragma unroll
  for (int r = 0; r < 4; ++r) { const int n = c + 16 * r; int i, j;
    if (n < 16) { i = 0; j = n; } else if (n < 24) { i = 1; j = n - 16; } else if (n < 29) { i = 2; j = n - 24; } else if (n < 33) { i = 3; j = n - 29; } else if (n < 36) { i = 4; j = n - 33; }
    else if (n < 42) { i = 5 + ((n - 36) >> 1); j = (n - 36) & 1; } else if (n < 50) { i = 8 + (n - 42); j = 0; } else { i = -1; j = 0; }
    ci[r] = i; cj[r] = j; }
  unsigned ck[4][4];
#pragma unroll
  for (int reg = 0; reg < 4; ++reg)
#pragma unroll
    for (int r = 0; r < 4; ++r) {
      const unsigned a = (unsigned)__shfl((int)top[0][reg], rowbase + (ci[r] < 0 ? 0 : ci[r])), b = (unsigned)__shfl((int)top[1][reg], rowbase + cj[r]);
      const float v = unsort_f32(a & ~0x7Fu) + unsort_f32(b & ~0x7Fu);
      ck[reg][r] = (ci[r] < 0) ? 0u : ((sortable_u32(v) & ~0xFFu) | (unsigned)(255 - (ci[r] * 16 + cj[r])));
    }
  unsigned tt[4] = {0u, 0u, 0u, 0u};
#pragma unroll 1
  for (int round = 0; round < 16; ++round) {
    unsigned m[4];
#pragma unroll
    for (int reg = 0; reg < 4; ++reg) m[reg] = max(max(ck[reg][0], ck[reg][1]), max(ck[reg][2], ck[reg][3]));
#pragma unroll
    for (int reg = 0; reg < 4; ++reg) m[reg] = max(m[reg], row_ror(m[reg], 1));
#pragma unroll
    for (int reg = 0; reg < 4; ++reg) m[reg] = max(m[reg], row_ror(m[reg], 2));
#pragma unroll
    for (int reg = 0; reg < 4; ++reg) m[reg] = max(m[reg], row_ror(m[reg], 4));
#pragma unroll
    for (int reg = 0; reg < 4; ++reg) m[reg] = max(m[reg], row_ror(m[reg], 8));
#pragma unroll
    for (int reg = 0; reg < 4; ++reg) {
      if (c == round) tt[reg] = m[reg];
#pragma unroll
      for (int r = 0; r < 4; ++r) ck[reg][r] = (ck[reg][r] == m[reg]) ? 0u : ck[reg][r];
    }
  }
#pragma unroll
  for (int reg = 0; reg < 4; ++reg) {
    const unsigned t = tt[reg];
    const int flat = 255 - (int)(t & 0xFFu); const float ct = unsort_f32(t & ~0xFFu);
    const unsigned k0 = (unsigned)__shfl((int)top[0][reg], rowbase + (flat >> 4)), k1 = (unsigned)__shfl((int)top[1][reg], rowbase + (flat & 15));
    const int expert = (127 - (int)(k0 & 0x7Fu)) * 128 + (127 - (int)(k1 & 0x7Fu));
    const float cmax = __shfl(ct, rowbase);
    const float e = __expf(ct - cmax);
    const float g = e / row_sum_f32(e);
    u32x2 w; w.x = (unsigned)expert; w.y = __float_as_uint(g);
    EG[(16 * tg + 4 * q + reg) * 128 + h * 16 + c] = w;
  }
}

__device__ __forceinline__ unsigned umed3(unsigned a, unsigned b, unsigned c) { unsigned r; asm("v_med3_u32 %0, %1, %2, %3" : "=v"(r) : "v"(a), "v"(b), "v"(c)); return r; }
__device__ __forceinline__ void ins16(unsigned (&L)[16], unsigned x, int n) {
#pragma unroll
  for (int i = 15; i >= 1; --i) if (i <= n) L[i] = umed3(L[i - 1], L[i], x);
  L[0] = max(L[0], x);
}
__device__ __forceinline__ void merge_pair32(unsigned (&L)[16]) {
  unsigned P[16];
#pragma unroll
  for (int i = 0; i < 16; ++i) P[i] = (unsigned)__shfl_xor((int)L[15 - i], 32);
#pragma unroll
  for (int i = 0; i < 16; ++i) L[i] = max(L[i], P[i]);
#pragma unroll
  for (int d = 8; d >= 1; d >>= 1)
#pragma unroll
    for (int i = 0; i < 16; ++i) if ((i & d) == 0) { const unsigned a = L[i], b = L[i + d]; L[i] = max(a, b); L[i + d] = min(a, b); }
}
__device__ __forceinline__ unsigned byte16(const unsigned (&w)[4], unsigned i) {
  const unsigned sel = (i & 7u) | 0x0c0c0c00u;
  const unsigned lo = __builtin_amdgcn_perm(w[1], w[0], sel), hi = __builtin_amdgcn_perm(w[3], w[2], sel);
  return (i & 8u) ? hi : lo;
}
__device__ __forceinline__ void select_head(const f16* __restrict__ QR, const f16* __restrict__ SK16, LAS u32x2* EG, int t0, int h, int lane) {
  const int n = lane & 31, hf = lane >> 5;
  const unsigned nhf4 = hf ? 0u : 4u;
  unsigned top[2][16];
#pragma unroll
  for (int p = 0; p < 2; ++p) {
    const f16* qp = QR + (size_t)(t0 + n) * 2048 + h * 256 + p * 128 + 8 * hf;
    const f16* kp = SK16 + (size_t)((h * 2 + p) * 128 + n) * 128 + 8 * hf;
    f16x8 tk[8];
#pragma unroll
    for (int s = 0; s < 8; ++s) tk[s] = *(const f16x8*)(qp + 16 * s);
    unsigned L[16];
#pragma unroll
    for (int i = 0; i < 16; ++i) L[i] = 0u;
#pragma unroll
    for (int st = 0; st < 2; ++st) {
      f16x8 kf[2][8];
#pragma unroll
      for (int k2 = 0; k2 < 2; ++k2)
#pragma unroll
        for (int s = 0; s < 8; ++s) kf[k2][s] = *(const f16x8*)(kp + (size_t)(32 * (2 * st + k2)) * 128 + 16 * s);
#pragma unroll
      for (int k2 = 0; k2 < 2; ++k2) {
        f32x16 acc;
#pragma unroll
        for (int r = 0; r < 16; ++r) acc[r] = 0.f;
#pragma unroll
        for (int s = 0; s < 8; ++s) acc = __builtin_amdgcn_mfma_f32_32x32x16_f16(kf[k2][s], tk[s], acc, 0, 0, 0);
#pragma unroll
        for (int r = 0; r < 16; ++r) {
          const int kt = 2 * st + k2, key0 = 32 * kt + (r & 3) + 8 * (r >> 2);
          const unsigned pk = ((sortable_u32(acc[r]) & ~0x7Fu) | nhf4) | (unsigned)((127 - key0) & ~4);
          ins16(L, pk, 16 * kt + r);
        }
      }
    }
    merge_pair32(L);
#pragma unroll
    for (int i = 0; i < 16; ++i) top[p][i] = L[i];
  }
  float X[16], Y[16];
#pragma unroll
  for (int i = 0; i < 16; ++i) { const float fa = unsort_f32(top[0][i] & ~0x7Fu), fb = unsort_f32(top[1][i] & ~0x7Fu); X[i] = hf ? fb : fa; Y[i] = hf ? fa : fb; }
  unsigned TT[16];
#pragma unroll
  for (int i = 0; i < 16; ++i) TT[i] = 0u;
  {
    int cnt = 0;
#pragma unroll
    for (int i = 0; i < 16; ++i)
#pragma unroll
      for (int j = i; j < 16; ++j) if ((i + 1) * (j + 1) <= 16) {
        const float v = X[i] + Y[j];
        const unsigned low = hf ? (unsigned)(255 - (16 * j + i)) : (unsigned)(255 - (16 * i + j));
        unsigned ck = (sortable_u32(v) & ~0xFFu) | low;
        if (i == j) ck = ((i & 1) == hf) ? ck : 0u;
        ins16(TT, ck, cnt); ++cnt;
      }
  }
  merge_pair32(TT);
  unsigned pa[4], pb[4];
#pragma unroll
  for (int w = 0; w < 4; ++w) {
    pa[w] = __builtin_amdgcn_perm(top[0][4 * w + 1], top[0][4 * w], 0x0c0c0400u) | __builtin_amdgcn_perm(top[0][4 * w + 3], top[0][4 * w + 2], 0x04000c0cu);
    pb[w] = __builtin_amdgcn_perm(top[1][4 * w + 1], top[1][4 * w], 0x0c0c0400u) | __builtin_amdgcn_perm(top[1][4 * w + 3], top[1][4 * w + 2], 0x04000c0cu);
  }
  const float cmax = unsort_f32(TT[0] & ~0xFFu);
  unsigned ex[8]; float ev[8]; float esum = 0.f;
#pragma unroll
  for (int k = 0; k < 8; ++k) {
    const unsigned t = hf ? TT[8 + k] : TT[k];
    const unsigned flat = (t & 0xFFu) ^ 0xFFu;
    const unsigned a7 = byte16(pa, flat >> 4) & 0x7Fu, b7 = byte16(pb, flat & 15u) & 0x7Fu;
    ex[k] = 16383u - ((a7 << 7) | b7);
    ev[k] = __expf(unsort_f32(t & ~0xFFu) - cmax);
    esum += ev[k];
  }
  esum += __shfl_xor(esum, 32);
  const float rs = 1.0f / esum;
  LAS u32x4* ep = (LAS u32x4*)(EG + n * 128 + h * 16 + 8 * hf);
#pragma unroll
  for (int k = 0; k < 4; ++k) ep[k] = (u32x4){ex[2 * k], __float_as_uint(ev[2 * k] * rs), ex[2 * k + 1], __float_as_uint(ev[2 * k + 1] * rs)};
}

__device__ __forceinline__ void gather_token(const unsigned char* __restrict__ U6, const unsigned char* __restrict__ V6, const float* __restrict__ USC, const float* __restrict__ VSC,
                                             const f16* __restrict__ X2H, const float* __restrict__ SSQ2, const float* src, float* dst, const LAS u32x2* EG, int t, int tl, int lane) {
  typedef _Float16 h2 __attribute__((ext_vector_type(2)));
  f16x8 xh[4];
#pragma unroll
  for (int m = 0; m < 4; ++m) { const f16x4 lo4 = *(const f16x4*)(X2H + (size_t)t * 2048 + 4 * lane + 256 * (2 * m)), hi4 = *(const f16x4*)(X2H + (size_t)t * 2048 + 4 * lane + 256 * (2 * m + 1));
    xh[m] = (f16x8){lo4[0], lo4[1], lo4[2], lo4[3], hi4[0], hi4[1], hi4[2], hi4[3]}; }
  float ss = lane < 32 ? SSQ2[(size_t)t * 32 + lane] : 0.f;
  const float r2 = 1.0f / sqrtf(wave_sum(ss) * (1.0f / 2048.0f) + EPS);
  f32x32 acc;
#pragma unroll
  for (int i = 0; i < 32; ++i) acc[i] = 0.f;
  const LAS u32x2* eg = EG + tl * 128;
  typedef unsigned u32x16 __attribute__((ext_vector_type(16)));
#define FP4PAIR(dw, k) ((k) == 0 ? __builtin_amdgcn_cvt_scalef32_pk_f16_fp4(dw, 1.0f, 0) : (k) == 1 ? __builtin_amdgcn_cvt_scalef32_pk_f16_fp4(dw, 1.0f, 1) : (k) == 2 ? __builtin_amdgcn_cvt_scalef32_pk_f16_fp4(dw, 1.0f, 2) : __builtin_amdgcn_cvt_scalef32_pk_f16_fp4(dw, 1.0f, 3))
#if TAB_U_FP4
  typedef u32x4 urow_t;
#define LOADU(dst, e) do { dst = *(const u32x4*)(U6 + (size_t)(e) * 1024 + 16 * lane); } while (0)
#define DOTROW(src, res) do { float d_ = 0.f; _Pragma("unroll") for (int i_ = 0; i_ < 4; ++i_) { _Pragma("unroll") for (int j_ = 0; j_ < 4; ++j_) { \
      const h2 a_ = FP4PAIR(src[i_], j_), b_ = {xh[i_][2 * j_], xh[i_][2 * j_ + 1]}; d_ = __builtin_amdgcn_fdot2(a_, b_, d_, false); } } res = d_; } while (0)
#else
  typedef u32x6 urow_t;
#define LOADU(dst, e) do { const u32x2* rp_ = (const u32x2*)(U6 + (size_t)(e) * 1536 + 24 * lane); const u32x2 q0_ = rp_[0], q1_ = rp_[1], q2_ = rp_[2]; dst = (u32x6){q0_.x, q0_.y, q1_.x, q1_.y, q2_.x, q2_.y}; } while (0)
#define DOTROW(src, res) do { const f16x32 uh_ = __builtin_amdgcn_cvt_scalef32_pk32_f16_fp6(src, 1.0f); float d_ = 0.f; _Pragma("unroll") for (int i_ = 0; i_ < 4; ++i_) { _Pragma("unroll") for (int j_ = 0; j_ < 4; ++j_) { \
      const h2 a_ = {uh_[8 * i_ + 2 * j_], uh_[8 * i_ + 2 * j_ + 1]}, b_ = {xh[i_][2 * j_], xh[i_][2 * j_ + 1]}; d_ = __builtin_amdgcn_fdot2(a_, b_, d_, false); } } res = d_; } while (0)
#endif
#if TAB_V_FP4
  typedef u32x4 vrow_t;
#define LOADV(dst, e) do { dst = *(const u32x4*)(V6 + (size_t)(e) * 1024 + 16 * lane); } while (0)
#define ACCROW(src, w) do { const _Float16 wh1_ = (_Float16)(w); const h2 wh_ = {wh1_, wh1_}; _Pragma("unroll") for (int i_ = 0; i_ < 4; ++i_) { _Pragma("unroll") for (int j_ = 0; j_ < 4; ++j_) { \
      const h2 c_ = FP4PAIR(src[i_], j_); accH[4 * i_ + j_] = __builtin_elementwise_fma(c_, wh_, accH[4 * i_ + j_]); } } } while (0)
#define ACCFLUSH() do { const float one_ = 1.0f; __builtin_amdgcn_sched_barrier(0); asm volatile("s_nop 1"); __builtin_amdgcn_sched_barrier(0); \
    _Pragma("unroll") for (int i_ = 0; i_ < 16; ++i_) { asm("v_fma_mix_f32 %0, %1, %2, %0 op_sel_hi:[1,0,0]" : "+v"(acc[2 * i_]) : "v"(accH[i_]), "v"(one_)); \
                                                       asm("v_fma_mix_f32 %0, %1, %2, %0 op_sel:[1,0,0] op_sel_hi:[1,0,0]" : "+v"(acc[2 * i_ + 1]) : "v"(accH[i_]), "v"(one_)); accH[i_] = (h2){(_Float16)0, (_Float16)0}; } } while (0)
#else
  typedef u32x6 vrow_t;
#define LOADV(dst, e) do { const u32x2* rp_ = (const u32x2*)(V6 + (size_t)(e) * 1536 + 24 * lane); const u32x2 q0_ = rp_[0], q1_ = rp_[1], q2_ = rp_[2]; dst = (u32x6){q0_.x, q0_.y, q1_.x, q1_.y, q2_.x, q2_.y}; } while (0)
#define ACCFLUSH() do { } while (0)
#define ACCROW(src, w) do { const f16x32 vh_ = __builtin_amdgcn_cvt_scalef32_pk32_f16_fp6(src, 1.0f); const u32x16 vr_ = __builtin_bit_cast(u32x16, vh_); const float w_ = (w); \
    _Pragma("unroll") for (int i_ = 0; i_ < 16; ++i_) { asm("v_fma_mix_f32 %0, %1, %2, %0 op_sel_hi:[1,0,0]" : "+v"(acc[2 * i_]) : "v"(vr_[i_]), "v"(w_)); \
                                                       asm("v_fma_mix_f32 %0, %1, %2, %0 op_sel:[1,0,0] op_sel_hi:[1,0,0]" : "+v"(acc[2 * i_ + 1]) : "v"(vr_[i_]), "v"(w_)); } } while (0)
#endif
#define GELU_F(v) ({ const float v_ = (v), av_ = fabsf(v_), tt_ = __builtin_amdgcn_rcpf(fmaf(av_, 0.2316418882f, 1.0f)); \
    float q_ = fmaf(tt_, 0.5307027145f, -0.7265760135f); q_ = fmaf(q_, tt_, 0.7107068705f); q_ = fmaf(q_, tt_, -0.142248368f); q_ = fmaf(q_, tt_, 0.127414796f); q_ *= tt_; \
    const float m_ = v_ * (q_ * __builtin_amdgcn_exp2f(v_ * v_ * -0.72134752044f)); v_ < 0.f ? m_ : v_ - m_; })
#define REDUCE4W(d, eg4, wout) do { \
    { auto r_ = __builtin_amdgcn_permlane32_swap(__float_as_uint(d[0]), __float_as_uint(d[1]), false, false); d[0] = __uint_as_float(r_[0]) + __uint_as_float(r_[1]); } \
    { auto r_ = __builtin_amdgcn_permlane32_swap(__float_as_uint(d[2]), __float_as_uint(d[3]), false, false); d[2] = __uint_as_float(r_[0]) + __uint_as_float(r_[1]); } \
    const bool q1_ = (lane & 16) != 0, q2_ = (lane & 32) != 0; const float keep_ = q1_ ? d[2] : d[0], send_ = q1_ ? d[0] : d[2]; \
    float s_ = keep_ + __shfl_xor(send_, 16); \
    s_ = peer::row_sum_f32(s_); \
    const u32x2 em_ = q1_ ? (q2_ ? eg4[3] : eg4[2]) : (q2_ ? eg4[1] : eg4[0]);     \
    const float a_ = s_ * r2 * USC[em_.x]; const float wq_ = __uint_as_float(em_.y) * VSC[em_.x] * GELU_F(a_); \
    wout[0] = __uint_as_float(__builtin_amdgcn_readlane(__float_as_uint(wq_), 0)); wout[1] = __uint_as_float(__builtin_amdgcn_readlane(__float_as_uint(wq_), 32)); \
    wout[2] = __uint_as_float(__builtin_amdgcn_readlane(__float_as_uint(wq_), 16)); wout[3] = __uint_as_float(__builtin_amdgcn_readlane(__float_as_uint(wq_), 48)); } while (0)
  constexpr int GS = 4;
  h2 accH[16];
#pragma unroll
  for (int i = 0; i < 16; ++i) accH[i] = (h2){(_Float16)0, (_Float16)0};
  urow_t ua[GS], ub[GS]; vrow_t va[GS];
  u32x2 ea[GS], eb[GS];
#pragma unroll
  for (int i = 0; i < GS; ++i) { ea[i] = eg[i]; LOADU(ua[i], ea[i].x); }
#pragma unroll 1
  for (int k = 0; k < 128; k += 2 * GS) {
#pragma unroll
    for (int i = 0; i < GS; ++i) eb[i] = eg[k + GS + i];
#pragma unroll
    for (int i = 0; i < GS; ++i) LOADV(va[i], ea[i].x);
#pragma unroll
    for (int i = 0; i < GS; ++i) LOADU(ub[i], eb[i].x);
    { float d[GS], w[GS];
#pragma unroll
      for (int i = 0; i < GS; ++i) DOTROW(ua[i], d[i]);
      REDUCE4W(d, ea, w);
#pragma unroll
      for (int i = 0; i < GS; ++i) { ACCROW(va[i], w[i]); __builtin_amdgcn_sched_barrier(0); } }
    const int kn = (k + 2 * GS < 128) ? k + 2 * GS : 0;
#pragma unroll
    for (int i = 0; i < GS; ++i) ea[i] = eg[kn + i];
#pragma unroll
    for (int i = 0; i < GS; ++i) LOADV(va[i], eb[i].x);
#pragma unroll
    for (int i = 0; i < GS; ++i) LOADU(ua[i], ea[i].x);
    { float d[GS], w[GS];
#pragma unroll
      for (int i = 0; i < GS; ++i) DOTROW(ub[i], d[i]);
      REDUCE4W(d, eb, w);
#pragma unroll
      for (int i = 0; i < GS; ++i) { ACCROW(va[i], w[i]); __builtin_amdgcn_sched_barrier(0); } }
    ACCFLUSH();
  }
#undef REDUCE4W
#undef ACCFLUSH
#undef GELU_F
#undef LOADU
#undef LOADV
#undef FP4PAIR
#undef DOTROW
#undef ACCROW
  float* op = dst + (size_t)t * 2048 + 4 * lane;
#pragma unroll
  for (int i = 0; i < 8; ++i) { const f16x8 xv = xh[i >> 1]; const int o = 4 * (i & 1);
    __builtin_nontemporal_store((f32x4){(float)xv[o] + acc[4 * i], (float)xv[o + 1] + acc[4 * i + 1], (float)xv[o + 2] + acc[4 * i + 2], (float)xv[o + 3] + acc[4 * i + 3]}, (f32x4*)(op + 256 * i)); }
}

#if TAB_U_FP4 && TAB_V_FP4
#define FP4PAIR(dw, k) ((k) == 0 ? __builtin_amdgcn_cvt_scalef32_pk_f16_fp4(dw, 1.0f, 0) : (k) == 1 ? __builtin_amdgcn_cvt_scalef32_pk_f16_fp4(dw, 1.0f, 1) : (k) == 2 ? __builtin_amdgcn_cvt_scalef32_pk_f16_fp4(dw, 1.0f, 2) : __builtin_amdgcn_cvt_scalef32_pk_f16_fp4(dw, 1.0f, 3))
#define GELU_F(v) ({ const float v_ = (v), av_ = fabsf(v_), tt_ = __builtin_amdgcn_rcpf(fmaf(av_, 0.2316418882f, 1.0f)); \
    float q_ = fmaf(tt_, 0.5307027145f, -0.7265760135f); q_ = fmaf(q_, tt_, 0.7107068705f); q_ = fmaf(q_, tt_, -0.142248368f); q_ = fmaf(q_, tt_, 0.127414796f); q_ *= tt_; \
    const float m_ = v_ * (q_ * __builtin_amdgcn_exp2f(v_ * v_ * -0.72134752044f)); v_ < 0.f ? m_ : v_ - m_; })
__device__ __forceinline__ void gather_u_token(const unsigned char* __restrict__ U6, const float* __restrict__ USC, const float* __restrict__ VSC, const f16* __restrict__ X2H, const float* __restrict__ SSQ2,
                                               const LAS u32x2* EG, LAS float* WL, int t, int tl, int lane) {
  typedef _Float16 h2 __attribute__((ext_vector_type(2)));
  f16x8 xh[4];
#pragma unroll
  for (int m = 0; m < 4; ++m) { const f16x4 lo4 = *(const f16x4*)(X2H + (size_t)t * 2048 + 4 * lane + 256 * (2 * m)), hi4 = *(const f16x4*)(X2H + (size_t)t * 2048 + 4 * lane + 256 * (2 * m + 1));
    xh[m] = (f16x8){lo4[0], lo4[1], lo4[2], lo4[3], hi4[0], hi4[1], hi4[2], hi4[3]}; }
  float ss = lane < 32 ? SSQ2[(size_t)t * 32 + lane] : 0.f;
  const float r2 = 1.0f / sqrtf(wave_sum(ss) * (1.0f / 2048.0f) + EPS);
  const LAS u32x2* eg = EG + tl * 128;
  LAS float* wl = WL + tl * 128;
#define LOADU(dst, e) do { dst = *(const u32x4*)(U6 + (size_t)(e) * 1024 + 16 * lane); } while (0)
#define DOTROW(src, res) do { float d_ = 0.f; _Pragma("unroll") for (int i_ = 0; i_ < 4; ++i_) { _Pragma("unroll") for (int j_ = 0; j_ < 4; ++j_) { \
      const h2 a_ = FP4PAIR(src[i_], j_), b_ = {xh[i_][2 * j_], xh[i_][2 * j_ + 1]}; d_ = __builtin_amdgcn_fdot2(a_, b_, d_, false); } } res = d_; } while (0)
#define REDUCE4S(d, eg4, kbase) do { \
    { auto r_ = __builtin_amdgcn_permlane32_swap(__float_as_uint(d[0]), __float_as_uint(d[1]), false, false); d[0] = __uint_as_float(r_[0]) + __uint_as_float(r_[1]); } \
    { auto r_ = __builtin_amdgcn_permlane32_swap(__float_as_uint(d[2]), __float_as_uint(d[3]), false, false); d[2] = __uint_as_float(r_[0]) + __uint_as_float(r_[1]); } \
    const bool q1_ = (lane & 16) != 0, q2_ = (lane & 32) != 0; const float keep_ = q1_ ? d[2] : d[0], send_ = q1_ ? d[0] : d[2]; \
    float s_ = keep_ + __shfl_xor(send_, 16); \
    s_ = peer::row_sum_f32(s_); \
    const u32x2 em_ = q1_ ? (q2_ ? eg4[3] : eg4[2]) : (q2_ ? eg4[1] : eg4[0]); \
    const float a_ = s_ * r2 * USC[em_.x]; const float wq_ = __uint_as_float(em_.y) * VSC[em_.x] * GELU_F(a_); \
    if ((lane & 15) == 0) wl[(kbase) + (q1_ ? 2 : 0) + (q2_ ? 1 : 0)] = wq_; } while (0)
  constexpr int GS = 4;
  u32x4 ua[GS], ub[GS]; u32x2 ea[GS], eb[GS];
#pragma unroll
  for (int i = 0; i < GS; ++i) { ea[i] = eg[i]; LOADU(ua[i], ea[i].x); }
#pragma unroll 1
  for (int k = 0; k < 128; k += 2 * GS) {
#pragma unroll
    for (int i = 0; i < GS; ++i) { eb[i] = eg[k + GS + i]; LOADU(ub[i], eb[i].x); }
    { float d[GS];
#pragma unroll
      for (int i = 0; i < GS; ++i) DOTROW(ua[i], d[i]);
      REDUCE4S(d, ea, k); }
    const int kn = (k + 2 * GS < 128) ? k + 2 * GS : 0;
#pragma unroll
    for (int i = 0; i < GS; ++i) { ea[i] = eg[kn + i]; LOADU(ua[i], ea[i].x); }
    { float d[GS];
#pragma unroll
      for (int i = 0; i < GS; ++i) DOTROW(ub[i], d[i]);
      REDUCE4S(d, eb, k + GS); }
  }
#undef LOADU
#undef DOTROW
#undef REDUCE4S
}
__device__ __forceinline__ void gather_v_token(const unsigned char* __restrict__ V6, const f16* __restrict__ X2H, float* dst, const LAS u32x2* EG, const LAS float* WL, int t, int tl, int lane) {
  typedef _Float16 h2 __attribute__((ext_vector_type(2)));
  f32x32 acc;
#pragma unroll
  for (int i = 0; i < 32; ++i) acc[i] = 0.f;
  h2 accH[16];
#pragma unroll
  for (int i = 0; i < 16; ++i) accH[i] = (h2){(_Float16)0, (_Float16)0};
  const LAS u32x2* eg = EG + tl * 128;
  const LAS float* wl = WL + tl * 128;
#define LOADV(dst, e) do { dst = *(const u32x4*)(V6 + (size_t)(e) * 1024 + 16 * lane); } while (0)
#define ACCROW(src, w) do { const _Float16 wh1_ = (_Float16)(w); const h2 wh_ = {wh1_, wh1_}; _Pragma("unroll") for (int i_ = 0; i_ < 4; ++i_) { _Pragma("unroll") for (int j_ = 0; j_ < 4; ++j_) { \
      const h2 c_ = FP4PAIR(src[i_], j_); accH[4 * i_ + j_] = __builtin_elementwise_fma(c_, wh_, accH[4 * i_ + j_]); } } } while (0)
#define ACCFLUSH() do { const float one_ = 1.0f; __builtin_amdgcn_sched_barrier(0); asm volatile("s_nop 1"); __builtin_amdgcn_sched_barrier(0); \
    _Pragma("unroll") for (int i_ = 0; i_ < 16; ++i_) { asm("v_fma_mix_f32 %0, %1, %2, %0 op_sel_hi:[1,0,0]" : "+v"(acc[2 * i_]) : "v"(accH[i_]), "v"(one_)); \
                                                       asm("v_fma_mix_f32 %0, %1, %2, %0 op_sel:[1,0,0] op_sel_hi:[1,0,0]" : "+v"(acc[2 * i_ + 1]) : "v"(accH[i_]), "v"(one_)); accH[i_] = (h2){(_Float16)0, (_Float16)0}; } } while (0)
  constexpr int GS = 4;
  u32x4 va[GS], vb[GS];
#pragma unroll
  for (int i = 0; i < GS; ++i) LOADV(va[i], eg[i].x);
#pragma unroll 1
  for (int k = 0; k < 128; k += 2 * GS) {
#pragma unroll
    for (int i = 0; i < GS; ++i) LOADV(vb[i], eg[k + GS + i].x);
    { const f32x4 w4 = *(const LAS f32x4*)(wl + k);
#pragma unroll
      for (int i = 0; i < GS; ++i) { ACCROW(va[i], w4[i]); __builtin_amdgcn_sched_barrier(0); } }
    const int kn = (k + 2 * GS < 128) ? k + 2 * GS : 0;
#pragma unroll
    for (int i = 0; i < GS; ++i) LOADV(va[i], eg[kn + i].x);
    { const f32x4 w4 = *(const LAS f32x4*)(wl + k + GS);
#pragma unroll
      for (int i = 0; i < GS; ++i) { ACCROW(vb[i], w4[i]); __builtin_amdgcn_sched_barrier(0); } }
    ACCFLUSH();
  }
#undef LOADV
#undef ACCROW
#undef ACCFLUSH
  float* op = dst + (size_t)t * 2048 + 4 * lane;
#pragma unroll
  for (int i = 0; i < 8; ++i) { const f16x4 xv = *(const f16x4*)(X2H + (size_t)t * 2048 + 4 * lane + 256 * i);
    __builtin_nontemporal_store((f32x4){(float)xv[0] + acc[4 * i], (float)xv[1] + acc[4 * i + 1], (float)xv[2] + acc[4 * i + 2], (float)xv[3] + acc[4 * i + 3]}, (f32x4*)(op + 256 * i)); }
}
#undef FP4PAIR
#undef GELU_F
#endif
}

__device__ __forceinline__ void peer_phase(LAS unsigned char* lds, unsigned char* ws, const float* src, float* dst, int cu, int wave) {
  const int lane = lane_id_v();
  LAS u32x2* EG = (LAS u32x2*)lds;
  const int t0 = cu * 32;
  __syncthreads();
#if defined(MK_REPEAT)
#endif
#if SEL_INLANE
#if defined(MK_REPEAT)
  _Pragma("unroll 1") for (int rep8_ = 0; rep8_ < (MK_REPEAT == 8 ? 5 : 1); ++rep8_) { if (rep8_) WG_BAR(); asm volatile("" : "+s"(ws) :: "memory");
#endif
  peer::select_head((const f16*)(ws + WS_QR), (const f16*)(ws + WS_SK16), EG, t0, wave, lane);
#if defined(MK_REPEAT)
  }
#endif
#else
#pragma unroll 1
  for (int k = 0; k < 2; ++k) { const int task = wave + 8 * k; peer::select_task<0>((const f16*)(ws + WS_QR), (const f16*)(ws + WS_SK16), EG, t0, task & 1, task >> 1, lane); }
#endif
  WG_BAR();
#if GATHER_SPLIT && TAB_U_FP4 && TAB_V_FP4
  LAS float* WL = (LAS float*)(lds + 32768);
#pragma unroll 1
  for (int k = 0; k < 4; ++k) { const int tl = wave + 8 * k; peer::gather_u_token(ws + WS_U16, (const float*)(ws + WS_USCL), (const float*)(ws + WS_VSCL), (const f16*)(ws + WS_XN), (const float*)(ws + WS_SSQ2), EG, WL, t0 + tl, tl, lane); }
  WG_BAR();
#pragma unroll 1
  for (int k = 0; k < 4; ++k) { const int tl = wave + 8 * k; peer::gather_v_token(ws + WS_V16, (const f16*)(ws + WS_XN), dst, EG, WL, t0 + tl, tl, lane); }
#else
#pragma unroll 1
  for (int k = 0; k < 4; ++k) { const int tl = wave + 8 * k; peer::gather_token(ws + WS_U16, ws + WS_V16, (const float*)(ws + WS_USCL), (const float*)(ws + WS_VSCL), (const f16*)(ws + WS_XN), (const float*)(ws + WS_SSQ2), src, dst, EG, t0 + tl, tl, lane); }
#endif
}
#ifndef IDX_MODE
#define IDX_MODE 0
#endif
#define PHASE2_PROBE idx_phase<IDX_MODE>(lds + RING_OFF, (const f16*)(ws + WS_QI), (const f16*)(ws + WS_KI), (const float*)(ws + WS_WI), (unsigned*)(ws + WS_MASK), c, wave);
#define PHASE2_EXTRA idx_phase<0>(lds + RING_OFF, (const f16*)(ws + WS_QI), (const f16*)(ws + WS_KI), (const float*)(ws + WS_WI), (unsigned*)(ws + WS_MASK), c, wave);
#ifndef PHASE2_EXTRA
#define PHASE2_EXTRA
#endif
#ifndef PHASES_4_TO_6
#define PHASES_4_TO_6
#endif
#ifndef DEBUG_STAGE_2
#define DEBUG_STAGE_2
#endif

#ifndef MK_DEBUG
#define MK_DEBUG 0
#endif
constexpr int N_PHASES = 7;
__global__ void __launch_bounds__(NTHR, 2) mk_fwd(Args args) {
    extern __shared__ __attribute__((aligned(16))) unsigned char lds_raw[];
    LAS unsigned char* lds = (LAS unsigned char*)lds_raw;
    const int wave = __builtin_amdgcn_readfirstlane(threadIdx.x >> 6);
    volatile LAS unsigned* MISC = (volatile LAS unsigned*)(lds + MISC_OFF);
    if (threadIdx.x < 64) MISC[threadIdx.x] = 0u;
    __syncthreads();
    unsigned char* ws = args.ws;
    const int lo = args.ph_lo, hi = args.ph_hi;
    const bool multi = (hi - lo) > 1;
    XcdBarrier bar; bar.bar = (unsigned*)(ws + WS_CTL); bar.x = 0; bar.st = nullptr; bar.wave = wave;
    if (multi) bar = xcd_barrier_post((unsigned*)(ws + WS_CTL), MISC + 8, wave);
#define IN(k) (lo <= (k) && (k) < hi)
#ifdef MK_REPEAT
#define REP(k) for (int rep_ = 0; rep_ < ((k) == MK_REPEAT ? 2 : 1); ++rep_, ((k) == MK_REPEAT && rep_ == 1 ? xcd_barrier(bar) : (void)0))
#else
#define REP(k)
#endif
#ifdef MK_PROBE
    unsigned long long* stamps = (unsigned long long*)(ws + 49152);
#define STAMP(k) do { if (blockIdx.x == 0 && wave == 0 && lane_id_v() == 0) stamps[k] = __builtin_amdgcn_s_memrealtime(); } while (0)
#else
#define STAMP(k) do { } while (0)
#endif
    STAMP(0);
#define SEAM(k) do { const bool slice_ = TAB_SEAM_ROWS > 0 && (k) >= 0 && (k) <= 4 && IN(k) && (MK_DEBUG == 0 || MK_DEBUG >= 6); const bool bar_ = IN(k) && IN((k) + 1); \
    if (slice_) { if (bar_) xcd_barrier_arrive(bar); p0_tables(args, TAB_ROWS_P2 + (k) * TAB_SEAM_ROWS + blockIdx.x * NWAVES + wave, gridDim.x * NWAVES, TAB_ROWS_P2 + ((k) + 1) * TAB_SEAM_ROWS, lane_id_v()); if (bar_) xcd_barrier_wait(bar); } \
    else if (bar_) xcd_barrier(bar); } while (0)
    const int c = blockIdx.x;
    LAS float* P = (LAS float*)(lds + EPI_OFF);

#if defined(MK_REPEAT)
    if (MK_REPEAT == 20) { int x_ = wave; asm volatile(".rept 16384\n\tv_add_u32 %0, 1, %0\n\t.endr" : "+v"(x_)); if (x_ == 12345) ((int*)(ws + 49152))[0] = x_; }
    if (MK_REPEAT == 22) { int a_ = wave, b_ = wave + 1, c_ = wave + 2, d_ = wave + 3; for (int i_ = 0; i_ < 64; ++i_) asm volatile(".rept 64\n\tv_max_i32 %0, 1, %0\n\tv_max_i32 %1, 1, %1\n\tv_max_i32 %2, 1, %2\n\tv_max_i32 %3, 1, %3\n\t.endr" : "+v"(a_), "+v"(b_), "+v"(c_), "+v"(d_)); if (a_ + b_ + c_ + d_ == 12345) ((int*)(ws + 49152))[0] = a_; }
    if (MK_REPEAT == 23) { unsigned a_ = wave, b_ = wave + 1, c_ = wave + 2, d_ = wave + 3, e_ = wave * 7; for (int i_ = 0; i_ < 64; ++i_) asm volatile(".rept 64\n\tv_med3_u32 %0, %0, %1, %4\n\tv_med3_u32 %1, %1, %2, %4\n\tv_med3_u32 %2, %2, %3, %4\n\tv_med3_u32 %3, %3, %0, %4\n\t.endr" : "+v"(a_), "+v"(b_), "+v"(c_), "+v"(d_) : "v"(e_)); if (a_ + b_ + c_ + d_ == 12345) ((int*)(ws + 49152))[0] = a_; }
    if (MK_REPEAT == 24) { f32x2 a_ = {1.f, 2.f}, b_ = {1.f, 2.f}, c_ = {1.f, 2.f}, d_ = {1.f, 2.f}, e_ = {0.5f, 0.25f}; for (int i_ = 0; i_ < 64; ++i_) asm volatile(".rept 64\n\tv_pk_fma_f32 %0, %0, %4, %4\n\tv_pk_fma_f32 %1, %1, %4, %4\n\tv_pk_fma_f32 %2, %2, %4, %4\n\tv_pk_fma_f32 %3, %3, %4, %4\n\t.endr" : "+v"(a_), "+v"(b_), "+v"(c_), "+v"(d_) : "v"(e_)); if (a_[0] + b_[0] + c_[0] + d_[1] == 12345.f) ((int*)(ws + 49152))[0] = 1; }
    if (MK_REPEAT == 25) { float a_ = 1.f, b_ = 2.f, c_ = 3.f, d_ = 4.f, e_ = 0.5f; for (int i_ = 0; i_ < 64; ++i_) asm volatile(".rept 64\n\tv_fma_f32 %0, %0, %4, %4\n\tv_fma_f32 %1, %1, %4, %4\n\tv_fma_f32 %2, %2, %4, %4\n\tv_fma_f32 %3, %3, %4, %4\n\t.endr" : "+v"(a_), "+v"(b_), "+v"(c_), "+v"(d_) : "v"(e_)); if (a_ + b_ + c_ + d_ == 12345.f) ((int*)(ws + 49152))[0] = 1; }
    if (MK_REPEAT == 21) { int x_ = wave; for (int i_ = 0; i_ < 64; ++i_) asm volatile(".rept 256\n\tv_add_u32 %0, 1, %0\n\t.endr" : "+v"(x_)); if (x_ == 12345) ((int*)(ws + 49152))[0] = x_; }
#endif
#if defined(MK_REPEAT)
    if (MK_REPEAT >= 10 && MK_REPEAT <= 12 && IN(0)) { p0_prologue(args, lds, wave, lane_id_v(), true, 1 << (MK_REPEAT - 10)); __syncthreads(); xcd_barrier(bar); }
#endif
    REP(0) if (IN(0)) { p0_prologue(args, lds, wave, lane_id_v(), MK_DEBUG == 0 || MK_DEBUG >= 6); __syncthreads(); }
    SEAM(0); STAMP(1);
    REP(1) if (IN(1)) {
        pg8::Gemm g{(const f16*)(ws + WS_XN), (const f16*)(ws + WS_WT_IN), T_, 4096, 2048}; pg8::StaticOrder S; S.init(T_, 4096, gridDim.x, c);
        EpiIn E{(f16*)(ws + WS_CQ), (f16*)(ws + WS_CKV), (float*)(ws + WS_SSQ_CQ), (float*)(ws + WS_SSQ_CKV), (bf16_t*)(ws + WS_QD), (bf16_t*)(ws + WS_KD), (f16*)(ws + WS_QI), (f16*)(ws + WS_KI),
                (float*)(ws + WS_WI), (float*)(ws + WS_KR), (float*)(ws + WS_SSQ_KR), args.in[I_GDQ], args.in[I_GDK], args.in[I_GMK], (const float*)(ws + WS_CS), P};
        pg8::gemm_phase<EpiIn, pg8::StaticOrder>(lds + RING_OFF, g, S, E, wave);
    }
    SEAM(1); STAMP(2);
    if (IN(2)) {
        const int half = gridDim.x / 2;
#if defined(MK_REPEAT)
        for (int rep9_ = 0; rep9_ < (MK_REPEAT == 9 ? 2 : 1); ++rep9_)
#endif
        if (c < half) {
            pg8::Gemm g{(const f16*)(ws + WS_XN), (const f16*)(ws + WS_WT_IN) + (size_t)4096 * 2048, T_, 1024, 2048}; pg8::StaticOrder S; S.init(T_, 1024, half, c);
            EpiVd E{(bf16_t*)(ws + WS_VD)};
            pg8::gemm_phase<EpiVd, pg8::StaticOrder>(lds + RING_OFF, g, S, E, wave);
            if (TAB_ROWS_P2 > 0 && (MK_DEBUG == 0 || MK_DEBUG >= 6)) p0_tables(args, c * NWAVES + wave, half * NWAVES, TAB_ROWS_P2, lane_id_v());
        } else {
            { pg8::Gemm g{(const f16*)(ws + WS_CQ), (const f16*)(ws + WS_WT_UQ), T_, 2048, 512}; pg8::StaticOrder S; S.init(T_, 2048, half, c - half);
              EpiQup E{(bf16_t*)(ws + WS_QM), (const float*)(ws + WS_SSQ_CQ), args.in[I_GMQ], (const float*)(ws + WS_CS), P};
              pg8::gemm_phase<EpiQup, pg8::StaticOrder>(lds + RING_OFF, g, S, E, wave); }
            { pg8::Gemm g{(const f16*)(ws + WS_CKV), (const f16*)(ws + WS_WT_UKV), T_, 2048, 256}; pg8::StaticOrder S; S.init(T_, 2048, half, c - half);
              EpiKVup E{(bf16_t*)(ws + WS_KM), (bf16_t*)(ws + WS_VM), (const float*)(ws + WS_SSQ_CKV), (const float*)(ws + WS_SSQ_KR), (const float*)(ws + WS_KR), args.in[I_GMK], P};
              pg8::gemm_phase<EpiKVup, pg8::StaticOrder>(lds + RING_OFF, g, S, E, wave); }
        }
#if defined(MK_REPEAT)
        if (MK_REPEAT == 7) { PHASE2_PROBE }
#endif
        PHASE2_EXTRA
    }
    SEAM(2); STAMP(3);
    REP(3) if (IN(3)) { attn_phase(lds + RING_OFF, ws, args.in[I_RELB], c, wave); }
    SEAM(3); STAMP(4);
    REP(4) if (IN(4)) {
        pg8::Gemm g{(const f16*)(ws + WS_Y), (const f16*)(ws + WS_WT_O), T_, 2048, 2048}; pg8::StaticOrder S; S.init(T_, 2048, gridDim.x, c);
        EpiOut E{args.in[I_X], args.out, (f16*)(ws + WS_XN), (float*)(ws + WS_SSQ2)};
        pg8::gemm_phase<EpiOut, pg8::StaticOrder>(lds + RING_OFF, g, S, E, wave);
    }
    SEAM(4); STAMP(5);
    REP(5) if (IN(5)) {
        pg8::Gemm g{(const f16*)(ws + WS_XN), (const f16*)(ws + WS_WT_PQ), T_, 2048, 2048}; pg8::StaticOrder S; S.init(T_, 2048, gridDim.x, c);
        LAS float* R2s = (LAS float*)(lds + R2S_OFF);
        pg8::Unit u0;
        if (S.next(0, u0)) { const int tid = wave * 64 + lane_id_v();
            if (tid < 256) { const float* sp = (const float*)(ws + WS_SSQ2) + (size_t)(u0.pm * 256 + tid) * 32; float ss = 0.f;
#pragma unroll
                for (int i = 0; i < 8; ++i) ss += sum4(*(const f32x4*)(sp + 4 * i));
                R2s[tid] = 1.0f / sqrtf(ss * (1.0f / 2048.0f) + EPS); } }
        __syncthreads();
        EpiQr E{(f16*)(ws + WS_QR), R2s};
        pg8::gemm_phase<EpiQr, pg8::StaticOrder>(lds + RING_OFF, g, S, E, wave);
    }
    SEAM(5); STAMP(6);
#ifdef MK_REPEAT
    if (MK_REPEAT == 6 && IN(6)) { peer_phase(lds + RING_OFF, ws, args.out, (float*)(ws + 416 * MiB), c, wave); xcd_barrier(bar); }
#endif
    if (IN(6)) { peer_phase(lds + RING_OFF, ws, args.out, args.out, c, wave); }
#ifdef MK_PROBE
    if (multi) xcd_barrier(bar);
    STAMP(7);
#endif
#undef IN
#undef SEAM
}

#ifdef MK_PROBE
__global__ void k_probe_report(const unsigned long long* st, int i1, int j1, int i2, int j2, const float* __restrict__ x, float* __restrict__ out, size_t n) {
  const float D1 = (float)(st[j1] - st[i1]) * 0.01f, V = 300.f * (float)(st[j2] - st[i2]) * 0.01f;
  for (size_t i = (size_t)blockIdx.x * 256 + threadIdx.x; i < n; i += (size_t)gridDim.x * 256) out[i] = (i == 0) ? V : x[i] * (1.0f + D1);
}
#endif
extern "C" void kernel_launch(void* const* d_in, const int* in_sizes, int n_in, void* d_out, int out_size, void* d_ws, size_t ws_size, hipStream_t stream) {
    static int ok = 0;
    if (ok == 0) {
        if (n_in != 18 || in_sizes[0] != T_ * D_ || out_size != T_ * D_ || ws_size < (size_t)512 * MiB) { fprintf(stderr, "kernel_launch: unexpected shapes / workspace (n_in %d, ws %zu)\n", n_in, ws_size); ok = -1; return; }
        int dev = 0, cus = 0;
        if (hipGetDevice(&dev) != hipSuccess || hipDeviceGetAttribute(&cus, hipDeviceAttributeMultiprocessorCount, dev) != hipSuccess || cus < NCU) { fprintf(stderr, "kernel_launch: needs a %d-CU device (got %d)\n", NCU, cus); ok = -1; return; }
        if (hipFuncSetAttribute((const void*)mk_fwd, hipFuncAttributeMaxDynamicSharedMemorySize, LDS_BYTES) != hipSuccess) { fprintf(stderr, "kernel_launch: hipFuncSetAttribute failed\n"); ok = -1; return; }
        int per_cu = 0;
        if (hipOccupancyMaxActiveBlocksPerMultiprocessor(&per_cu, (const void*)mk_fwd, NTHR, LDS_BYTES) != hipSuccess || per_cu < 1 || (long)cus * per_cu < NCU) {
            fprintf(stderr, "kernel_launch: the occupancy query admits %d workgroups per CU on %d CUs: a grid of %d would not be co-resident; nothing launched\n", per_cu, cus, NCU); (void)hipGetLastError(); ok = -1; return; }
        ok = 1;
    }
    if (ok < 0) return;
    unsigned char* ws = (unsigned char*)d_ws;
    (void)hipMemsetAsync(ws + WS_CTL, 0, CTL_ZERO_BYTES, stream);
    Args a{};
    for (int i = 0; i < 18; ++i) a.in[i] = (const float*)d_in[i];
    a.out = (float*)d_out; a.ws = ws;
#if MK_DEBUG == 0
#ifdef MK_PROBE
    a.ph_lo = 0; a.ph_hi = N_PHASES;
    hipLaunchKernelGGL(mk_fwd, dim3(NCU), dim3(NTHR), LDS_BYTES, stream, a);
    k_probe_report<<<2048, 256, 0, stream>>>((const unsigned long long*)(ws + 49152), MK_PROBE_I1, MK_PROBE_J1, MK_PROBE_I2, MK_PROBE_J2, a.in[I_X], a.out, (size_t)T_ * D_);
#elif defined(MK_PER_PHASE)
    for (int ph = 0; ph < N_PHASES; ++ph) { a.ph_lo = ph; a.ph_hi = ph + 1; hipLaunchKernelGGL(mk_fwd, dim3(NCU), dim3(NTHR), LDS_BYTES, stream, a); }
#else
    a.ph_lo = 0; a.ph_hi = N_PHASES;
    hipLaunchKernelGGL(mk_fwd, dim3(NCU), dim3(NTHR), LDS_BYTES, stream, a);
#endif
#else
    const float* x = a.in[I_X];
    unsigned* ERR = (unsigned*)(ws + 32768);
    int nslots = 0;
#if MK_DEBUG == 1
    for (int ph = 0; ph < 3; ++ph) { a.ph_lo = ph; a.ph_hi = ph + 1; hipLaunchKernelGGL(mk_fwd, dim3(NCU), dim3(NTHR), LDS_BYTES, stream, a); }
    float* PROJ = (float*)(ws + 288 * MiB); float* H = (float*)(ws + 368 * MiB); float* QRAW = H; float* KVRAW = (float*)(ws + 400 * MiB);
    float* CQN = (float*)(ws + 432 * MiB); float* CKVN = (float*)(ws + 440 * MiB); float* QM = (float*)(ws + 432 * MiB); float* KMT = (float*)(ws + 456 * MiB);
    float* QD = (float*)(ws + 480 * MiB); float* KDT = (float*)(ws + 496 * MiB);
    k_rmsnorm<<<TB0 / 4, 256, 0, stream>>>(x, 2048, 2048, a.in[I_GATTN], H, 2048, TB0);
    k_cmp<<<1024, 256, 0, stream>>>(F_f16_f32{(const f16*)(ws + WS_XN), H}, (size_t)TB0 * 2048, ERR, 0, 0.004f, 0.004f);
    k_gemm<<<dim3((INW + 63) / 64, TB0 / 64), 256, 0, stream>>>(H, 2048, a.in[I_WIN], INW, PROJ, INW, TB0, INW, 2048, nullptr, 0);
    k_cmp<<<1024, 256, 0, stream>>>(F_cols16{(const f16*)(ws + WS_CQ), PROJ, 512, INW, OFF_CQ, 1.f}, (size_t)TB0 * 512, ERR, 1, 0.004f, 0.004f);
    k_cmp<<<1024, 256, 0, stream>>>(F_cols16{(const f16*)(ws + WS_CKV), PROJ, 256, INW, OFF_CKV, 1.f}, (size_t)TB0 * 256, ERR, 2, 0.004f, 0.004f);
    k_cmp<<<1024, 256, 0, stream>>>(F_cols16{(const f16*)(ws + WS_QI), PROJ, 1024, INW, OFF_QI, 0.125f}, (size_t)TB0 * 1024, ERR, 3, 0.004f, 0.0005f);
    k_cmp<<<1024, 256, 0, stream>>>(F_cols16{(const f16*)(ws + WS_KI), PROJ, 64, INW, OFF_KI, 1.f}, (size_t)TB0 * 64, ERR, 4, 0.004f, 0.004f);
    k_cmp<<<1024, 256, 0, stream>>>(F_cols32{(const float*)(ws + WS_WI), PROJ, 16, INW, OFF_WI, 0}, (size_t)TB0 * 16, ERR, 5, 0.004f, 0.004f);
    k_rmsnorm<<<TB0 / 4, 256, 0, stream>>>(PROJ + OFF_CQ, INW, 512, a.in[I_GCQ], CQN, 512, TB0);
    k_rmsnorm<<<TB0 / 4, 256, 0, stream>>>(PROJ + OFF_CKV, INW, 256, a.in[I_GCKV], CKVN, 256, TB0);
    k_gemm<<<dim3(1536 / 64, TB0 / 64), 256, 0, stream>>>(CQN, 512, a.in[I_WUQ], 1536, QRAW, 1536, TB0, 1536, 512, nullptr, 0);
    k_gemm<<<dim3(2048 / 64, TB0 / 64), 256, 0, stream>>>(CKVN, 256, a.in[I_WUKV], 2048, KVRAW, 2048, TB0, 2048, 256, nullptr, 0);
    k_mla_prep<<<TB0 * 8 / 4, 256, 0, stream>>>(QRAW, KVRAW, PROJ, a.in[I_GMQ], a.in[I_GMK], QM, KMT);
    k_dsa_prep<<<TB0 * 8 / 4, 256, 0, stream>>>(PROJ, a.in[I_GDQ], a.in[I_GDK], QD, KDT);
    k_cmp<<<1024, 256, 0, stream>>>(F_heads{(const bf16_t*)(ws + WS_QD), QD, 128, QS_DSA, 0, 0}, (size_t)8 * S_ * 128, ERR, 6, 0.008f, 0.006f * QS_DSA);
    k_cmp<<<1024, 256, 0, stream>>>(F_heads{(const bf16_t*)(ws + WS_KD), KDT, 128, 1.f, 1, 0}, (size_t)8 * S_ * 128, ERR, 7, 0.008f, 0.006f);
    k_cmp<<<1024, 256, 0, stream>>>(F_headcols{(const bf16_t*)(ws + WS_VD), PROJ, INW, OFF_VD, 128, 0}, (size_t)8 * S_ * 128, ERR, 8, 0.008f, 0.006f);
    k_cmp<<<1024, 256, 0, stream>>>(F_heads{(const bf16_t*)(ws + WS_QM), QM, 192, QS_MLA, 0, 1}, (size_t)8 * S_ * 192, ERR, 9, 0.008f, 0.006f * QS_MLA);
    k_cmp<<<1024, 256, 0, stream>>>(F_heads{(const bf16_t*)(ws + WS_KM), KMT, 192, 1.f, 1, 1}, (size_t)8 * S_ * 192, ERR, 10, 0.008f, 0.006f);
    k_cmp<<<1024, 256, 0, stream>>>(F_headcols{(const bf16_t*)(ws + WS_VM), KVRAW, 2048, 128, 256, 0}, (size_t)8 * S_ * 128, ERR, 11, 0.008f, 0.006f);
    nslots = 12;
#endif
#if MK_DEBUG == 2
    for (int ph = 0; ph < 3; ++ph) { a.ph_lo = ph; a.ph_hi = ph + 1; hipLaunchKernelGGL(mk_fwd, dim3(NCU), dim3(NTHR), LDS_BYTES, stream, a); }
    { float* PROJ = (float*)(ws + 288 * MiB); float* H = (float*)(ws + 368 * MiB); float* KIT = (float*)(ws + 400 * MiB); unsigned* MASKN = (unsigned*)(ws + 402 * MiB);
      k_rmsnorm<<<TB0 / 4, 256, 0, stream>>>(x, 2048, 2048, a.in[I_GATTN], H, 2048, TB0);
      k_gemm<<<dim3((INW + 63) / 64, TB0 / 64), 256, 0, stream>>>(H, 2048, a.in[I_WIN], INW, PROJ, INW, TB0, INW, 2048, nullptr, 0);
      k_kit<<<TB0 * 64 / 256, 256, 0, stream>>>(PROJ, KIT);
      k_index<<<TB0 / 2, 128, 0, stream>>>(PROJ, KIT, MASKN);
      k_cmp<<<1024, 256, 0, stream>>>(F_mask{(const unsigned*)(ws + WS_MASK), MASKN}, (size_t)TB0 * 128, ERR, 0, 0.f, 4.0f);
      nslots = 1; }
#endif
#if MK_DEBUG == 3
    for (int ph = 0; ph < 4; ++ph) { a.ph_lo = ph; a.ph_hi = ph + 1; hipLaunchKernelGGL(mk_fwd, dim3(NCU), dim3(NTHR), LDS_BYTES, stream, a); }
    { float* PROJ = (float*)(ws + 288 * MiB); float* H = (float*)(ws + 368 * MiB); float* QRAW = H; float* KVRAW = (float*)(ws + 400 * MiB);
      float* CQN = (float*)(ws + 432 * MiB); float* CKVN = (float*)(ws + 440 * MiB); float* QM = (float*)(ws + 432 * MiB); float* KMT = (float*)(ws + 456 * MiB);
      float* QD = (float*)(ws + 480 * MiB); float* KDT = (float*)(ws + 496 * MiB); float* KIT = (float*)(ws + 368 * MiB); unsigned* MASKN = (unsigned*)(ws + 370 * MiB); float* YN = a.out;
      k_rmsnorm<<<TB0 / 4, 256, 0, stream>>>(x, 2048, 2048, a.in[I_GATTN], H, 2048, TB0);
      k_gemm<<<dim3((INW + 63) / 64, TB0 / 64), 256, 0, stream>>>(H, 2048, a.in[I_WIN], INW, PROJ, INW, TB0, INW, 2048, nullptr, 0);
      k_rmsnorm<<<TB0 / 4, 256, 0, stream>>>(PROJ + OFF_CQ, INW, 512, a.in[I_GCQ], CQN, 512, TB0);
      k_rmsnorm<<<TB0 / 4, 256, 0, stream>>>(PROJ + OFF_CKV, INW, 256, a.in[I_GCKV], CKVN, 256, TB0);
      k_gemm<<<dim3(1536 / 64, TB0 / 64), 256, 0, stream>>>(CQN, 512, a.in[I_WUQ], 1536, QRAW, 1536, TB0, 1536, 512, nullptr, 0);
      k_gemm<<<dim3(2048 / 64, TB0 / 64), 256, 0, stream>>>(CKVN, 256, a.in[I_WUKV], 2048, KVRAW, 2048, TB0, 2048, 256, nullptr, 0);
      k_mla_prep<<<TB0 * 8 / 4, 256, 0, stream>>>(QRAW, KVRAW, PROJ, a.in[I_GMQ], a.in[I_GMK], QM, KMT);
      k_attn<192><<<8 * S_ / 4, 256, 0, stream>>>(QM, KMT, KVRAW, 2048, 128, 256, 0.07216878364870322f, nullptr, nullptr, YN, 0);
      k_dsa_prep<<<TB0 * 8 / 4, 256, 0, stream>>>(PROJ, a.in[I_GDQ], a.in[I_GDK], QD, KDT);
      k_kit<<<TB0 * 64 / 256, 256, 0, stream>>>(PROJ, KIT);
      k_index<<<TB0 / 2, 128, 0, stream>>>(PROJ, KIT, MASKN);
      k_attn<128><<<8 * S_ / 4, 256, 0, stream>>>(QD, KDT, PROJ, INW, OFF_VD, 128, 0.08838834764831845f, (const unsigned*)(ws + WS_MASK), a.in[I_RELB], YN, 1024);
      k_cmp<<<1024, 256, 0, stream>>>(F_ycols{(const f16*)(ws + WS_Y), YN, 0}, (size_t)TB0 * 1024, ERR, 0, 0.02f, 0.004f);
      k_cmp<<<1024, 256, 0, stream>>>(F_ycols{(const f16*)(ws + WS_Y), YN, 1024}, (size_t)TB0 * 1024, ERR, 1, 0.02f, 0.004f);
      nslots = 2; }
#endif
    k_report<<<2048, 256, 0, stream>>>(ERR, nslots, x, a.out, (size_t)T_ * D_);
#endif
    const hipError_t le = hipPeekAtLastError();
    if (le != hipSuccess) fprintf(stderr, "kernel_launch: launch failed: %s\n", hipGetErrorName(le));
}
```

```cpp
#define MK_DEBUG 0
#include <hip/hip_runtime.h>
#include <cstdio>
#include <cstdint>

#define LAS __attribute__((address_space(3)))
#define GAS __attribute__((address_space(1)))
typedef _Float16 f16;
typedef _Float16 f16x8 __attribute__((ext_vector_type(8)));
typedef _Float16 f16x4 __attribute__((ext_vector_type(4)));
typedef _Float16 f16x2 __attribute__((ext_vector_type(2)));
typedef short bf16x8 __attribute__((ext_vector_type(8)));
typedef short s16x4 __attribute__((ext_vector_type(4)));
typedef unsigned short bf16_t;
typedef float f32x2 __attribute__((ext_vector_type(2)));
typedef float f32x4 __attribute__((ext_vector_type(4)));
typedef float f32x8 __attribute__((ext_vector_type(8)));
typedef float f32x16 __attribute__((ext_vector_type(16)));
typedef unsigned u32x2 __attribute__((ext_vector_type(2)));
typedef unsigned u32x4 __attribute__((ext_vector_type(4)));

constexpr int B_ = 2, S_ = 4096, D_ = 2048, T_ = B_ * S_;
constexpr int INW = 5008;
constexpr int OFF_CQ = 0, OFF_CKV = 512, OFF_KR = 768, OFF_QD = 832, OFF_KD = 1856, OFF_VD = 2880, OFF_QI = 3904, OFF_KI = 4928, OFF_WI = 4992;
constexpr float EPS = 1e-6f;
constexpr float LOG2E = 1.4426950408889634f;
constexpr float QS_MLA = 0.07216878364870322f * LOG2E;
constexpr float QS_DSA = 0.08838834764831845f * LOG2E;
constexpr int NCU = 256, NTHR = 512, NWAVES = 8;

constexpr size_t MiB = 1u << 20;
constexpr size_t WS_CTL = 0, CTL_ZERO_BYTES = 64 * 1024;
constexpr size_t WS_WT_IN = 1 * MiB, WS_WT_UQ = 21 * MiB, WS_WT_UKV = 23 * MiB, WS_WT_O = 24 * MiB, WS_WT_PQ = 32 * MiB, WS_SK16 = 40 * MiB, WS_CS = 41 * MiB;
constexpr size_t WS_XN = 42 * MiB, WS_CQ = 74 * MiB, WS_CKV = 82 * MiB, WS_SSQ_CQ = 86 * MiB, WS_SSQ_CKV = 86 * MiB + 256 * 1024, WS_SSQ_KR = 86 * MiB + 384 * 1024;
constexpr size_t WS_SSQ2 = 87 * MiB, WS_KR = 88 * MiB, WS_WI = 90 * MiB, WS_KI = 91 * MiB, WS_QI = 92 * MiB;
constexpr size_t WS_QD = 108 * MiB, WS_KD = 124 * MiB, WS_VD = 140 * MiB, WS_QM = 156 * MiB, WS_KM = 180 * MiB, WS_VM = 204 * MiB, WS_MASK = 220 * MiB;
constexpr size_t WS_Y = 224 * MiB, WS_QR = 256 * MiB, WS_U16 = 288 * MiB, WS_V16 = 352 * MiB, WS_END = 416 * MiB;
constexpr size_t WS_USCL = 320 * MiB, WS_VSCL = 384 * MiB;
constexpr size_t WS_DBG = 288 * MiB;

#ifndef TAB_U_FP4
#define TAB_U_FP4 1
#endif
#ifndef TAB_V_FP4
#define TAB_V_FP4 1
#endif
constexpr int U_ROWB = TAB_U_FP4 ? 1024 : 1536, V_ROWB = TAB_V_FP4 ? 1024 : 1536;

constexpr int RING_OFF = 0, RING_BYTES = 131072;
constexpr int EPI_OFF = RING_BYTES;
constexpr int R2S_OFF = EPI_OFF + 8192 + 2048;
constexpr int MISC_OFF = 163840 - 256;
constexpr int LDS_BYTES = 163840;

#define LDS_WAIT() asm volatile("s_waitcnt lgkmcnt(0)" ::: "memory")
#define VM_WAIT() asm volatile("s_waitcnt vmcnt(0)" ::: "memory")
#define WG_BAR() do { asm volatile("s_waitcnt lgkmcnt(0)" ::: "memory"); __builtin_amdgcn_s_barrier(); asm volatile("" ::: "memory"); } while (0)

__device__ __forceinline__ unsigned cvt_pk_bf16(float lo, float hi) { unsigned r; asm volatile("v_cvt_pk_bf16_f32 %0, %1, %2" : "=v"(r) : "v"(lo), "v"(hi)); return r; }
__device__ __forceinline__ u32x4 pack_bf16x8(const f32x4 a, const f32x4 b) { u32x4 w; w.x = cvt_pk_bf16(a[0], a[1]); w.y = cvt_pk_bf16(a[2], a[3]); w.z = cvt_pk_bf16(b[0], b[1]); w.w = cvt_pk_bf16(b[2], b[3]); return w; }
__device__ __forceinline__ f16x8 pack_f16x8(const f32x4 a, const f32x4 b) { f16x8 w; w[0] = (f16)a[0]; w[1] = (f16)a[1]; w[2] = (f16)a[2]; w[3] = (f16)a[3]; w[4] = (f16)b[0]; w[5] = (f16)b[1]; w[6] = (f16)b[2]; w[7] = (f16)b[3]; return w; }
__device__ __forceinline__ float wave_sum(float v) {
#pragma unroll
  for (int o = 1; o < 64; o <<= 1) v += __shfl_xor(v, o);
  return v;
}
__device__ __forceinline__ float wave_max(float v) {
#pragma unroll
  for (int o = 1; o < 64; o <<= 1) v = fmaxf(v, __shfl_xor(v, o));
  return v;
}
__device__ __forceinline__ int lane_id_v() { int l; asm volatile("v_mbcnt_lo_u32_b32 %0, -1, 0\n\tv_mbcnt_hi_u32_b32 %0, -1, %0" : "=v"(l)); return l; }
template <int N> __device__ __forceinline__ int dpp_row_ror(int x) { return __builtin_amdgcn_update_dpp(0, x, 0x120 + N, 0xf, 0xf, false); }
__device__ __forceinline__ int row_sum_i32(int x) { x += dpp_row_ror<1>(x); x += dpp_row_ror<2>(x); x += dpp_row_ror<4>(x); x += dpp_row_ror<8>(x); return x; }
__device__ __forceinline__ float sum4(const f32x4 v) { return (v[0] + v[1]) + (v[2] + v[3]); }
__device__ __forceinline__ float ssq4(const f32x4 v) { return (v[0] * v[0] + v[1] * v[1]) + (v[2] * v[2] + v[3] * v[3]); }

__device__ __forceinline__ int t5_bucket(int rel) {
  const int n = rel < 0 ? -rel : rel;
  int bkt;
  if (n < 8) bkt = n; else if (n < 12) bkt = 8; else if (n < 16) bkt = 9; else if (n < 23) bkt = 10; else if (n < 32) bkt = 11;
  else if (n < 46) bkt = 12; else if (n < 64) bkt = 13; else if (n < 91) bkt = 14; else bkt = 15;
  return bkt + (rel > 0 ? 16 : 0);
}

namespace pg8 {
constexpr int BM = 256, BK = 64, HALF = 128, HTB = HALF * BK * 2, STAGE_BYTES = 8 * HTB, NXCD = 8, WGM = 8;
__host__ __device__ __forceinline__ int lds_byte(int r, int c) { const int st = (r >> 4) * 2 + (c >> 5), rr = r & 15, cc = c & 31, ob = rr * 64 + cc * 2; return st * 1024 + (ob ^ (((ob >> 9) & 1) << 5)); }
__host__ __device__ __forceinline__ void stage_rc(int b, int& R, int& C) { const int st = b / 1024, sb = b % 1024, swz = sb ^ (((sb >> 9) & 1) << 5); R = (st >> 1) * 16 + swz / 64; C = (st & 1) * 32 + (swz % 64) / 2; }
__host__ __device__ __forceinline__ int perm32(int rho) { const int n = rho >> 4, i = rho & 15; return 8 * (i >> 2) + 4 * n + (i & 3); }
struct Unit { int pm, pn; };
struct Gemm { const f16* A; const f16* Bt; int M, N, K; };
struct StaticOrder {
    int nM, nN, nwg, G, c;
    __host__ __device__ __forceinline__ void init(int M, int N, int G_, int c_) { nM = M / BM; nN = N / BM; nwg = nM * nN; G = G_; c = c_; }
    __host__ __device__ __forceinline__ bool next(int i, Unit& u) const {
        const long L = (long)i * G + c; if (L >= nwg || c < 0) return false;
        int wgid = (int)L; { const int q = nwg / NXCD, r = nwg % NXCD, xcd = wgid % NXCD, off = wgid / NXCD; wgid = (xcd < r ? xcd * (q + 1) : r * (q + 1) + (xcd - r) * q) + off; }
        const int nig = WGM * nN, gid = wgid / nig, fm = gid * WGM, gsz = (nM - fm) < WGM ? (nM - fm) : WGM;
        u.pm = fm + ((wgid % nig) % gsz); u.pn = (wgid % nig) / gsz; return true;
    }
    __device__ __forceinline__ void a_ready(const Unit&) const {}
    __device__ __forceinline__ void done(const Unit&) const {}
};

template <class Epi, class Sched, bool ALIGN_EPI = true, bool SP2 = true>
__device__ __forceinline__ void gemm_phase(LAS unsigned char* lds, const Gemm g, const Sched& S, const Epi& E, int wave_sgpr) {
    const int wid = wave_sgpr, lane = lane_id_v(), tid = wid * 64 + lane, wr = wid >> 2, wc = wid & 3, fr = lane & 15, fq = lane >> 4;
    const int K = g.K, nt = K / BK;
    unsigned voffA[2], voffB[2];
#pragma unroll
    for (int i = 0; i < 2; ++i) { int R, C; stage_rc(tid * 16 + i * 8192, R, C); const int Rb = Epi::PERM ? ((R & ~31) + perm32(R & 31)) : R;
        voffA[i] = (unsigned)(R * K + C) * 2u; voffB[i] = (unsigned)(Rb * K + C) * 2u; }
    const size_t kstep = (size_t)(BK * 2);
    const size_t hstep = (size_t)HALF * K * 2;
    const size_t tstep = 2 * hstep;
    const unsigned ldsw = (unsigned)wid * 1024u;
    const int aoff = lds_byte(wr * 64 + fr, fq * 8), boff = lds_byte(wc * 32 + fr, fq * 8);
#define PG8_SA(b, h) (((b) * 2 + (h)) * HTB)
#define PG8_SB(b, h) ((4 + (b) * 2 + (h)) * HTB)
#define PG8_STAGE(bufoff, gbase, voff) do { _Pragma("unroll") for (int _i = 0; _i < 2; ++_i) \
        __builtin_amdgcn_global_load_lds((const unsigned*)((const char*)(gbase) + (voff)[_i]), (LAS unsigned*)(lds + (bufoff) + ldsw + _i * 8192), 16, 0, 0); } while (0)
#define PG8_LDA(dst, b, h) do { _Pragma("unroll") for (int m = 0; m < 4; ++m) _Pragma("unroll") for (int k = 0; k < 2; ++k) dst[m][k] = *(const LAS f16x8*)(lds + PG8_SA(b, h) + aoff + m * 2048 + k * 1024); } while (0)
#define PG8_LDB(dst, b, h) do { _Pragma("unroll") for (int n = 0; n < 2; ++n) _Pragma("unroll") for (int k = 0; k < 2; ++k) dst[n][k] = *(const LAS f16x8*)(lds + PG8_SB(b, h) + boff + n * 2048 + k * 1024); } while (0)
#define PG8_MMA(ai, bj, At, Bt) do { __builtin_amdgcn_s_setprio(1); _Pragma("unroll") for (int m = 0; m < 4; ++m) _Pragma("unroll") for (int n = 0; n < 2; ++n) _Pragma("unroll") for (int k = 0; k < 2; ++k) \
        acc[ai][bj][m][n] = __builtin_amdgcn_mfma_f32_16x16x32_f16(Bt[n][k], At[m][k], acc[ai][bj][m][n], 0, 0, 0); __builtin_amdgcn_s_setprio(0); } while (0)
#define PG8_WAIT_V(n) asm volatile("s_waitcnt vmcnt(" #n ")" ::: "memory")
#define PG8_WAIT_L(n) asm volatile("s_waitcnt lgkmcnt(" #n ")" ::: "memory")
#define PG8_BAR __builtin_amdgcn_s_barrier()
#define PG8_SCHED __builtin_amdgcn_sched_barrier(0)
    Unit cur, nxt; int ui = 0;
    if (!S.next(0, cur)) return;
    f32x4 acc[2][2][4][2];
#pragma unroll
    for (int a = 0; a < 2; ++a)
#pragma unroll
        for (int b = 0; b < 2; ++b)
#pragma unroll
            for (int m = 0; m < 4; ++m)
#pragma unroll
                for (int n = 0; n < 2; ++n) acc[a][b][m][n] = (f32x4){0.f, 0.f, 0.f, 0.f};
    f16x8 At[4][2], B0[2][2], B1[2][2];
    const char* cA = (const char*)g.A + (size_t)cur.pm * tstep; const char* cB = (const char*)g.Bt + (size_t)cur.pn * tstep;
    S.a_ready(cur);
    if constexpr (SP2) {
        PG8_STAGE(PG8_SB(0, 0), cB, voffB); PG8_STAGE(PG8_SB(0, 1), cB + hstep, voffB); PG8_STAGE(PG8_SA(0, 0), cA, voffA); PG8_STAGE(PG8_SA(0, 1), cA + hstep, voffA);
        if (wr == 1) PG8_BAR;
        PG8_WAIT_V(2); PG8_BAR;
        PG8_STAGE(PG8_SB(1, 0), cB + kstep, voffB); PG8_STAGE(PG8_SA(1, 0), cA + kstep, voffA); PG8_STAGE(PG8_SB(1, 1), cB + hstep + kstep, voffB);
        PG8_WAIT_V(6); PG8_BAR;
    } else {
        PG8_STAGE(PG8_SB(0, 0), cB, voffB); PG8_STAGE(PG8_SA(0, 0), cA, voffA); PG8_STAGE(PG8_SB(0, 1), cB + hstep, voffB); PG8_STAGE(PG8_SA(0, 1), cA + hstep, voffA);
        if (wr == 1) PG8_BAR;
        PG8_WAIT_V(4); PG8_BAR;
        PG8_STAGE(PG8_SB(1, 0), cB + kstep, voffB); PG8_STAGE(PG8_SA(1, 0), cA + kstep, voffA); PG8_STAGE(PG8_SB(1, 1), cB + hstep + kstep, voffB);
        PG8_WAIT_V(6); PG8_BAR;
    }
    for (;;) {
        const bool has_next = S.next(ui + 1, nxt);
        const char* nA = has_next ? (const char*)g.A + (size_t)nxt.pm * tstep : cA; const char* nB = has_next ? (const char*)g.Bt + (size_t)nxt.pn * tstep : cB;
#pragma unroll 1
        for (int t = 0; t < nt; t += 2) {
            const bool last = (t == nt - 2);
            const char* a1 = cA + (size_t)(t + 1) * kstep;
            const char* a2 = last ? nA : cA + (size_t)(t + 2) * kstep; const char* b2 = last ? nB : cB + (size_t)(t + 2) * kstep;
            const char* a3 = a2 + kstep; const char* b3 = b2 + kstep;
            if (last && has_next) S.a_ready(nxt);
            if constexpr (SP2) {
            PG8_LDB(B0, 0, 0); PG8_LDB(B1, 0, 1); PG8_SCHED; PG8_LDA(At, 0, 0); PG8_STAGE(PG8_SA(1, 1), a1 + hstep, voffA);
            PG8_WAIT_V(8); PG8_WAIT_L(0); PG8_BAR; PG8_MMA(0, 0, At, B0); PG8_MMA(0, 1, At, B1); PG8_BAR; PG8_SCHED;
            PG8_LDA(At, 0, 1); PG8_STAGE(PG8_SB(0, 0), b2, voffB); PG8_STAGE(PG8_SB(0, 1), b2 + hstep, voffB); PG8_STAGE(PG8_SA(0, 0), a2, voffA);
            PG8_WAIT_V(8); PG8_WAIT_L(0); PG8_BAR; PG8_MMA(1, 0, At, B0); PG8_MMA(1, 1, At, B1); PG8_BAR; PG8_SCHED;
            PG8_LDB(B0, 1, 0); PG8_LDB(B1, 1, 1); PG8_SCHED; PG8_LDA(At, 1, 0); PG8_STAGE(PG8_SA(0, 1), a2 + hstep, voffA);
            PG8_WAIT_V(8); PG8_WAIT_L(0); PG8_BAR; PG8_MMA(0, 0, At, B0); PG8_MMA(0, 1, At, B1); PG8_BAR; PG8_SCHED;
            PG8_LDA(At, 1, 1); PG8_STAGE(PG8_SB(1, 0), b3, voffB); PG8_STAGE(PG8_SB(1, 1), b3 + hstep, voffB); PG8_STAGE(PG8_SA(1, 0), a3, voffA);
            PG8_WAIT_V(8); PG8_WAIT_L(0); PG8_BAR; PG8_MMA(1, 0, At, B0); PG8_MMA(1, 1, At, B1); PG8_BAR; PG8_SCHED;
            } else {
            PG8_LDB(B0, 0, 0); PG8_SCHED; PG8_LDA(At, 0, 0); PG8_STAGE(PG8_SA(1, 1), a1 + hstep, voffA);
            PG8_WAIT_L(8); PG8_BAR; PG8_WAIT_L(0); PG8_MMA(0, 0, At, B0); PG8_BAR; PG8_SCHED;
            PG8_LDB(B1, 0, 1); PG8_STAGE(PG8_SB(0, 0), b2, voffB);
            PG8_BAR; PG8_WAIT_L(0); PG8_MMA(0, 1, At, B1); PG8_BAR;
            PG8_LDA(At, 0, 1); PG8_STAGE(PG8_SA(0, 0), a2, voffA);
            PG8_BAR; PG8_WAIT_L(0); PG8_MMA(1, 0, At, B0); PG8_BAR; PG8_SCHED;
            PG8_STAGE(PG8_SB(0, 1), b2 + hstep, voffB);
            PG8_WAIT_V(6); PG8_BAR; PG8_MMA(1, 1, At, B1); PG8_BAR;
            PG8_LDB(B0, 1, 0); PG8_SCHED; PG8_LDA(At, 1, 0); PG8_STAGE(PG8_SA(0, 1), a2 + hstep, voffA);
            PG8_WAIT_L(8); PG8_BAR; PG8_WAIT_L(0); PG8_MMA(0, 0, At, B0); PG8_BAR; PG8_SCHED;
            PG8_LDB(B1, 1, 1); PG8_STAGE(PG8_SB(1, 0), b3, voffB);
            PG8_BAR; PG8_WAIT_L(0); PG8_MMA(0, 1, At, B1); PG8_BAR;
            PG8_LDA(At, 1, 1); PG8_STAGE(PG8_SA(1, 0), a3, voffA);
            PG8_BAR; PG8_WAIT_L(0); PG8_MMA(1, 0, At, B0); PG8_BAR; PG8_SCHED;
            PG8_STAGE(PG8_SB(1, 1), b3 + hstep, voffB);
            PG8_WAIT_V(6); PG8_BAR; PG8_MMA(1, 1, At, B1); PG8_BAR;
            }
        }
        if constexpr (ALIGN_EPI) { if (wr == 0) PG8_BAR; }
        E(acc, cur, wr, wc, fr, fq);
        if (!has_next) break;
#pragma unroll
        for (int a = 0; a < 2; ++a)
#pragma unroll
            for (int b = 0; b < 2; ++b)
#pragma unroll
                for (int m = 0; m < 4; ++m)
#pragma unroll
                    for (int n = 0; n < 2; ++n) acc[a][b][m][n] = (f32x4){0.f, 0.f, 0.f, 0.f};
        cur = nxt; cA = nA; cB = nB; ++ui;
        if constexpr (ALIGN_EPI) { if (wr == 1) PG8_BAR; }
    }
    PG8_WAIT_V(0);
    if constexpr (!ALIGN_EPI) { if (wr == 0) PG8_BAR; }
    PG8_BAR;
#undef PG8_SA
#undef PG8_SB
#undef PG8_STAGE
#undef PG8_LDA
#undef PG8_LDB
#undef PG8_MMA
#undef PG8_WAIT_V
#undef PG8_WAIT_L
#undef PG8_BAR
#undef PG8_SCHED
}
}

typedef f32x4 AccT[2][2][4][2];
#define FOR_AI_M _Pragma("unroll") for (int ai = 0; ai < 2; ++ai) _Pragma("unroll") for (int m = 0; m < 4; ++m)

__device__ __forceinline__ float fq_sum(float s) { s += __shfl_xor(s, 16); s += __shfl_xor(s, 32); return s; }

__device__ __forceinline__ f32x4 rope_freq4(int i0) { f32x4 f;
#pragma unroll
    for (int k = 0; k < 4; ++k) f[k] = __builtin_amdgcn_exp2f(-(float)(i0 + k) * (2.0f / 64.0f) * 13.287712379549449f) * 0.15915494309189535f; return f; }
__device__ __forceinline__ void rope_cs4(const f32x4 fr4, int s, f32x4& c0, f32x4& c1) {
    const float sf = (float)s;
    float r0 = sf * fr4[0], r1 = sf * fr4[1], r2 = sf * fr4[2], r3 = sf * fr4[3];
    r0 -= floorf(r0); r1 -= floorf(r1); r2 -= floorf(r2); r3 -= floorf(r3);
    c0 = (f32x4){__builtin_amdgcn_cosf(r0), __builtin_amdgcn_sinf(r0), __builtin_amdgcn_cosf(r1), __builtin_amdgcn_sinf(r1)};
    c1 = (f32x4){__builtin_amdgcn_cosf(r2), __builtin_amdgcn_sinf(r2), __builtin_amdgcn_cosf(r3), __builtin_amdgcn_sinf(r3)};
}
struct EpiIn {
    static constexpr bool PERM = true;
    f16* CQ; f16* CKV; float* SSQ_CQ; float* SSQ_CKV; bf16_t* Qd; bf16_t* Kd; f16* QI; f16* KI; float* WI; float* KR; float* SSQ_KR;
    const float* g_dq; const float* g_dk; const float* g_mk; const float* CS;
    LAS float* P;
    __device__ __forceinline__ void operator()(const AccT& acc, const pg8::Unit& u_, int wr, int wc, int fr, int fq) const {
        pg8::Unit u = u_; asm volatile("" : "+s"(u.pm), "+s"(u.pn), "+v"(fr), "+v"(fq));
        const int pn = u.pn, row0 = u.pm * 256 + wr * 64 + fr, cl = wc * 32 + fq * 8;
        if (pn < 3) {
            FOR_AI_M { const int row = row0 + ai * 128 + m * 16; float ss = 0.f;
#pragma unroll
                for (int bj = 0; bj < 2; ++bj) { const f32x4 a = acc[ai][bj][m][0], b = acc[ai][bj][m][1]; ss += ssq4(a) + ssq4(b);
                    if (pn < 2) *(f16x8*)(CQ + (size_t)row * 512 + pn * 256 + bj * 128 + cl) = pack_f16x8(a, b);
                    else *(f16x8*)(CKV + (size_t)row * 256 + bj * 128 + cl) = pack_f16x8(a, b); }
                ss = fq_sum(ss);
                if (fq == 0) { if (pn < 2) SSQ_CQ[(size_t)row * 8 + pn * 4 + wc] = ss; else SSQ_CKV[(size_t)row * 4 + wc] = ss; } }
        } else if (pn < 11) {
            FOR_AI_M { const int rl = ai * 128 + wr * 64 + m * 16 + fr;
#pragma unroll
                for (int bj = 0; bj < 2; ++bj) { float ss = fq_sum(ssq4(acc[ai][bj][m][0]) + ssq4(acc[ai][bj][m][1])); if (fq == 0) P[(bj * 256 + rl) * 4 + wc] = ss; } }
            WG_BAR();
            const bool isq = pn < 7; const float* g = isq ? g_dq : g_dk; const float qs = isq ? QS_DSA : 1.0f;
            const f32x4 g0 = *(const f32x4*)(g + cl) * qs, g1 = *(const f32x4*)(g + cl + 4) * qs;
            bf16_t* O = isq ? Qd : Kd; const int hb = (isq ? pn - 3 : pn - 7) * 2;
            FOR_AI_M { const int rl = ai * 128 + wr * 64 + m * 16 + fr, row = u.pm * 256 + rl, b = row >> 12, s = row & 4095;
#pragma unroll
                for (int bj = 0; bj < 2; ++bj) { const f32x4 p4 = *(const LAS f32x4*)(P + (bj * 256 + rl) * 4); const float r = 1.0f / sqrtf(sum4(p4) * (1.0f / 128.0f) + EPS);
                    *(u32x4*)(O + ((size_t)(b * 8 + hb + bj) * S_ + s) * 128 + cl) = pack_bf16x8(acc[ai][bj][m][0] * r * g0, acc[ai][bj][m][1] * r * g1); } }
        } else if (pn < 15) {
            FOR_AI_M { const int row = row0 + ai * 128 + m * 16;
#pragma unroll
                for (int bj = 0; bj < 2; ++bj) *(f16x8*)(QI + (size_t)row * 1024 + (pn - 11) * 256 + bj * 128 + cl) = pack_f16x8(acc[ai][bj][m][0] * 0.125f, acc[ai][bj][m][1] * 0.125f); }
        } else {
            FOR_AI_M { const int row = row0 + ai * 128 + m * 16, s = row & 4095;
                if (wc < 2) {
                    const f32x4 a = acc[ai][0][m][0], b = acc[ai][0][m][1];
                    const float ss = fq_sum(ssq4(a) + ssq4(b)); if (fq == 0) SSQ_KR[(size_t)row * 2 + wc] = ss;
                    const int i0 = cl >> 1;
                    const f32x4 ga = *(const f32x4*)(g_mk + 128 + i0), gb = *(const f32x4*)(g_mk + 160 + i0);
                    f32x4 c0, c1; rope_cs4(rope_freq4(i0), s, c0, c1);
                    f32x4 o0, o1;
                    { const float x1 = a[0] * ga[0], x2 = a[1] * gb[0]; o0[0] = x1 * c0[0] - x2 * c0[1]; o0[1] = x1 * c0[1] + x2 * c0[0]; }
                    { const float x1 = a[2] * ga[1], x2 = a[3] * gb[1]; o0[2] = x1 * c0[2] - x2 * c0[3]; o0[3] = x1 * c0[3] + x2 * c0[2]; }
                    { const float x1 = b[0] * ga[2], x2 = b[1] * gb[2]; o1[0] = x1 * c1[0] - x2 * c1[1]; o1[1] = x1 * c1[1] + x2 * c1[0]; }
                    { const float x1 = b[2] * ga[3], x2 = b[3] * gb[3]; o1[2] = x1 * c1[2] - x2 * c1[3]; o1[3] = x1 * c1[3] + x2 * c1[2]; }
                    *(f32x4*)(KR + (size_t)row * 64 + cl) = o0; *(f32x4*)(KR + (size_t)row * 64 + cl + 4) = o1;
                } else {
                    *(f16x8*)(KI + (size_t)row * 64 + (cl - 64)) = pack_f16x8(acc[ai][0][m][0], acc[ai][0][m][1]);
                }
                if (wc == 0 && fq < 2) {
                    *(f32x4*)(WI + (size_t)row * 16 + cl) = acc[ai][1][m][0]; *(f32x4*)(WI + (size_t)row * 16 + cl + 4) = acc[ai][1][m][1];
                } }
        }
    }
};

struct EpiVd {
    static constexpr bool PERM = true;
    bf16_t* Vd;
    __device__ __forceinline__ void operator()(const AccT& acc, const pg8::Unit& u_, int wr, int wc, int fr, int fq) const {
        pg8::Unit u = u_; asm volatile("" : "+s"(u.pm), "+s"(u.pn), "+v"(fr), "+v"(fq));
        const int row0 = u.pm * 256 + wr * 64 + fr, cl = wc * 32 + fq * 8;
        FOR_AI_M { const int row = row0 + ai * 128 + m * 16, b = row >> 12, s = row & 4095;
#pragma unroll
            for (int bj = 0; bj < 2; ++bj) *(u32x4*)(Vd + ((size_t)(b * 8 + u.pn * 2 + bj) * S_ + s) * 128 + cl) = pack_bf16x8(acc[ai][bj][m][0], acc[ai][bj][m][1]); }
    }
};

struct EpiQup {
    static constexpr bool PERM = true;
    bf16_t* Qm; const float* SSQ_CQ; const float* g_mq; const float* CS; LAS float* P;
    __device__ __forceinline__ void operator()(AccT& acc, const pg8::Unit& u_, int wr, int wc, int fr, int fq) const {
        pg8::Unit u = u_; asm volatile("" : "+s"(u.pm), "+s"(u.pn), "+v"(fr), "+v"(fq));
        const int cl = wc * 32 + fq * 8, h = u.pn;
        LAS float* RQ = P + 2048;
        { const int tid_ = (wr * 4 + wc) * 64 + fq * 16 + fr;
          if (tid_ < 256) { const float* sp = SSQ_CQ + (size_t)(u.pm * 256 + tid_) * 8; RQ[tid_] = 1.0f / sqrtf((sum4(*(const f32x4*)sp) + sum4(*(const f32x4*)(sp + 4))) * (1.0f / 512.0f) + EPS); } }
        WG_BAR();
        FOR_AI_M { const int rl = ai * 128 + wr * 64 + m * 16 + fr;
            const float rq = RQ[rl];
#pragma unroll
            for (int bj = 0; bj < 2; ++bj) { acc[ai][bj][m][0] *= rq; acc[ai][bj][m][1] *= rq;
                const float ss = fq_sum(ssq4(acc[ai][bj][m][0]) + ssq4(acc[ai][bj][m][1])); if (fq == 0) P[(bj * 256 + rl) * 4 + wc] = ss; } asm volatile("" ::: "memory"); }
        WG_BAR();
        const f32x4 g0 = *(const f32x4*)(g_mq + cl) * QS_MLA, g1 = *(const f32x4*)(g_mq + cl + 4) * QS_MLA;
        const int i0 = cl >> 1;
        f32x4 ga = {0.f, 0.f, 0.f, 0.f}, gb = {0.f, 0.f, 0.f, 0.f};
        if (wc < 2) { ga = *(const f32x4*)(g_mq + 128 + i0) * QS_MLA; gb = *(const f32x4*)(g_mq + 160 + i0) * QS_MLA; }
        const f32x4 fr4 = rope_freq4(i0);
        FOR_AI_M { const int rl = ai * 128 + wr * 64 + m * 16 + fr, row = u.pm * 256 + rl, b = row >> 12, s = row & 4095;
            const f32x4 p0 = *(const LAS f32x4*)(P + rl * 4), p1 = *(const LAS f32x4*)(P + (256 + rl) * 4);
            const float r = 1.0f / sqrtf((sum4(p0) + sum4(p1)) * (1.0f / 192.0f) + EPS);
            bf16_t* o = Qm + ((size_t)(b * 8 + h) * S_ + s) * 192;
            *(u32x4*)(o + cl) = pack_bf16x8(acc[ai][0][m][0] * r * g0, acc[ai][0][m][1] * r * g1);
            if (wc < 2) {
                const f32x4 a = acc[ai][1][m][0] * r, bq = acc[ai][1][m][1] * r;
                f32x4 c0, c1; rope_cs4(fr4, s, c0, c1);
                f32x4 o0, o1;
                { const float x1 = a[0] * ga[0], x2 = a[1] * gb[0]; o0[0] = x1 * c0[0] - x2 * c0[1]; o0[1] = x1 * c0[1] + x2 * c0[0]; }
                { const float x1 = a[2] * ga[1], x2 = a[3] * gb[1]; o0[2] = x1 * c0[2] - x2 * c0[3]; o0[3] = x1 * c0[3] + x2 * c0[2]; }
                { const float x1 = bq[0] * ga[2], x2 = bq[1] * gb[2]; o1[0] = x1 * c1[0] - x2 * c1[1]; o1[1] = x1 * c1[1] + x2 * c1[0]; }
                { const float x1 = bq[2] * ga[3], x2 = bq[3] * gb[3]; o1[2] = x1 * c1[2] - x2 * c1[3]; o1[3] = x1 * c1[3] + x2 * c1[2]; }
                *(u32x4*)(o + 128 + cl) = pack_bf16x8(o0, o1);
            } asm volatile("" ::: "memory"); }
    }
};

struct EpiKVup {
    static constexpr bool PERM = true;
    bf16_t* Km; bf16_t* Vm; const float* SSQ_CKV; const float* SSQ_KR; const float* KR; const float* g_mk; LAS float* P;
    __device__ __forceinline__ void operator()(AccT& acc, const pg8::Unit& u_, int wr, int wc, int fr, int fq) const {
        pg8::Unit u = u_; asm volatile("" : "+s"(u.pm), "+s"(u.pn), "+v"(fr), "+v"(fq));
        const int cl = wc * 32 + fq * 8, h = u.pn;
        LAS float* RKV = P + 2048; LAS float* SKR = P + 2048 + 256;
        { const int tid_ = (wr * 4 + wc) * 64 + fq * 16 + fr;
          if (tid_ < 256) { const int row_ = u.pm * 256 + tid_; RKV[tid_] = 1.0f / sqrtf(sum4(*(const f32x4*)(SSQ_CKV + (size_t)row_ * 4)) * (1.0f / 256.0f) + EPS);
                            SKR[tid_] = SSQ_KR[(size_t)row_ * 2] + SSQ_KR[(size_t)row_ * 2 + 1]; } }
        WG_BAR();
        FOR_AI_M { const int rl = ai * 128 + wr * 64 + m * 16 + fr, row = u.pm * 256 + rl, b = row >> 12, s = row & 4095;
            const float rkv = RKV[rl];
            acc[ai][0][m][0] *= rkv; acc[ai][0][m][1] *= rkv;
            const float ss = fq_sum(ssq4(acc[ai][0][m][0]) + ssq4(acc[ai][0][m][1])); if (fq == 0) P[rl * 4 + wc] = ss;
            *(u32x4*)(Vm + ((size_t)(b * 8 + h) * S_ + s) * 128 + cl) = pack_bf16x8(acc[ai][1][m][0] * rkv, acc[ai][1][m][1] * rkv); asm volatile("" ::: "memory"); }
        WG_BAR();
        const f32x4 g0 = *(const f32x4*)(g_mk + cl), g1 = *(const f32x4*)(g_mk + cl + 4);
        const int rc = wc * 16 + fq * 4;
        f32x4 krp[2][4];
        FOR_AI_M krp[ai][m] = *(const f32x4*)(KR + (size_t)(u.pm * 256 + ai * 128 + wr * 64 + m * 16 + fr) * 64 + rc);
        FOR_AI_M { const int rl = ai * 128 + wr * 64 + m * 16 + fr, row = u.pm * 256 + rl, b = row >> 12, s = row & 4095;
            const f32x4 p0 = *(const LAS f32x4*)(P + rl * 4);
            const float tot = sum4(p0) + SKR[rl];
            const float r = 1.0f / sqrtf(tot * (1.0f / 192.0f) + EPS);
            bf16_t* o = Km + ((size_t)(b * 8 + h) * S_ + s) * 192;
            *(u32x4*)(o + cl) = pack_bf16x8(acc[ai][0][m][0] * r * g0, acc[ai][0][m][1] * r * g1);
            const f32x4 kr = krp[ai][m] * r;
            u32x2 w; w.x = cvt_pk_bf16(kr[0], kr[1]); w.y = cvt_pk_bf16(kr[2], kr[3]);
            *(u32x2*)(o + 128 + rc) = w; asm volatile("" ::: "memory"); }
    }
};

struct EpiOut {
    static constexpr bool PERM = true;
    const float* x; float* X2; f16* X2H; float* SSQ2;
    __device__ __forceinline__ void operator()(const AccT& acc, const pg8::Unit& u_, int wr, int wc, int fr, int fq) const {
        pg8::Unit u = u_; asm volatile("" : "+s"(u.pm), "+s"(u.pn), "+v"(fr), "+v"(fq));
        const int row0 = u.pm * 256 + wr * 64 + fr, cl = wc * 32 + fq * 8;
        FOR_AI_M { const int row = row0 + ai * 128 + m * 16; float ss = 0.f;
#pragma unroll
            for (int bj = 0; bj < 2; ++bj) { const size_t off = (size_t)row * 2048 + u.pn * 256 + bj * 128 + cl;
                const f32x4 a = acc[ai][bj][m][0] + *(const f32x4*)(x + off), b = acc[ai][bj][m][1] + *(const f32x4*)(x + off + 4);
                *(f16x8*)(X2H + off) = pack_f16x8(a, b); ss += ssq4(a) + ssq4(b); }
            ss = fq_sum(ss); if (fq == 0) SSQ2[(size_t)row * 32 + u.pn * 4 + wc] = ss; }
    }
};

struct EpiQr {
    static constexpr bool PERM = true;
    f16* QR; const LAS float* R2s;
    __device__ __forceinline__ void operator()(const AccT& acc, const pg8::Unit& u_, int wr, int wc, int fr, int fq) const {
        pg8::Unit u = u_; asm volatile("" : "+s"(u.pm), "+s"(u.pn), "+v"(fr), "+v"(fq));
        const int cl = wc * 32 + fq * 8;
        FOR_AI_M { const int rl = ai * 128 + wr * 64 + m * 16 + fr, row = u.pm * 256 + rl; const float r = R2s[rl];
#pragma unroll
            for (int bj = 0; bj < 2; ++bj) *(f16x8*)(QR + (size_t)row * 2048 + u.pn * 256 + bj * 128 + cl) = pack_f16x8(acc[ai][bj][m][0] * r, acc[ai][bj][m][1] * r); }
    }
};

#define XB_TMO      128
#define XB_XCNT(j)  (256  + 64 * (j))
#define XB_XSUB(j)  (1280 + 64 * (j))
#define XB_XGEN(j)  (2304 + 64 * (j))
#define XB_TOP      3328
#define XB_TOPGEN   3392
#define XCD_BAR_WORDS 3456
#define XB_SPIN_CAP (1u << 22)
__device__ __forceinline__ unsigned xb_ld(unsigned* p)              { return __hip_atomic_load(p, __ATOMIC_RELAXED, __HIP_MEMORY_SCOPE_AGENT); }
__device__ __forceinline__ unsigned xb_add(unsigned* p, unsigned v) { return __hip_atomic_fetch_add(p, v, __ATOMIC_RELAXED, __HIP_MEMORY_SCOPE_AGENT); }
__device__ __forceinline__ unsigned xb_xcc_id() { return (unsigned)__builtin_amdgcn_s_getreg((3 << 11) | 20) & 0xFu; }
#define XB_SPIN(cond, bar) do { unsigned _sp = 0; while (cond) { __builtin_amdgcn_s_sleep(1); \
    if ((++_sp & 255u) == 0u) { if (xb_ld(&(bar)[XB_TMO])) break; if (_sp > XB_SPIN_CAP) { atomicAdd(&(bar)[XB_TMO], 1u); break; } } } } while (0)
struct XcdBarrier { unsigned* bar; unsigned x; volatile LAS unsigned* st; int wave; };
__device__ __forceinline__ XcdBarrier xcd_barrier_post(unsigned* bar, volatile LAS unsigned* st, int wave) {
    XcdBarrier b; b.bar = bar; b.x = xb_xcc_id(); b.st = st; b.wave = wave;
    if (wave == 0 && lane_id_v() == 0) (void)xb_add(&bar[XB_XCNT(b.x)], 1u);
    return b;
}
__device__ __forceinline__ void xcd_barrier_complete(unsigned* bar, unsigned x, unsigned& nloc, unsigned& nx) {
    const unsigned G = gridDim.x * gridDim.y * gridDim.z;
    unsigned sum, cnt, mine, sp = 0u;
    for (;;) {
        sum = 0u; cnt = 0u; mine = 0u;
#pragma unroll
        for (unsigned j = 0; j < 16; ++j) { const unsigned c = xb_ld(&bar[XB_XCNT(j)]); sum += c; cnt += (c > 0u) ? 1u : 0u; mine = (j == x) ? c : mine; }
        if (sum == G) break;
        __builtin_amdgcn_s_sleep(1);
        if ((++sp & 255u) == 0u) { if (xb_ld(&bar[XB_TMO])) break; if (sp > XB_SPIN_CAP) { atomicAdd(&bar[XB_TMO], 1u); break; } }
    }
    nloc = mine > 0u ? mine : 1u; nx = cnt > 0u ? cnt : 1u;
}
__device__ __forceinline__ void xcd_barrier_arrive(const XcdBarrier& b) {
    asm volatile("s_waitcnt vmcnt(0)" ::: "memory");
    __syncthreads();
    if (b.wave == 0 && lane_id_v() == 0) {
        unsigned* bar = b.bar;
        __builtin_amdgcn_s_waitcnt(0);
        unsigned nloc = b.st[0], nx = b.st[1];
        if (nloc == 0u) { xcd_barrier_complete(bar, b.x, nloc, nx); b.st[0] = nloc; b.st[1] = nx; }
        const unsigned old = xb_add(&bar[XB_XSUB(b.x)], 1u);
        const unsigned gen = old / nloc;
        unsigned role = 1u, tg = 0u;
        if (old + 1u == (gen + 1u) * nloc) {
            __builtin_amdgcn_fence(__ATOMIC_RELEASE, "agent");
            asm volatile("s_waitcnt vmcnt(0)" ::: "memory");
            const unsigned og = xb_add(&bar[XB_TOP], 1u);
            tg = og / nx; role = 2u;
            if (og + 1u == (tg + 1u) * nx) { xb_add(&bar[XB_TOPGEN], 1u); role = 3u; }
        }
        b.st[2] = role; b.st[3] = gen; b.st[4] = tg;
    }
}
__device__ __forceinline__ void xcd_barrier_wait(const XcdBarrier& b) {
    asm volatile("s_waitcnt vmcnt(0)" ::: "memory");
    if (b.wave == 0 && lane_id_v() == 0) {
        unsigned* bar = b.bar;
        const unsigned role = b.st[2], gen = b.st[3], tg = b.st[4];
        if (role >= 2u) {
            if (role == 2u) XB_SPIN(xb_ld(&bar[XB_TOPGEN]) == tg, bar);
            __builtin_amdgcn_fence(__ATOMIC_ACQUIRE, "agent");
            xb_add(&bar[XB_XGEN(b.x)], 1u);
            asm volatile("s_waitcnt vmcnt(0)" ::: "memory");
        } else {
            XB_SPIN(xb_ld(&bar[XB_XGEN(b.x)]) == gen, bar);
            __builtin_amdgcn_fence(__ATOMIC_ACQUIRE, "agent");
            asm volatile("s_waitcnt vmcnt(0)" ::: "memory");
        }
    }
    __syncthreads();
}
__device__ __forceinline__ void xcd_barrier(const XcdBarrier& b) {
    asm volatile("s_waitcnt vmcnt(0)" ::: "memory");
    __syncthreads();
    if (b.wave == 0 && lane_id_v() == 0) {
        unsigned* bar = b.bar;
        __builtin_amdgcn_s_waitcnt(0);
        unsigned nloc = b.st[0], nx = b.st[1];
        if (nloc == 0u) { xcd_barrier_complete(bar, b.x, nloc, nx); b.st[0] = nloc; b.st[1] = nx; }
        const unsigned old = xb_add(&bar[XB_XSUB(b.x)], 1u);
        const unsigned gen = old / nloc;
        if (old + 1u == (gen + 1u) * nloc) {
            __builtin_amdgcn_fence(__ATOMIC_RELEASE, "agent");
            asm volatile("s_waitcnt vmcnt(0)" ::: "memory");
            const unsigned og = xb_add(&bar[XB_TOP], 1u);
            const unsigned tg = og / nx;
            if (og + 1u == (tg + 1u) * nx) xb_add(&bar[XB_TOPGEN], 1u);
            else XB_SPIN(xb_ld(&bar[XB_TOPGEN]) == tg, bar);
            __builtin_amdgcn_fence(__ATOMIC_ACQUIRE, "agent");
            xb_add(&bar[XB_XGEN(b.x)], 1u);
            asm volatile("s_waitcnt vmcnt(0)" ::: "memory");
        } else {
            XB_SPIN(xb_ld(&bar[XB_XGEN(b.x)]) == gen, bar);
            __builtin_amdgcn_fence(__ATOMIC_ACQUIRE, "agent");
            asm volatile("s_waitcnt vmcnt(0)" ::: "memory");
        }
    }
    __syncthreads();
}

struct Args { const float* in[18]; float* out; unsigned char* ws; int ph_lo, ph_hi; };
enum { I_X = 0, I_GATTN, I_WIN, I_GCQ, I_GCKV, I_WUQ, I_WUKV, I_GMQ, I_GMK, I_GDQ, I_GDK, I_RELB, I_WO, I_GFFN, I_WPQ, I_SUBK, I_UTAB, I_VTAB };

__device__ __forceinline__ int map_in(int n) {
    if (n < 768) return n;
    if (n < 2816) return n + 64;
    if (n < 3840) return n + 1088;
    if (n < 3904) { const int j = n - 3840; return 768 + (j >> 1) + 32 * (j & 1); }
    if (n < 3984) return n + 1024;
    if (n < 4096) return -1;
    return n - 1216;
}
__device__ __forceinline__ int map_uq(int n) {
    const int h = n >> 8, j = n & 255;
    if (j < 128) return h * 192 + j;
    if (j < 192) { const int i = (j - 128) >> 1, par = (j - 128) & 1; return h * 192 + 128 + i + 32 * par; }
    return -1;
}
template <int MAP>
__device__ __forceinline__ void p0_transpose_item(const float* __restrict__ W, int K, int Nsrc, int Nout, f16* __restrict__ WT, const float* __restrict__ g, LAS float* scr, int item, int lane) {
    const int nblk = Nout / 32, kb = item / nblk, nb = item % nblk, k0 = 64 * kb, n0 = 32 * nb;
    const int s0 = MAP == 1 ? map_in(n0) : (MAP == 2 ? map_uq(n0) : n0), s31 = MAP == 1 ? map_in(n0 + 31) : (MAP == 2 ? map_uq(n0 + 31) : n0 + 31);
    if (s31 - s0 == 31 || (s0 < 0 && s31 < 0)) {
        const int c4 = lane & 7, kq = lane >> 3;
#pragma unroll
        for (int i = 0; i < 8; ++i) { const int kk = kq + 8 * i; f32x4 v = {0.f, 0.f, 0.f, 0.f};
            if (s0 >= 0) v = __builtin_nontemporal_load((const f32x4*)(W + (size_t)(k0 + kk) * Nsrc + s0 + 4 * c4));
            if (g) v = v * g[k0 + kk];
            LAS float* d = scr + kk * 33 + 4 * c4; d[0] = v[0]; d[1] = v[1]; d[2] = v[2]; d[3] = v[3]; }
    } else {
        const int n = n0 + (lane & 31);
        const int src = MAP == 1 ? map_in(n) : (MAP == 2 ? map_uq(n) : n);
#pragma unroll 8
        for (int i = 0; i < 32; ++i) { const int kk = 2 * i + (lane >> 5); float v = 0.f; if (src >= 0) v = W[(size_t)(k0 + kk) * Nsrc + src]; if (g) v *= g[k0 + kk]; scr[kk * 33 + (lane & 31)] = v; }
    }
    LDS_WAIT(); asm volatile("" ::: "memory");
    const int c = lane & 7;
#pragma unroll
    for (int j = 0; j < 4; ++j) { const int nn = (lane >> 3) + 8 * j; const LAS float* s = scr + (8 * c) * 33 + nn;
        f16x8 o; o[0] = (f16)s[0 * 33]; o[1] = (f16)s[1 * 33]; o[2] = (f16)s[2 * 33]; o[3] = (f16)s[3 * 33]; o[4] = (f16)s[4 * 33]; o[5] = (f16)s[5 * 33]; o[6] = (f16)s[6 * 33]; o[7] = (f16)s[7 * 33];
        *(f16x8*)(WT + (size_t)(n0 + nn) * K + k0 + 8 * c) = o; }
    LDS_WAIT(); asm volatile("" ::: "memory");
}
__device__ __forceinline__ void p0_cvt_f16(const float* __restrict__ src, f16* __restrict__ dst, size_t n8, const float* __restrict__ g, int ncols, size_t gtid, size_t gn) {
    for (size_t i = gtid; i < n8; i += gn) {
        f32x4 a = *(const f32x4*)(src + i * 8), b = *(const f32x4*)(src + i * 8 + 4);
        if (g) { const int c = (int)((i * 8) & (size_t)(ncols - 1)); a = a * *(const f32x4*)(g + c); b = b * *(const f32x4*)(g + c + 4); }
        *(f16x8*)(dst + i * 8) = pack_f16x8(a, b);
    }
}
typedef unsigned u32x6 __attribute__((ext_vector_type(6)));
typedef float f32x32 __attribute__((ext_vector_type(32)));
typedef _Float16 f16x32 __attribute__((ext_vector_type(32)));
__device__ __forceinline__ void p0_row_fp6(const float* __restrict__ src, const float* __restrict__ g, unsigned char* __restrict__ dst, float* __restrict__ scl, int row, int lane) {
    const float* rp = src + (size_t)row * 2048 + 4 * lane;
    f32x16 a, b; float mx = 0.f;
#pragma unroll
    for (int i = 0; i < 8; ++i) { f32x4 v = *(const f32x4*)(rp + 256 * i);
        if (g) v = v * *(const f32x4*)(g + 4 * lane + 256 * i);
        a[2 * i] = v[0]; b[2 * i] = v[1]; a[2 * i + 1] = v[2]; b[2 * i + 1] = v[3];
        mx = fmaxf(mx, fmaxf(fmaxf(fabsf(v[0]), fabsf(v[1])), fmaxf(fabsf(v[2]), fabsf(v[3])))); }
    mx = wave_max(mx);
    const float inv = mx > 0.f ? 7.4999f / mx : 0.f;
    a = a * inv; b = b * inv;
    const u32x6 pk = __builtin_amdgcn_cvt_scalef32_2xpk16_fp6_f32(a, b, 1.0f);
    __builtin_amdgcn_sched_barrier(0); asm volatile("s_nop 7\n\ts_nop 7"); __builtin_amdgcn_sched_barrier(0);
    u32x2* dp = (u32x2*)(dst + (size_t)row * 1536 + 24 * lane);
    dp[0] = (u32x2){pk[0], pk[1]}; dp[1] = (u32x2){pk[2], pk[3]}; dp[2] = (u32x2){pk[4], pk[5]};
    if (lane == 0) scl[row] = mx * (1.0f / 7.4999f);
}
__device__ __forceinline__ void p0_row_fp4_load(const float* __restrict__ src, int row, int lane, f32x4 (&v)[8]) {
    const float* rp = src + (size_t)row * 2048 + 4 * lane;
#pragma unroll
    for (int i = 0; i < 8; ++i) v[i] = __builtin_nontemporal_load((const f32x4*)(rp + 256 * i));
}
__device__ __forceinline__ void p0_row_fp4_finish(f32x4 (&v)[8], const float* __restrict__ g, unsigned char* __restrict__ dst, float* __restrict__ scl, int row, int lane) {
    float mx = 0.f;
#pragma unroll
    for (int i = 0; i < 8; ++i) {
        if (g) v[i] = v[i] * *(const f32x4*)(g + 4 * lane + 256 * i);
        mx = fmaxf(mx, fmaxf(fmaxf(fabsf(v[i][0]), fabsf(v[i][1])), fmaxf(fabsf(v[i][2]), fabsf(v[i][3])))); }
    mx = wave_max(mx);
    const float inv = mx > 0.f ? 5.9999f / mx : 0.f;
    f32x4 sv[8];
#pragma unroll
    for (int i = 0; i < 8; ++i) sv[i] = v[i] * inv;
    __builtin_amdgcn_sched_barrier(0);
    unsigned pk0 = 0u, pk1 = 0u, pk2 = 0u, pk3 = 0u;
#define P4(B, I0, J0, I1, J1, I2, J2, I3, J3) do { \
    pk0 = __builtin_amdgcn_cvt_scalef32_pk_fp4_f32(pk0, sv[I0][J0], sv[I0][J0 + 1], 1.0f, B); pk1 = __builtin_amdgcn_cvt_scalef32_pk_fp4_f32(pk1, sv[I1][J1], sv[I1][J1 + 1], 1.0f, B); \
    pk2 = __builtin_amdgcn_cvt_scalef32_pk_fp4_f32(pk2, sv[I2][J2], sv[I2][J2 + 1], 1.0f, B); pk3 = __builtin_amdgcn_cvt_scalef32_pk_fp4_f32(pk3, sv[I3][J3], sv[I3][J3 + 1], 1.0f, B); \
    __builtin_amdgcn_sched_barrier(0); asm volatile("s_nop 3"); __builtin_amdgcn_sched_barrier(0); } while (0)
    P4(0, 0, 0, 2, 0, 4, 0, 6, 0);
    P4(1, 0, 2, 2, 2, 4, 2, 6, 2);
    P4(2, 1, 0, 3, 0, 5, 0, 7, 0);
    P4(3, 1, 2, 3, 2, 5, 2, 7, 2);
#undef P4
    asm volatile("s_nop 7\n\ts_nop 7" : "+v"(sv[0]), "+v"(sv[1]), "+v"(sv[2]), "+v"(sv[3]), "+v"(sv[4]), "+v"(sv[5]), "+v"(sv[6]), "+v"(sv[7]));
    const u32x4 pk = {pk0, pk1, pk2, pk3};
    __builtin_nontemporal_store(pk, (u32x4*)(dst + (size_t)row * 1024 + 16 * lane));
    if (lane == 0) scl[row] = mx * (1.0f / 5.9999f);
}
__device__ __forceinline__ void p0_row_fp4(const float* __restrict__ src, const float* __restrict__ g, unsigned char* __restrict__ dst, float* __restrict__ scl, int row, int lane) {
    f32x4 v[8]; p0_row_fp4_load(src, row, lane, v); p0_row_fp4_finish(v, g, dst, scl, row, lane);
}
#ifndef TAB_ROWS_P2
#define TAB_ROWS_P2 6144
#endif
#ifndef TAB_SEAM_ROWS
#define TAB_SEAM_ROWS 2048
#endif
#define TAB_ROWS_SEAMS (5 * TAB_SEAM_ROWS)
__device__ __forceinline__ void p0_tables(const Args& A, int row0, int step, int row_end, int lane) {
    unsigned char* ws = A.ws;
#if TAB_U_FP4 && TAB_V_FP4
    f32x4 ua[8], va[8], ub[8], vb[8];
    int row = row0;
    if (row < row_end) { p0_row_fp4_load(A.in[I_UTAB], row, lane, ua); p0_row_fp4_load(A.in[I_VTAB], row, lane, va); }
    while (row < row_end) {
        const int r1 = row + step;
        if (r1 < row_end) { p0_row_fp4_load(A.in[I_UTAB], r1, lane, ub); p0_row_fp4_load(A.in[I_VTAB], r1, lane, vb); }
        p0_row_fp4_finish(ua, A.in[I_GFFN], ws + WS_U16, (float*)(ws + WS_USCL), row, lane);
        p0_row_fp4_finish(va, nullptr, ws + WS_V16, (float*)(ws + WS_VSCL), row, lane);
        if (r1 >= row_end) break;
        const int r2 = r1 + step;
        if (r2 < row_end) { p0_row_fp4_load(A.in[I_UTAB], r2, lane, ua); p0_row_fp4_load(A.in[I_VTAB], r2, lane, va); }
        p0_row_fp4_finish(ub, A.in[I_GFFN], ws + WS_U16, (float*)(ws + WS_USCL), r1, lane);
        p0_row_fp4_finish(vb, nullptr, ws + WS_V16, (float*)(ws + WS_VSCL), r1, lane);
        row = r2;
    }
#else
    for (int row = row0; row < row_end; row += step) {
        if (TAB_U_FP4) p0_row_fp4(A.in[I_UTAB], A.in[I_GFFN], ws + WS_U16, (float*)(ws + WS_USCL), row, lane); else p0_row_fp6(A.in[I_UTAB], A.in[I_GFFN], ws + WS_U16, (float*)(ws + WS_USCL), row, lane);
        if (TAB_V_FP4) p0_row_fp4(A.in[I_VTAB], nullptr, ws + WS_V16, (float*)(ws + WS_VSCL), row, lane); else p0_row_fp6(A.in[I_VTAB], nullptr, ws + WS_V16, (float*)(ws + WS_VSCL), row, lane);
    }
#endif
}
struct P0Args { const float* const* in; unsigned char* ws; };
__device__ __forceinline__ void p0_prologue(const Args& A, LAS unsigned char* lds, int wave, int lane, bool tables, int parts = 7) {
    LAS float* scr = (LAS float*)(lds + RING_OFF + wave * 16384);
    const int G = gridDim.x, gw = blockIdx.x * NWAVES + wave, NGW = G * NWAVES;
    unsigned char* ws = A.ws;
    constexpr int I_IN = (2048 / 64) * (5120 / 32), I_UQ = (512 / 64) * (2048 / 32), I_UKV = (256 / 64) * (2048 / 32), I_O = (2048 / 64) * (2048 / 32), I_PQ = I_O;
    constexpr int NITEMS = I_IN + I_UQ + I_UKV + I_O + I_PQ;
    if (tables && (parts & 4)) p0_tables(A, TAB_ROWS_P2 + TAB_ROWS_SEAMS + gw, NGW, 16384, lane);
    if (parts & 1) for (int it = gw; it < NITEMS; it += NGW) {
        int r = it;
        if (r < I_IN) { p0_transpose_item<1>(A.in[I_WIN], 2048, INW, 5120, (f16*)(ws + WS_WT_IN), nullptr, scr, r, lane); continue; } r -= I_IN;
        if (r < I_UQ) { p0_transpose_item<2>(A.in[I_WUQ], 512, 1536, 2048, (f16*)(ws + WS_WT_UQ), A.in[I_GCQ], scr, r, lane); continue; } r -= I_UQ;
        if (r < I_UKV) { p0_transpose_item<0>(A.in[I_WUKV], 256, 2048, 2048, (f16*)(ws + WS_WT_UKV), A.in[I_GCKV], scr, r, lane); continue; } r -= I_UKV;
        if (r < I_O) { p0_transpose_item<0>(A.in[I_WO], 2048, 2048, 2048, (f16*)(ws + WS_WT_O), nullptr, scr, r, lane); continue; } r -= I_O;
        p0_transpose_item<0>(A.in[I_WPQ], 2048, 2048, 2048, (f16*)(ws + WS_WT_PQ), A.in[I_GFFN], scr, r, lane);
    }
    if (parts & 2) {
        const float* gat = A.in[I_GATTN]; f16* XN = (f16*)(ws + WS_XN);
#define XN_LOAD(v, row) do { const float* xr_ = A.in[I_X] + (size_t)(row) * 2048 + lane * 8; _Pragma("unroll") for (int j_ = 0; j_ < 4; ++j_) { v[2 * j_] = __builtin_nontemporal_load((const f32x4*)(xr_ + 512 * j_)); v[2 * j_ + 1] = __builtin_nontemporal_load((const f32x4*)(xr_ + 512 * j_ + 4)); } } while (0)
#define XN_FIN(v, row) do { float ss_ = 0.f; _Pragma("unroll") for (int j_ = 0; j_ < 8; ++j_) ss_ += ssq4(v[j_]); const float r_ = 1.0f / sqrtf(wave_sum(ss_) * (1.0f / 2048.0f) + EPS); \
            _Pragma("unroll") for (int j_ = 0; j_ < 4; ++j_) { const f32x4 g0_ = *(const f32x4*)(gat + lane * 8 + 512 * j_), g1_ = *(const f32x4*)(gat + lane * 8 + 512 * j_ + 4); \
                *(f16x8*)(XN + (size_t)(row) * 2048 + lane * 8 + 512 * j_) = pack_f16x8(v[2 * j_] * r_ * g0_, v[2 * j_ + 1] * r_ * g1_); } } while (0)
        f32x4 xa[8], xb[8];
        int row = gw;
        if (row < T_) XN_LOAD(xa, row);
        while (row < T_) {
            const int r1 = row + NGW;
            if (r1 < T_) XN_LOAD(xb, r1);
            XN_FIN(xa, row);
            if (r1 >= T_) break;
            const int r2 = r1 + NGW;
            if (r2 < T_) XN_LOAD(xa, r2);
            XN_FIN(xb, r1);
            row = r2;
        }
#undef XN_LOAD
#undef XN_FIN
    }
    const size_t gtid = (size_t)blockIdx.x * NTHR + wave * 64 + lane, gn = (size_t)G * NTHR;
    p0_cvt_f16(A.in[I_SUBK], (f16*)(ws + WS_SK16), (size_t)16 * 128 * 128 / 8, nullptr, 128, gtid, gn);
}

__device__ __forceinline__ unsigned sortable_u32(float f) { const unsigned b = __float_as_uint(f); return (b & 0x80000000u) ? ~b : (b | 0x80000000u); }
template <int MODE>
__device__ __forceinline__ void idx_item(LAS unsigned char* lds, const f16* __restrict__ QI, const f16* __restrict__ KI, const float* __restrict__ WI, unsigned* __restrict__ MASK,
                                         int b, int chunk, int qq, int wave, int lane) {
    const int t0 = b * S_ + chunk * 64 + qq * 16 + wave * 2;
    const int r32 = lane & 31, hi = lane >> 5;
    const int nt32 = 2 * (chunk + 1);
    f16x8 af[4];
    { const f16* qp = QI + (size_t)(t0 + ((r32 >> 2) & 1)) * 1024 + ((r32 & 3) + 4 * (r32 >> 3)) * 64 + 8 * hi;
#pragma unroll
      for (int s = 0; s < 4; ++s) af[s] = *(const f16x8*)(qp + 16 * s); }
    float wv[16];
    { const float* wp = WI + (size_t)(t0 + hi) * 16;
#pragma unroll
      for (int i = 0; i < 4; ++i) { const f32x4 w4 = *(const f32x4*)(wp + 4 * i); wv[4 * i] = w4[0]; wv[4 * i + 1] = w4[1]; wv[4 * i + 2] = w4[2]; wv[4 * i + 3] = w4[3]; } }
    const f16* kbase = KI + (size_t)b * S_ * 64;
    unsigned koff[4];
#pragma unroll
    for (int j = 0; j < 4; ++j) { const int p = (wave * 4 + j) * 1024 + lane * 16, key = p >> 7, chp = (p >> 4) & 7; koff[j] = (unsigned)(key * 64 + ((chp ^ ((key >> 1) & 7)) * 8)) * 2u; }
#define IDX_DMA(stage, buf) do { int so_ = (stage) * 256 * 64 * 2; asm volatile("" : "+s"(so_)); const char* gb_ = (const char*)kbase + so_; _Pragma("unroll") for (int j_ = 0; j_ < 4; ++j_) \
        __builtin_amdgcn_global_load_lds((const unsigned*)(gb_ + koff[j_]), (LAS unsigned*)(lds + (buf) * 32768 + (wave * 4 + j_) * 1024), 16, 0, 0); } while (0)
    unsigned u[128];
#pragma unroll
    for (int i = 0; i < 128; ++i) u[i] = 0u;
    IDX_DMA(0, 0); asm volatile("s_waitcnt vmcnt(0)" ::: "memory"); WG_BAR();
    int bo[4];
#pragma unroll
    for (int s = 0; s < 4; ++s) bo[s] = r32 * 128 + (((2 * s + hi) ^ ((r32 >> 1) & 7)) << 4);
    const int nstg = (nt32 + 7) >> 3, off = (16 - nstg) * 8;
#pragma unroll 1
    for (int stg = 0; stg < (MODE == 2 ? 0 : nstg); ++stg) {
#pragma unroll
        for (int i = 0; i < 120; ++i) u[i] = u[i + 8];
        const bool more = stg + 1 < nstg;
        if (more) IDX_DMA(stg + 1, (stg + 1) & 1);
        const LAS unsigned char* kb = lds + (stg & 1) * 32768;
        const int nval = nt32 - stg * 8;
        f16x8 bf[4];
#pragma unroll
        for (int s = 0; s < 4; ++s) bf[s] = *(const LAS f16x8*)(kb + bo[s]);
#pragma unroll
        for (int tl = 0; tl < 8; ++tl) {
            unsigned val = 0u;
            if (tl < nval) {
                asm volatile("s_waitcnt lgkmcnt(0)" ::: "memory"); __builtin_amdgcn_sched_barrier(0);
                f32x16 acc = {0.f, 0.f, 0.f, 0.f, 0.f, 0.f, 0.f, 0.f, 0.f, 0.f, 0.f, 0.f, 0.f, 0.f, 0.f, 0.f};
#pragma unroll
                for (int s = 0; s < 4; ++s) acc = __builtin_amdgcn_mfma_f32_32x32x16_f16(af[s], bf[s], acc, 0, 0, 0);
                __builtin_amdgcn_sched_barrier(0);
                if (tl < 7 && tl + 1 < nval) {
#pragma unroll
                    for (int s = 0; s < 4; ++s) bf[s] = *(const LAS f16x8*)(kb + (tl + 1) * 4096 + bo[s]);
                }
                __builtin_amdgcn_sched_barrier(0);
                f32x2 sa = {0.f, 0.f}, sb = {0.f, 0.f};
#pragma unroll
                for (int r = 0; r < 16; r += 4) {
                    const f32x2 ma = {__int_as_float(max(__float_as_int(acc[r]), 0)), __int_as_float(max(__float_as_int(acc[r + 1]), 0))};
                    const f32x2 mb = {__int_as_float(max(__float_as_int(acc[r + 2]), 0)), __int_as_float(max(__float_as_int(acc[r + 3]), 0))};
                    sa = __builtin_elementwise_fma((f32x2){wv[r], wv[r + 1]}, ma, sa); sb = __builtin_elementwise_fma((f32x2){wv[r + 2], wv[r + 3]}, mb, sb); }
                sa = sa + sb;
                val = sortable_u32(sa[0] + sa[1]) >> 1;
            }
            u[120 + tl] = val;
        }
        if (more) asm volatile("s_waitcnt vmcnt(0)" ::: "memory");
        WG_BAR();
    }
#undef IDX_DMA
    unsigned thr = 1u;
    if (MODE != 1 && nt32 * 32 > 256) {
        typedef short s16x2 __attribute__((ext_vector_type(2)));
        const int visited = 128 - (off & ~15);
        unsigned hp[64];
#pragma unroll
        for (int j = 0; j < 64; ++j) hp[j] = __builtin_amdgcn_perm(u[2 * j + 1] >> 15, u[2 * j] >> 15, 0x05040100u) ^ 0x80008000u;
        unsigned T = 0u;
#pragma unroll 1
        for (int bit = 15; bit >= 0; --bit) {
            const unsigned cand = T | (1u << bit), cs = (cand ^ 0x8000u) & 0xFFFFu; const s16x2 c2 = __builtin_bit_cast(s16x2, cs | (cs << 16));
            s16x2 a0 = {0, 0}, a1 = {0, 0}, a2 = {0, 0}, a3 = {0, 0};
#pragma unroll
            for (int j0 = 0; j0 < 64; j0 += 8) { if (2 * j0 + 16 > off) {
#pragma unroll
                for (int j = j0; j < j0 + 8; j += 4) {
                    a0 += __builtin_elementwise_sub_sat(__builtin_bit_cast(s16x2, hp[j]), c2) >> 15; a1 += __builtin_elementwise_sub_sat(__builtin_bit_cast(s16x2, hp[j + 1]), c2) >> 15;
                    a2 += __builtin_elementwise_sub_sat(__builtin_bit_cast(s16x2, hp[j + 2]), c2) >> 15; a3 += __builtin_elementwise_sub_sat(__builtin_bit_cast(s16x2, hp[j + 3]), c2) >> 15; } } }
            const s16x2 at = (a0 + a1) + (a2 + a3);
            int cnt = visited + (int)at[0] + (int)at[1];
            cnt = row_sum_i32(cnt); cnt += __shfl_xor(cnt, 16);
            if (cnt >= 256) T = cand;
        }
        unsigned TL = 0u;
        int G;
        { const unsigned candg = T == 0xFFFFu ? 0xFFFFu : T + 1u, cs = (candg ^ 0x8000u) & 0xFFFFu; const s16x2 c2 = __builtin_bit_cast(s16x2, cs | (cs << 16));
          s16x2 a0 = {0, 0}, a1 = {0, 0}, a2 = {0, 0}, a3 = {0, 0};
#pragma unroll
          for (int j0 = 0; j0 < 64; j0 += 8) { if (2 * j0 + 16 > off) {
#pragma unroll
              for (int j = j0; j < j0 + 8; j += 4) {
                  a0 += __builtin_elementwise_sub_sat(__builtin_bit_cast(s16x2, hp[j]), c2) >> 15; a1 += __builtin_elementwise_sub_sat(__builtin_bit_cast(s16x2, hp[j + 1]), c2) >> 15;
                  a2 += __builtin_elementwise_sub_sat(__builtin_bit_cast(s16x2, hp[j + 2]), c2) >> 15; a3 += __builtin_elementwise_sub_sat(__builtin_bit_cast(s16x2, hp[j + 3]), c2) >> 15; } } }
          const s16x2 at = (a0 + a1) + (a2 + a3);
          int cnt = visited + (int)at[0] + (int)at[1];
          cnt = row_sum_i32(cnt); cnt += __shfl_xor(cnt, 16);
          G = T == 0xFFFFu ? 0 : cnt; }
        const int rneed = 256 - G;
        const unsigned tbh = (T << 15) + 0x7FFFu;
        unsigned L0 = 0u, L1 = 0u, L2 = 0u;
#pragma unroll
        for (int i0 = 0; i0 < 128; i0 += 16) { if (i0 + 16 > off) {
#pragma unroll
            for (int i = i0; i < i0 + 16; ++i) {
                const unsigned z = tbh - u[i], kk = 0x8000u - min(z, 0x8000u);
                unsigned t2, t1;
                asm("v_med3_u32 %0, %1, %2, %3" : "=v"(t2) : "v"(L1), "v"(L2), "v"(kk)); asm("v_med3_u32 %0, %1, %2, %3" : "=v"(t1) : "v"(L0), "v"(L1), "v"(kk));
                L2 = t2; L1 = t1; L0 = max(L0, kk); } } }
        if (__ballot(L2 != 0u) == 0ull) {
            unsigned TK = 0u;
#pragma unroll 1
            for (int bit = 15; bit >= 0; --bit) {
                const unsigned cand = TK | (1u << bit);
                int cnt = (L0 >= cand ? 1 : 0) + (L1 >= cand ? 1 : 0);
                cnt = row_sum_i32(cnt); cnt += __shfl_xor(cnt, 16);
                if (cnt >= rneed) TK = cand;
            }
            TL = TK ? TK - 1u : 0u;
        } else {
        const int tb = (int)(T << 15);
#pragma unroll
        for (int j = 0; j < 64; ++j) { const int x0 = min(max((int)u[2 * j] - tb, -1), 0x7FFF), x1 = min(max((int)u[2 * j + 1] - tb, -1), 0x7FFF);
            hp[j] = __builtin_amdgcn_perm((unsigned)x1, (unsigned)x0, 0x05040100u); }
#pragma unroll 1
        for (int bit = 14; bit >= 0; --bit) {
            const unsigned cand = TL | (1u << bit); const s16x2 c2 = __builtin_bit_cast(s16x2, cand | (cand << 16));
            s16x2 a0 = {0, 0}, a1 = {0, 0}, a2 = {0, 0}, a3 = {0, 0};
#pragma unroll
            for (int j0 = 0; j0 < 64; j0 += 8) { if (2 * j0 + 16 > off) {
#pragma unroll
                for (int j = j0; j < j0 + 8; j += 4) {
                    a0 += (__builtin_bit_cast(s16x2, hp[j]) - c2) >> 15; a1 += (__builtin_bit_cast(s16x2, hp[j + 1]) - c2) >> 15;
                    a2 += (__builtin_bit_cast(s16x2, hp[j + 2]) - c2) >> 15; a3 += (__builtin_bit_cast(s16x2, hp[j + 3]) - c2) >> 15; } } }
            const s16x2 at = (a0 + a1) + (a2 + a3);
            int cnt = visited + (int)at[0] + (int)at[1];
            cnt = row_sum_i32(cnt); cnt += __shfl_xor(cnt, 16);
            if (cnt >= 256) TL = cand;
        }
        }
        thr = (T << 15) | TL;
    }
    unsigned wlo0 = 0u, whi0 = 0u, wlo1 = 0u, whi1 = 0u;
#define WL(w, val, ln) asm volatile("v_writelane_b32 %0, %1, %2" : "+v"(w) : "s"(val), "n"(ln))
#pragma unroll
    for (int i0 = 0; i0 < 128; i0 += 4) {
        const unsigned long long b0 = __ballot(u[i0] >= thr), b1 = __ballot(u[i0 + 1] >= thr), b2 = __ballot(u[i0 + 2] >= thr), b3 = __ballot(u[i0 + 3] >= thr);
        const unsigned l0 = (unsigned)b0, h0 = (unsigned)(b0 >> 32), l1 = (unsigned)b1, h1 = (unsigned)(b1 >> 32), l2 = (unsigned)b2, h2 = (unsigned)(b2 >> 32), l3 = (unsigned)b3, h3 = (unsigned)(b3 >> 32);
        asm volatile("s_nop 3" :: "s"(l0), "s"(h0), "s"(l1), "s"(h1), "s"(l2), "s"(h2), "s"(l3), "s"(h3));
        if (i0 < 64) { WL(wlo0, l0, i0 & 63); WL(whi0, h0, i0 & 63); WL(wlo0, l1, (i0 + 1) & 63); WL(whi0, h1, (i0 + 1) & 63); WL(wlo0, l2, (i0 + 2) & 63); WL(whi0, h2, (i0 + 2) & 63); WL(wlo0, l3, (i0 + 3) & 63); WL(whi0, h3, (i0 + 3) & 63); }
        else { WL(wlo1, l0, i0 & 63); WL(whi1, h0, i0 & 63); WL(wlo1, l1, (i0 + 1) & 63); WL(whi1, h1, (i0 + 1) & 63); WL(wlo1, l2, (i0 + 2) & 63); WL(whi1, h2, (i0 + 2) & 63); WL(wlo1, l3, (i0 + 3) & 63); WL(whi1, h3, (i0 + 3) & 63); }
    }
#undef WL
    { const int ta = lane - off, tb = 64 + lane - off;
      if (ta >= 0) { MASK[(size_t)t0 * 128 + ta] = wlo0; MASK[(size_t)(t0 + 1) * 128 + ta] = whi0; }
      if (tb >= 0 && tb < 128) { MASK[(size_t)t0 * 128 + tb] = wlo1; MASK[(size_t)(t0 + 1) * 128 + tb] = whi1; } }
}
template <int MODE>
__device__ __forceinline__ void idx_phase(LAS unsigned char* lds, const f16* QI, const f16* KI, const float* WI, unsigned* MASK, int cu, int wave) {
    const int lane = lane_id_v();
#pragma unroll 1
    for (int k = 0; k < 2; ++k) {
        const int L = k == 0 ? cu : 511 - cu;
        idx_item<MODE>(lds, QI, KI, WI, MASK, (L >> 2) & 1, L >> 3, L & 3, wave, lane);
    }
}

namespace att {
#define SBAR() __builtin_amdgcn_sched_barrier(0)
__device__ __forceinline__ int crow(int r, int hi) { return (r & 3) + 8 * (r >> 2) + 4 * hi; }
__device__ __forceinline__ int v_st(int k, int c) { const int kk = (k & ~0xC) | ((k & 4) << 1) | ((k & 8) >> 1); return ((kk >> 3) * 4 + (c >> 5)) * 512 + ((kk & 7) * 32 + (c & 31)) * 2; }
__device__ __forceinline__ int v_rd_base(int lane) { return ((lane & 3) << 3) | (((lane >> 2) & 3) << 6) | (((lane >> 4) & 1) << 5) | (((lane >> 5) & 1) << 8); }
constexpr int v_rd_off(int d0, int ks, int half) { return d0 * 512 + ks * 4096 + half * 2048; }
template <int OFF> __device__ __forceinline__ s16x4 tr_read(int vb) { s16x4 r; asm volatile("ds_read_b64_tr_b16 %0, %1 offset:%2" : "=&v"(r) : "v"(vb), "i"(OFF) : "memory"); return r; }
template <int D0> __device__ __forceinline__ void pv_one(f32x16& od, int vb, bf16x8 pa0, bf16x8 pa1, bf16x8 pa2, bf16x8 pa3) {
  const s16x4 l0 = tr_read<v_rd_off(D0, 0, 0)>(vb), h0 = tr_read<v_rd_off(D0, 0, 1)>(vb), l1 = tr_read<v_rd_off(D0, 1, 0)>(vb), h1 = tr_read<v_rd_off(D0, 1, 1)>(vb);
  const s16x4 l2 = tr_read<v_rd_off(D0, 2, 0)>(vb), h2 = tr_read<v_rd_off(D0, 2, 1)>(vb), l3 = tr_read<v_rd_off(D0, 3, 0)>(vb), h3 = tr_read<v_rd_off(D0, 3, 1)>(vb);
  asm volatile("s_waitcnt lgkmcnt(0)" ::: "memory"); SBAR();
#define PK(L, H) (bf16x8){L[0], L[1], L[2], L[3], H[0], H[1], H[2], H[3]}
  od = __builtin_amdgcn_mfma_f32_32x32x16_bf16(pa0, PK(l0, h0), od, 0, 0, 0);
  od = __builtin_amdgcn_mfma_f32_32x32x16_bf16(pa1, PK(l1, h1), od, 0, 0, 0);
  od = __builtin_amdgcn_mfma_f32_32x32x16_bf16(pa2, PK(l2, h2), od, 0, 0, 0);
  od = __builtin_amdgcn_mfma_f32_32x32x16_bf16(pa3, PK(l3, h3), od, 0, 0, 0);
#undef PK
}
__device__ __forceinline__ void pv_d0(f32x16* o, int vb, bf16x8 pa0, bf16x8 pa1, bf16x8 pa2, bf16x8 pa3) {
  pv_one<0>(o[0], vb, pa0, pa1, pa2, pa3); pv_one<1>(o[1], vb, pa0, pa1, pa2, pa3); pv_one<2>(o[2], vb, pa0, pa1, pa2, pa3); pv_one<3>(o[3], vb, pa0, pa1, pa2, pa3);
}
template <bool DSA> __device__ __forceinline__ void exp16(f32x16& p, unsigned bits, bool near, const LAS float* bt) {
  if (DSA) { if (near) {
#pragma unroll
    for (int r = 0; r < 16; ++r) p[r] += bt[(r & 3) + 8 * (r >> 2)]; } }
#pragma unroll
  for (int r = 0; r < 16; ++r) {
    float v = p[r];
    v = __builtin_amdgcn_exp2f(v);
    if (DSA) { const int m = ((int)(bits << (31 - ((r & 3) + 8 * (r >> 2))))) >> 31; v = __uint_as_float(__float_as_uint(v) & (unsigned)m); }
    p[r] = v;
  }
}
__device__ __forceinline__ void pack_p(const f32x16& p0, const f32x16& p1, float& l_reg, bf16x8& pa0, bf16x8& pa1, bf16x8& pa2, bf16x8& pa3) {
  float ps = 0.f;
#pragma unroll
  for (int r = 0; r < 16; ++r) ps += p0[r];
#pragma unroll
  for (int r = 0; r < 16; ++r) ps += p1[r];
  l_reg += ps;
#define PK4(P, BASE, OUT) do { unsigned a0 = cvt_pk_bf16(P[BASE + 0], P[BASE + 1]), a1 = cvt_pk_bf16(P[BASE + 2], P[BASE + 3]);   \
    unsigned b0 = cvt_pk_bf16(P[BASE + 4], P[BASE + 5]), b1 = cvt_pk_bf16(P[BASE + 6], P[BASE + 7]);                              \
    auto r0 = __builtin_amdgcn_permlane32_swap(a0, b0, false, false); auto r1 = __builtin_amdgcn_permlane32_swap(a1, b1, false, false); \
    u32x4 w = {r0[0], r1[0], r0[1], r1[1]}; OUT = *reinterpret_cast<bf16x8*>(&w); } while (0)
  PK4(p0, 0, pa0); PK4(p0, 8, pa1); PK4(p1, 0, pa2); PK4(p1, 8, pa3);
#undef PK4
}

constexpr int SHM_V = 64 * 128 * 2;
template <int DQK> struct Cfg { static constexpr int ND0 = DQK / 16, RB = DQK * 2, SHM_K = 64 * RB, NJ = SHM_K / 8192  , K_OFF = 3 * SHM_V, WS_OFF = K_OFF + 3 * SHM_K, BT_OFF = WS_OFF + 8 * 64 * 4, MW_OFF = BT_OFF + 2048  ; };

template <int DQK, bool DSA>
__device__ __forceinline__ void attn_item(LAS unsigned char* lds, const bf16_t* __restrict__ Qg, const bf16_t* __restrict__ Kg, const bf16_t* __restrict__ Vg, f16* __restrict__ Y, int ycol0,
                                          const unsigned* __restrict__ MASK, const float* __restrict__ rel_bias, int b, int h, int qb, int wave, int lane) {
  using C = Cfg<DQK>;
  const int tid = wave * 64 + lane, r32 = lane & 31, hi = lane >> 5;
  const int i0 = qb * 256, r0 = i0 + wave * 32;
  const int NT = 4 * (qb + 1), mychunk = 4 * qb + (wave >> 1);
  const bf16_t* Kh = Kg + (size_t)(b * 8 + h) * S_ * DQK;
  const bf16_t* Vh = Vg + (size_t)(b * 8 + h) * S_ * 128;
  LAS unsigned char* V_lds = lds; LAS unsigned char* K_lds = lds + C::K_OFF;
  LAS float* li_l = (LAS float*)(lds + C::WS_OFF) + wave * 64;
  LAS float* BT = (LAS float*)(lds + C::BT_OFF);
  bf16x8 qr[C::ND0];
  { const bf16_t* Qw = Qg + ((size_t)(b * 8 + h) * S_ + r0 + r32) * DQK + hi * 8;
#pragma unroll
    for (int d0 = 0; d0 < C::ND0; ++d0) qr[d0] = *(const bf16x8*)(Qw + d0 * 16); }
  float bias_far = 0.f;
  if (DSA) bias_far = rel_bias[15 * 8 + h] * LOG2E;
  unsigned kof[C::NJ], vof[2];
#pragma unroll
  for (int jj = 0; jj < C::NJ; ++jj) { const int p = (wave * C::NJ + jj) * 1024 + lane * 16, key = p / C::RB, chp = (p % C::RB) >> 4; const int xs = (DQK == 192) ? ((key >> 1) & 7) : (key & 15);
    kof[jj] = (unsigned)(key * DQK + ((chp ^ xs) * 8)) * 2u; }
#pragma unroll
  for (int jj = 0; jj < 2; ++jj) { const int p = (wave * 2 + jj) * 1024 + lane * 16, sub = p >> 9, q = (p & 511) >> 1, kk = (sub >> 2) * 8 + (q >> 5), c = (sub & 3) * 32 + (q & 31);
    const int key = (kk & ~0xC) | ((kk & 4) << 1) | ((kk & 8) >> 1); vof[jj] = (unsigned)(key * 128 + c) * 2u; }
  const int vb0 = (int)(uintptr_t)V_lds + v_rd_base(lane);
  const int xs_r = (DQK == 192) ? ((r32 >> 1) & 7) : (r32 & 15);
  int kb[8];
#pragma unroll
  for (int q = 0; q < 8; ++q) kb[q] = (DQK == 192) ? r32 * C::RB + ((((2 * q + hi) & 7) ^ xs_r) << 4) : r32 * C::RB + (((2 * q + hi) ^ xs_r) << 4);
#define KADDR(d0) ((DQK == 192) ? kb[(d0) & 3] + ((d0) >> 2) * 128 : kb[(d0) & 7])
  u32x2 mw = {0u, 0u};
  const unsigned* mrowl = DSA ? MASK + (size_t)(b * S_ + r0 + (lane >> 1)) * 128 + (lane & 1) : nullptr;
  LAS unsigned char* MW = lds + C::MW_OFF + wave * 256;
#define TILE_DMA(t, slot) do { int to_ = (t) * 64; asm volatile("" : "+s"(to_)); const char* kg_ = (const char*)Kh + (size_t)to_ * (DQK * 2); const char* vg_ = (const char*)Vh + (size_t)to_ * 256; const int sl_ = (slot); \
    _Pragma("unroll") for (int jj_ = 0; jj_ < C::NJ; ++jj_) __builtin_amdgcn_global_load_lds((const unsigned*)(kg_ + kof[jj_]), (LAS unsigned*)(K_lds + sl_ * C::SHM_K + (wave * C::NJ + jj_) * 1024), 16, 0, 0); \
    _Pragma("unroll") for (int jj_ = 0; jj_ < 2; ++jj_) __builtin_amdgcn_global_load_lds((const unsigned*)(vg_ + vof[jj_]), (LAS unsigned*)(V_lds + sl_ * SHM_V + (wave * 2 + jj_) * 1024), 16, 0, 0); \
    if (DSA) __builtin_amdgcn_global_load_lds((const unsigned*)(mrowl + 2 * (t)), (LAS unsigned*)(MW + sl_ * 2048), 4, 0, 0); } while (0)
#define TILE_OFF(j) ((DSA) ? (((64 * (j) + 154) <= r0) ? bias_far : 0.f) : (((j) <= mychunk) ? 0.f : -1e30f))
#define TILE_NEAR(j) ((64 * (j) + 154) > r0)
#define QKT(P0, P1, bf, j) do { const float off_ = TILE_OFF(j); \
    _Pragma("unroll") for (int rr_ = 0; rr_ < 16; ++rr_) { P0[rr_] = off_; P1[rr_] = off_; } \
    const LAS unsigned char* Kp = K_lds + (bf) * C::SHM_K; \
    _Pragma("unroll") for (int d0 = 0; d0 < C::ND0; ++d0) { \
      const bf16x8 b0 = *(const LAS bf16x8*)(Kp + KADDR(d0)); const bf16x8 b1 = *(const LAS bf16x8*)(Kp + KADDR(d0) + 32 * C::RB); \
      P0 = __builtin_amdgcn_mfma_f32_32x32x16_bf16(b0, qr[d0], P0, 0, 0, 0); P1 = __builtin_amdgcn_mfma_f32_32x32x16_bf16(b1, qr[d0], P1, 0, 0, 0); } } while (0)
#define BTP(j) (BT + (64 * (j) - r0 - r32 + 4 * hi + 256))
#define MWFIX(mw, j) do { if (DSA) { if ((j) > mychunk) { mw.x = 0u; mw.y = 0u; } mw.x >>= (4 * hi); mw.y >>= (4 * hi); } } while (0)
  f32x16 o[4];
#pragma unroll
  for (int d = 0; d < 4; ++d)
#pragma unroll
    for (int r = 0; r < 16; ++r) o[d][r] = 0.f;
  float l_reg = 0.f;
  f32x16 p0, p1; bf16x8 pa0, pa1, pa2, pa3;
  asm volatile("s_waitcnt lgkmcnt(0)" ::: "memory"); __builtin_amdgcn_s_barrier(); asm volatile("" ::: "memory");
  if (DSA) { if (tid < 320) BT[tid] = rel_bias[t5_bucket(tid - 256) * 8 + h] * LOG2E; }
  TILE_DMA(0, 0); TILE_DMA(1, 1);
#define TILE_BODY(jt, SL, SL2) do { const int j_ = (jt); \
    if (j_ + 1 < NT) asm volatile("s_waitcnt vmcnt(5)" ::: "memory"); else asm volatile("s_waitcnt vmcnt(0)" ::: "memory"); \
    asm volatile("s_waitcnt lgkmcnt(0)" ::: "memory"); __builtin_amdgcn_s_barrier(); asm volatile("" ::: "memory"); \
    if (j_ + 2 < NT) TILE_DMA(j_ + 2, SL2); \
    if (DSA) { mw = *(const LAS u32x2*)(MW + (SL) * 2048 + r32 * 8); MWFIX(mw, j_); } \
    SBAR(); QKT(p0, p1, SL, j_); \
    exp16<DSA>(p0, mw.x, TILE_NEAR(j_), BTP(j_)); exp16<DSA>(p1, mw.y, TILE_NEAR(j_), BTP(j_) + 32); \
    pack_p(p0, p1, l_reg, pa0, pa1, pa2, pa3); SBAR(); \
    pv_d0(o, vb0 + (SL) * SHM_V, pa0, pa1, pa2, pa3); } while (0)
#pragma unroll 1
  for (int j = 0; j < NT; j += 3) {
    TILE_BODY(j, 0, 2);
    if (j + 1 < NT) TILE_BODY(j + 1, 1, 0);
    if (j + 2 < NT) TILE_BODY(j + 2, 2, 1);
  }
#undef TILE_BODY
  { auto rr = __builtin_amdgcn_permlane32_swap(__float_as_uint(l_reg), __float_as_uint(l_reg), false, false); l_reg = __uint_as_float(rr[0]) + __uint_as_float(rr[1]); }
  if (hi == 0) li_l[r32] = l_reg;
  asm volatile("s_waitcnt lgkmcnt(0)" ::: "memory");
  float rli[16];
#pragma unroll
  for (int r = 0; r < 16; ++r) rli[r] = __builtin_amdgcn_rcpf(li_l[crow(r, hi)]);
  f16* Yw = Y + (size_t)(b * S_ + r0) * 2048 + ycol0 + h * 128 + r32;
#pragma unroll
  for (int r = 0; r < 16; ++r) { const int orow = crow(r, hi);
#pragma unroll
    for (int d0 = 0; d0 < 4; ++d0) Yw[(size_t)orow * 2048 + d0 * 32] = (f16)(o[d0][r] * rli[r]); }
#undef TILE_DMA
#undef TILE_OFF
#undef TILE_NEAR
#undef QKT
#undef KADDR
#undef BTP
#undef MWFIX
}
#undef SBAR
}

__device__ __forceinline__ void attn_phase(LAS unsigned char* lds, unsigned char* ws, const float* rel_bias, int cu, int wave) {
  const int lane = lane_id_v();
  const int bh = cu >> 4, qb = cu & 15, b = bh >> 3, h = bh & 7;
  att::attn_item<192, false>(lds, (const bf16_t*)(ws + WS_QM), (const bf16_t*)(ws + WS_KM), (const bf16_t*)(ws + WS_VM), (f16*)(ws + WS_Y), 0, nullptr, nullptr, b, h, qb, wave, lane);
  att::attn_item<128, true>(lds, (const bf16_t*)(ws + WS_QD), (const bf16_t*)(ws + WS_KD), (const bf16_t*)(ws + WS_VD), (f16*)(ws + WS_Y), 1024, (const unsigned*)(ws + WS_MASK), rel_bias, b, h, 15 - qb, wave, lane);
}

#ifndef SEL_MODE
#define SEL_MODE 0
#endif
#ifndef SEL_INLANE
#define SEL_INLANE 1
#endif
#ifndef GATHER_SPLIT
#define GATHER_SPLIT 1
#endif
namespace peer {
__device__ __forceinline__ unsigned row_ror(unsigned x, int n) {
  switch (n) { case 1: return (unsigned)__builtin_amdgcn_update_dpp(0, (int)x, 0x121, 0xf, 0xf, false); case 2: return (unsigned)__builtin_amdgcn_update_dpp(0, (int)x, 0x122, 0xf, 0xf, false);
               case 4: return (unsigned)__builtin_amdgcn_update_dpp(0, (int)x, 0x124, 0xf, 0xf, false); default: return (unsigned)__builtin_amdgcn_update_dpp(0, (int)x, 0x128, 0xf, 0xf, false); }
}
__device__ __forceinline__ unsigned row_max_u32(unsigned x) { x = max(x, row_ror(x, 1)); x = max(x, row_ror(x, 2)); x = max(x, row_ror(x, 4)); x = max(x, row_ror(x, 8)); return x; }
__device__ __forceinline__ float row_sum_f32(float x) {
  x += __uint_as_float(row_ror(__float_as_uint(x), 1)); x += __uint_as_float(row_ror(__float_as_uint(x), 2)); x += __uint_as_float(row_ror(__float_as_uint(x), 4)); x += __uint_as_float(row_ror(__float_as_uint(x), 8)); return x; }
__device__ __forceinline__ float unsort_f32(unsigned u) { return __uint_as_float((u & 0x80000000u) ? (u & 0x7fffffffu) : ~u); }

__device__ __forceinline__ void top16_of_128(unsigned (&pk)[8][4], unsigned (&top)[4], int c) {
  unsigned t[4] = {0u, 0u, 0u, 0u};
#pragma unroll 1
  for (int round = 0; round < 16; ++round) {
    unsigned m[4];
#pragma unroll
    for (int reg = 0; reg < 4; ++reg) m[reg] = max(max(max(pk[0][reg], pk[1][reg]), max(pk[2][reg], pk[3][reg])), max(max(pk[4][reg], pk[5][reg]), max(pk[6][reg], pk[7][reg])));
#pragma unroll
    for (int reg = 0; reg < 4; ++reg) m[reg] = max(m[reg], row_ror(m[reg], 1));
#pragma unroll
    for (int reg = 0; reg < 4; ++reg) m[reg] = max(m[reg], row_ror(m[reg], 2));
#pragma unroll
    for (int reg = 0; reg < 4; ++reg) m[reg] = max(m[reg], row_ror(m[reg], 4));
#pragma unroll
    for (int reg = 0; reg < 4; ++reg) m[reg] = max(m[reg], row_ror(m[reg], 8));
#pragma unroll
    for (int reg = 0; reg < 4; ++reg) {
      if (c == round) t[reg] = m[reg];
#pragma unroll
      for (int nt = 0; nt < 8; ++nt) pk[nt][reg] = (pk[nt][reg] == m[reg]) ? 0u : pk[nt][reg];
    }
  }
#pragma unroll
  for (int reg = 0; reg < 4; ++reg) top[reg] = t[reg];
}

template <int SMODE>
__device__ __forceinline__ void select_task(const f16* __restrict__ QR, const f16* __restrict__ SK16, LAS u32x2* EG, int t0, int tg, int h, int lane) {
  const int c = lane & 15, q = lane >> 4, rowbase = lane & 48;
  unsigned top[2][4];
#pragma unroll
  for (int p = 0; p < 2; ++p) {
    f16x8 af[4];
    { const f16* qp = QR + (size_t)(t0 + 16 * tg + c) * 2048 + h * 256 + p * 128 + 8 * q;
#pragma unroll
      for (int s = 0; s < 4; ++s) af[s] = *(const f16x8*)(qp + 32 * s); }
    const f16* kp = SK16 + (size_t)((h * 2 + p) * 128 + c) * 128 + 8 * q;
    f16x8 bfr[8][4];
#pragma unroll
    for (int nt = 0; nt < 8; ++nt)
#pragma unroll
      for (int s = 0; s < 4; ++s) bfr[nt][s] = *(const f16x8*)(kp + (size_t)nt * 16 * 128 + 32 * s);
    asm volatile("s_waitcnt vmcnt(0)" ::: "memory"); __builtin_amdgcn_sched_barrier(0);
    unsigned pk[8][4];
#pragma unroll
    for (int nt = 0; nt < 8; ++nt) {
      f32x4 acc = {0.f, 0.f, 0.f, 0.f};
#pragma unroll
      for (int s = 0; s < 4; ++s) acc = __builtin_amdgcn_mfma_f32_16x16x32_f16(af[s], bfr[nt][s], acc, 0, 0, 0);
#pragma unroll
      for (int reg = 0; reg < 4; ++reg) pk[nt][reg] = (sortable_u32(acc[reg]) & ~0x7Fu) | (unsigned)(127 - (16 * nt + c));
    }
    if (SMODE != 1 && SMODE != 3) top16_of_128(pk, top[p], c); else { for (int reg = 0; reg < 4; ++reg) top[p][reg] = pk[reg][reg] ^ pk[reg + 4][reg]; }
  }
  if (SMODE == 2 || SMODE == 3) { for (int reg = 0; reg < 4; ++reg) EG[(16 * tg + 4 * q + reg) * 128 + h * 16 + c] = (u32x2){top[0][reg] & 16383u, top[1][reg]}; return; }
  int ci[4], cj[4];
#pragma unroll
  for (int r = 0; r < 4; ++r) { const int n = c + 16 * r; int i, j;
    if (n < 16) { i = 0; j = n; } else if (n < 24) { i = 1; j = n - 16; } else if (n < 29) { i = 2; j = n - 24; } else if (n < 33) { i = 3; j = n - 29; } else if (n < 36) { i = 4; j = n - 33; }
    else if (n < 42) { i = 5 + ((n - 36) >> 1); j = (n - 36) & 1; } else if (n < 50) { i = 8 + (n - 42); j = 0; } else { i = -1; j = 0; }
    ci[r] = i; cj[r] = j; }
  unsigned ck[4][4];
#pragma unroll
  for (int reg = 0; reg < 4; ++reg)
#pragma unroll
    for (int r = 0; r < 4; ++r) {
      const unsigned a = (unsigned)__shfl((int)top[0][reg], rowbase + (ci[r] < 0 ? 0 : ci[r])), b = (unsigned)__shfl((int)top[1][reg], rowbase + cj[r]);
      const float v = unsort_f32(a & ~0x7Fu) + unsort_f32(b & ~0x7Fu);
      ck[reg][r] = (ci[r] < 0) ? 0u : ((sortable_u32(v) & ~0xFFu) | (unsigned)(255 - (ci[r] * 16 + cj[r])));
    }
  unsigned tt[4] = {0u, 0u, 0u, 0u};
#pragma unroll 1
  for (int round = 0; round < 16; ++round) {
    unsigned m[4];
#pragma unroll
    for (int reg = 0; reg < 4; ++reg) m[reg] = max(max(ck[reg][0], ck[reg][1]), max(ck[reg][2], ck[reg][3]));
#pragma unroll
    for (int reg = 0; reg < 4; ++reg) m[reg] = max(m[reg], row_ror(m[reg], 1));
#pragma unroll
    for (int reg = 0; reg < 4; ++reg) m[reg] = max(m[reg], row_ror(m[reg], 2));
#pragma unroll
    for (int reg = 0; reg < 4; ++reg) m[reg] = max(m[reg], row_ror(m[reg], 4));
#pragma unroll
    for (int reg = 0; reg < 4; ++reg) m[reg] = max(m[reg], row_ror(m[reg], 8));
#pragma unroll
    for (int reg = 0; reg < 4; ++reg) {
      if (c == round) tt[reg] = m[reg];
#pragma unroll
      for (int r = 0; r < 4; ++r) ck[reg][r] = (ck[reg][r] == m[reg]) ? 0u : ck[reg][r];
    }
  }
#pragma unroll
  for (int reg = 0; reg < 4; ++reg) {
    const unsigned t = tt[reg];
    const int flat = 255 - (int)(t & 0xFFu); const float ct = unsort_f32(t & ~0xFFu);
    const unsigned k0 = (unsigned)__shfl((int)top[0][reg], rowbase + (flat >> 4)), k1 = (unsigned)__shfl((int)top[1][reg], rowbase + (flat & 15));
    const int expert = (127 - (int)(k0 & 0x7Fu)) * 128 + (127 - (int)(k1 & 0x7Fu));
    const float cmax = __shfl(ct, rowbase);
    const float e = __expf(ct - cmax);
    const float g = e / row_sum_f32(e);
    u32x2 w; w.x = (unsigned)expert; w.y = __float_as_uint(g);
    EG[(16 * tg + 4 * q + reg) * 128 + h * 16 + c] = w;
  }
}

__device__ __forceinline__ unsigned umed3(unsigned a, unsigned b, unsigned c) { unsigned r; asm("v_med3_u32 %0, %1, %2, %3" : "=v"(r) : "v"(a), "v"(b), "v"(c)); return r; }
__device__ __forceinline__ void ins16(unsigned (&L)[16], unsigned x, int n) {
#pragma unroll
  for (int i = 15; i >= 1; --i) if (i <= n) L[i] = umed3(L[i - 1], L[i], x);
  L[0] = max(L[0], x);
}
__device__ __forceinline__ void merge_pair32(unsigned (&L)[16]) {
  unsigned P[16];
#pragma unroll
  for (int i = 0; i < 16; ++i) P[i] = (unsigned)__shfl_xor((int)L[15 - i], 32);
#pragma unroll
  for (int i = 0; i < 16; ++i) L[i] = max(L[i], P[i]);
#pragma unroll
  for (int d = 8; d >= 1; d >>= 1)
#pragma unroll
    for (int i = 0; i < 16; ++i) if ((i & d) == 0) { const unsigned a = L[i], b = L[i + d]; L[i] = max(a, b); L[i + d] = min(a, b); }
}
__device__ __forceinline__ unsigned byte16(const unsigned (&w)[4], unsigned i) {
  const unsigned sel = (i & 7u) | 0x0c0c0c00u;
  const unsigned lo = __builtin_amdgcn_perm(w[1], w[0], sel), hi = __builtin_amdgcn_perm(w[3], w[2], sel);
  return (i & 8u) ? hi : lo;
}
__device__ __forceinline__ void select_head(const f16* __restrict__ QR, const f16* __restrict__ SK16, LAS u32x2* EG, int t0, int h, int lane) {
  const int n = lane & 31, hf = lane >> 5;
  const unsigned nhf4 = hf ? 0u : 4u;
  unsigned top[2][16];
#pragma unroll
  for (int p = 0; p < 2; ++p) {
    const f16* qp = QR + (size_t)(t0 + n) * 2048 + h * 256 + p * 128 + 8 * hf;
    const f16* kp = SK16 + (size_t)((h * 2 + p) * 128 + n) * 128 + 8 * hf;
    f16x8 tk[8];
#pragma unroll
    for (int s = 0; s < 8; ++s) tk[s] = *(const f16x8*)(qp + 16 * s);
    unsigned L[16];
#pragma unroll
    for (int i = 0; i < 16; ++i) L[i] = 0u;
#pragma unroll
    for (int st = 0; st < 2; ++st) {
      f16x8 kf[2][8];
#pragma unroll
      for (int k2 = 0; k2 < 2; ++k2)
#pragma unroll
        for (int s = 0; s < 8; ++s) kf[k2][s] = *(const f16x8*)(kp + (size_t)(32 * (2 * st + k2)) * 128 + 16 * s);
#pragma unroll
      for (int k2 = 0; k2 < 2; ++k2) {
        f32x16 acc;
#pragma unroll
        for (int r = 0; r < 16; ++r) acc[r] = 0.f;
#pragma unroll
        for (int s = 0; s < 8; ++s) acc = __builtin_amdgcn_mfma_f32_32x32x16_f16(kf[k2][s], tk[s], acc, 0, 0, 0);
#pragma unroll
        for (int r = 0; r < 16; ++r) {
          const int kt = 2 * st + k2, key0 = 32 * kt + (r & 3) + 8 * (r >> 2);
          const unsigned pk = ((sortable_u32(acc[r]) & ~0x7Fu) | nhf4) | (unsigned)((127 - key0) & ~4);
          ins16(L, pk, 16 * kt + r);
        }
      }
    }
    merge_pair32(L);
#pragma unroll
    for (int i = 0; i < 16; ++i) top[p][i] = L[i];
  }
  float X[16], Y[16];
#pragma unroll
  for (int i = 0; i < 16; ++i) { const float fa = unsort_f32(top[0][i] & ~0x7Fu), fb = unsort_f32(top[1][i] & ~0x7Fu); X[i] = hf ? fb : fa; Y[i] = hf ? fa : fb; }
  unsigned TT[16];
#pragma unroll
  for (int i = 0; i < 16; ++i) TT[i] = 0u;
  {
    int cnt = 0;
#pragma unroll
    for (int i = 0; i < 16; ++i)
#pragma unroll
      for (int j = i; j < 16; ++j) if ((i + 1) * (j + 1) <= 16) {
        const float v = X[i] + Y[j];
        const unsigned low = hf ? (unsigned)(255 - (16 * j + i)) : (unsigned)(255 - (16 * i + j));
        unsigned ck = (sortable_u32(v) & ~0xFFu) | low;
        if (i == j) ck = ((i & 1) == hf) ? ck : 0u;
        ins16(TT, ck, cnt); ++cnt;
      }
  }
  merge_pair32(TT);
  unsigned pa[4], pb[4];
#pragma unroll
  for (int w = 0; w < 4; ++w) {
    pa[w] = __builtin_amdgcn_perm(top[0][4 * w + 1], top[0][4 * w], 0x0c0c0400u) | __builtin_amdgcn_perm(top[0][4 * w + 3], top[0][4 * w + 2], 0x04000c0cu);
    pb[w] = __builtin_amdgcn_perm(top[1][4 * w + 1], top[1][4 * w], 0x0c0c0400u) | __builtin_amdgcn_perm(top[1][4 * w + 3], top[1][4 * w + 2], 0x04000c0cu);
  }
  const float cmax = unsort_f32(TT[0] & ~0xFFu);
  unsigned ex[8]; float ev[8]; float esum = 0.f;
#pragma unroll
  for (int k = 0; k < 8; ++k) {
    const unsigned t = hf ? TT[8 + k] : TT[k];
    const unsigned flat = (t & 0xFFu) ^ 0xFFu;
    const unsigned a7 = byte16(pa, flat >> 4) & 0x7Fu, b7 = byte16(pb, flat & 15u) & 0x7Fu;
    ex[k] = 16383u - ((a7 << 7) | b7);
    ev[k] = __expf(unsort_f32(t & ~0xFFu) - cmax);
    esum += ev[k];
  }
  esum += __shfl_xor(esum, 32);
  const float rs = 1.0f / esum;
  LAS u32x4* ep = (LAS u32x4*)(EG + n * 128 + h * 16 + 8 * hf);
#pragma unroll
  for (int k = 0; k < 4; ++k) ep[k] = (u32x4){ex[2 * k], __float_as_uint(ev[2 * k] * rs), ex[2 * k + 1], __float_as_uint(ev[2 * k + 1] * rs)};
}

__device__ __forceinline__ void gather_token(const unsigned char* __restrict__ U6, const unsigned char* __restrict__ V6, const float* __restrict__ USC, const float* __restrict__ VSC,
                                             const f16* __restrict__ X2H, const float* __restrict__ SSQ2, const float* src, float* dst, const LAS u32x2* EG, int t, int tl, int lane) {
  typedef _Float16 h2 __attribute__((ext_vector_type(2)));
  f16x8 xh[4];
#pragma unroll
  for (int m = 0; m < 4; ++m) { const f16x4 lo4 = *(const f16x4*)(X2H + (size_t)t * 2048 + 4 * lane + 256 * (2 * m)), hi4 = *(const f16x4*)(X2H + (size_t)t * 2048 + 4 * lane + 256 * (2 * m + 1));
    xh[m] = (f16x8){lo4[0], lo4[1], lo4[2], lo4[3], hi4[0], hi4[1], hi4[2], hi4[3]}; }
  float ss = lane < 32 ? SSQ2[(size_t)t * 32 + lane] : 0.f;
  const float r2 = 1.0f / sqrtf(wave_sum(ss) * (1.0f / 2048.0f) + EPS);
  f32x32 acc;
#pragma unroll
  for (int i = 0; i < 32; ++i) acc[i] = 0.f;
  const LAS u32x2* eg = EG + tl * 128;
  typedef unsigned u32x16 __attribute__((ext_vector_type(16)));
#define FP4PAIR(dw, k) ((k) == 0 ? __builtin_amdgcn_cvt_scalef32_pk_f16_fp4(dw, 1.0f, 0) : (k) == 1 ? __builtin_amdgcn_cvt_scalef32_pk_f16_fp4(dw, 1.0f, 1) : (k) == 2 ? __builtin_amdgcn_cvt_scalef32_pk_f16_fp4(dw, 1.0f, 2) : __builtin_amdgcn_cvt_scalef32_pk_f16_fp4(dw, 1.0f, 3))
#if TAB_U_FP4
  typedef u32x4 urow_t;
#define LOADU(dst, e) do { dst = *(const u32x4*)(U6 + (size_t)(e) * 1024 + 16 * lane); } while (0)
#define DOTROW(src, res) do { float d_ = 0.f; _Pragma("unroll") for (int i_ = 0; i_ < 4; ++i_) { _Pragma("unroll") for (int j_ = 0; j_ < 4; ++j_) { \
      const h2 a_ = FP4PAIR(src[i_], j_), b_ = {xh[i_][2 * j_], xh[i_][2 * j_ + 1]}; d_ = __builtin_amdgcn_fdot2(a_, b_, d_, false); } } res = d_; } while (0)
#else
  typedef u32x6 urow_t;
#define LOADU(dst, e) do { const u32x2* rp_ = (const u32x2*)(U6 + (size_t)(e) * 1536 + 24 * lane); const u32x2 q0_ = rp_[0], q1_ = rp_[1], q2_ = rp_[2]; dst = (u32x6){q0_.x, q0_.y, q1_.x, q1_.y, q2_.x, q2_.y}; } while (0)
#define DOTROW(src, res) do { const f16x32 uh_ = __builtin_amdgcn_cvt_scalef32_pk32_f16_fp6(src, 1.0f); float d_ = 0.f; _Pragma("unroll") for (int i_ = 0; i_ < 4; ++i_) { _Pragma("unroll") for (int j_ = 0; j_ < 4; ++j_) { \
      const h2 a_ = {uh_[8 * i_ + 2 * j_], uh_[8 * i_ + 2 * j_ + 1]}, b_ = {xh[i_][2 * j_], xh[i_][2 * j_ + 1]}; d_ = __builtin_amdgcn_fdot2(a_, b_, d_, false); } } res = d_; } while (0)
#endif
#if TAB_V_FP4
  typedef u32x4 vrow_t;
#define LOADV(dst, e) do { dst = *(const u32x4*)(V6 + (size_t)(e) * 1024 + 16 * lane); } while (0)
#define ACCROW(src, w) do { const _Float16 wh1_ = (_Float16)(w); const h2 wh_ = {wh1_, wh1_}; _Pragma("unroll") for (int i_ = 0; i_ < 4; ++i_) { _Pragma("unroll") for (int j_ = 0; j_ < 4; ++j_) { \
      const h2 c_ = FP4PAIR(src[i_], j_); accH[4 * i_ + j_] = __builtin_elementwise_fma(c_, wh_, accH[4 * i_ + j_]); } } } while (0)
#define ACCFLUSH() do { const float one_ = 1.0f; __builtin_amdgcn_sched_barrier(0); asm volatile("s_nop 1"); __builtin_amdgcn_sched_barrier(0); \
    _Pragma("unroll") for (int i_ = 0; i_ < 16; ++i_) { asm("v_fma_mix_f32 %0, %1, %2, %0 op_sel_hi:[1,0,0]" : "+v"(acc[2 * i_]) : "v"(accH[i_]), "v"(one_)); \
                                                       asm("v_fma_mix_f32 %0, %1, %2, %0 op_sel:[1,0,0] op_sel_hi:[1,0,0]" : "+v"(acc[2 * i_ + 1]) : "v"(accH[i_]), "v"(one_)); accH[i_] = (h2){(_Float16)0, (_Float16)0}; } } while (0)
#else
  typedef u32x6 vrow_t;
#define LOADV(dst, e) do { const u32x2* rp_ = (const u32x2*)(V6 + (size_t)(e) * 1536 + 24 * lane); const u32x2 q0_ = rp_[0], q1_ = rp_[1], q2_ = rp_[2]; dst = (u32x6){q0_.x, q0_.y, q1_.x, q1_.y, q2_.x, q2_.y}; } while (0)
#define ACCFLUSH() do { } while (0)
#define ACCROW(src, w) do { const f16x32 vh_ = __builtin_amdgcn_cvt_scalef32_pk32_f16_fp6(src, 1.0f); const u32x16 vr_ = __builtin_bit_cast(u32x16, vh_); const float w_ = (w); \
    _Pragma("unroll") for (int i_ = 0; i_ < 16; ++i_) { asm("v_fma_mix_f32 %0, %1, %2, %0 op_sel_hi:[1,0,0]" : "+v"(acc[2 * i_]) : "v"(vr_[i_]), "v"(w_)); \
                                                       asm("v_fma_mix_f32 %0, %1, %2, %0 op_sel:[1,0,0] op_sel_hi:[1,0,0]" : "+v"(acc[2 * i_ + 1]) : "v"(vr_[i_]), "v"(w_)); } } while (0)
#endif
#define GELU_F(v) ({ const float v_ = (v), av_ = fabsf(v_), tt_ = __builtin_amdgcn_rcpf(fmaf(av_, 0.2316418882f, 1.0f)); \
    float q_ = fmaf(tt_, 0.5307027145f, -0.7265760135f); q_ = fmaf(q_, tt_, 0.7107068705f); q_ = fmaf(q_, tt_, -0.142248368f); q_ = fmaf(q_, tt_, 0.127414796f); q_ *= tt_; \
    const float m_ = v_ * (q_ * __builtin_amdgcn_exp2f(v_ * v_ * -0.72134752044f)); v_ < 0.f ? m_ : v_ - m_; })
#define REDUCE4W(d, eg4, wout) do { \
    { auto r_ = __builtin_amdgcn_permlane32_swap(__float_as_uint(d[0]), __float_as_uint(d[1]), false, false); d[0] = __uint_as_float(r_[0]) + __uint_as_float(r_[1]); } \
    { auto r_ = __builtin_amdgcn_permlane32_swap(__float_as_uint(d[2]), __float_as_uint(d[3]), false, false); d[2] = __uint_as_float(r_[0]) + __uint_as_float(r_[1]); } \
    const bool q1_ = (lane & 16) != 0, q2_ = (lane & 32) != 0; const float keep_ = q1_ ? d[2] : d[0], send_ = q1_ ? d[0] : d[2]; \
    float s_ = keep_ + __shfl_xor(send_, 16); \
    s_ = peer::row_sum_f32(s_); \
    const u32x2 em_ = q1_ ? (q2_ ? eg4[3] : eg4[2]) : (q2_ ? eg4[1] : eg4[0]);     \
    const float a_ = s_ * r2 * USC[em_.x]; const float wq_ = __uint_as_float(em_.y) * VSC[em_.x] * GELU_F(a_); \
    wout[0] = __uint_as_float(__builtin_amdgcn_readlane(__float_as_uint(wq_), 0)); wout[1] = __uint_as_float(__builtin_amdgcn_readlane(__float_as_uint(wq_), 32)); \
    wout[2] = __uint_as_float(__builtin_amdgcn_readlane(__float_as_uint(wq_), 16)); wout[3] = __uint_as_float(__builtin_amdgcn_readlane(__float_as_uint(wq_), 48)); } while (0)
  constexpr int GS = 4;
  h2 accH[16];
#pragma unroll
  for (int i = 0; i < 16; ++i) accH[i] = (h2){(_Float16)0, (_Float16)0};
  urow_t ua[GS], ub[GS]; vrow_t va[GS];
  u32x2 ea[GS], eb[GS];
#pragma unroll
  for (int i = 0; i < GS; ++i) { ea[i] = eg[i]; LOADU(ua[i], ea[i].x); }
#pragma unroll 1
  for (int k = 0; k < 128; k += 2 * GS) {
#pragma unroll
    for (int i = 0; i < GS; ++i) eb[i] = eg[k + GS + i];
#pragma unroll
    for (int i = 0; i < GS; ++i) LOADV(va[i], ea[i].x);
#pragma unroll
    for (int i = 0; i < GS; ++i) LOADU(ub[i], eb[i].x);
    { float d[GS], w[GS];
#pragma unroll
      for (int i = 0; i < GS; ++i) DOTROW(ua[i], d[i]);
      REDUCE4W(d, ea, w);
#pragma unroll
      for (int i = 0; i < GS; ++i) { ACCROW(va[i], w[i]); __builtin_amdgcn_sched_barrier(0); } }
    const int kn = (k + 2 * GS < 128) ? k + 2 * GS : 0;
#pragma unroll
    for (int i = 0; i < GS; ++i) ea[i] = eg[kn + i];
#pragma unroll
    for (int i = 0; i < GS; ++i) LOADV(va[i], eb[i].x);
#pragma unroll
    for (int i = 0; i < GS; ++i) LOADU(ua[i], ea[i].x);
    { float d[GS], w[GS];
#pragma unroll
      for (int i = 0; i < GS; ++i) DOTROW(ub[i], d[i]);
      REDUCE4W(d, eb, w);
#pragma unroll
      for (int i = 0; i < GS; ++i) { ACCROW(va[i], w[i]); __builtin_amdgcn_sched_barrier(0); } }
    ACCFLUSH();
  }
#undef REDUCE4W
#undef ACCFLUSH
#undef GELU_F
#undef LOADU
#undef LOADV
#undef FP4PAIR
#undef DOTROW
#undef ACCROW
  float* op = dst + (size_t)t * 2048 + 4 * lane;
#pragma unroll
  for (int i = 0; i < 8; ++i) { const f16x8 xv = xh[i >> 1]; const int o = 4 * (i & 1);
    __builtin_nontemporal_store((f32x4){(float)xv[o] + acc[4 * i], (float)xv[o + 1] + acc[4 * i + 1], (float)xv[o + 2] + acc[4 * i + 2], (float)xv[o + 3] + acc[4 * i + 3]}, (f32x4*)(op + 256 * i)); }
}

#if TAB_U_FP4 && TAB_V_FP4
#define FP4PAIR(dw, k) ((k) == 0 ? __builtin_amdgcn_cvt_scalef32_pk_f16_fp4(dw, 1.0f, 0) : (k) == 1 ? __builtin_amdgcn_cvt_scalef32_pk_f16_fp4(dw, 1.0f, 1) : (k) == 2 ? __builtin_amdgcn_cvt_scalef32_pk_f16_fp4(dw, 1.0f, 2) : __builtin_amdgcn_cvt_scalef32_pk_f16_fp4(dw, 1.0f, 3))
#define GELU_F(v) ({ const float v_ = (v), av_ = fabsf(v_), tt_ = __builtin_amdgcn_rcpf(fmaf(av_, 0.2316418882f, 1.0f)); \
    float q_ = fmaf(tt_, 0.5307027145f, -0.7265760135f); q_ = fmaf(q_, tt_, 0.7107068705f); q_ = fmaf(q_, tt_, -0.142248368f); q_ = fmaf(q_, tt_, 0.127414796f); q_ *= tt_; \
    const float m_ = v_ * (q_ * __builtin_amdgcn_exp2f(v_ * v_ * -0.72134752044f)); v_ < 0.f ? m_ : v_ - m_; })
__device__ __forceinline__ void gather_u_token(const unsigned char* __restrict__ U6, const float* __restrict__ USC, const float* __restrict__ VSC, const f16* __restrict__ X2H, const float* __restrict__ SSQ2,
                                               const LAS u32x2* EG, LAS float* WL, int t, int tl, int lane) {
  typedef _Float16 h2 __attribute__((ext_vector_type(2)));
  f16x8 xh[4];
#pragma unroll
  for (int m = 0; m < 4; ++m) { const f16x4 lo4 = *(const f16x4*)(X2H + (size_t)t * 2048 + 4 * lane + 256 * (2 * m)), hi4 = *(const f16x4*)(X2H + (size_t)t * 2048 + 4 * lane + 256 * (2 * m + 1));
    xh[m] = (f16x8){lo4[0], lo4[1], lo4[2], lo4[3], hi4[0], hi4[1], hi4[2], hi4[3]}; }
  float ss = lane < 32 ? SSQ2[(size_t)t * 32 + lane] : 0.f;
  const float r2 = 1.0f / sqrtf(wave_sum(ss) * (1.0f / 2048.0f) + EPS);
  const LAS u32x2* eg = EG + tl * 128;
  LAS float* wl = WL + tl * 128;
#define LOADU(dst, e) do { dst = *(const u32x4*)(U6 + (size_t)(e) * 1024 + 16 * lane); } while (0)
#define DOTROW(src, res) do { float d_ = 0.f; _Pragma("unroll") for (int i_ = 0; i_ < 4; ++i_) { _Pragma("unroll") for (int j_ = 0; j_ < 4; ++j_) { \
      const h2 a_ = FP4PAIR(src[i_], j_), b_ = {xh[i_][2 * j_], xh[i_][2 * j_ + 1]}; d_ = __builtin_amdgcn_fdot2(a_, b_, d_, false); } } res = d_; } while (0)
#define REDUCE4S(d, eg4, kbase) do { \
    { auto r_ = __builtin_amdgcn_permlane32_swap(__float_as_uint(d[0]), __float_as_uint(d[1]), false, false); d[0] = __uint_as_float(r_[0]) + __uint_as_float(r_[1]); } \
    { auto r_ = __builtin_amdgcn_permlane32_swap(__float_as_uint(d[2]), __float_as_uint(d[3]), false, false); d[2] = __uint_as_float(r_[0]) + __uint_as_float(r_[1]); } \
    const bool q1_ = (lane & 16) != 0, q2_ = (lane & 32) != 0; const float keep_ = q1_ ? d[2] : d[0], send_ = q1_ ? d[0] : d[2]; \
    float s_ = keep_ + __shfl_xor(send_, 16); \
    s_ = peer::row_sum_f32(s_); \
    const float a_ = s_ * r2 * (eg4).us; const float wq_ = __uint_as_float((eg4).em.y) * (eg4).vs * GELU_F(a_); \
    if ((lane & 15) == 0) wl[(kbase) + (q1_ ? 2 : 0) + (q2_ ? 1 : 0)] = wq_; } while (0)
  struct QSel { u32x2 em; float us, vs; };
#define QSEL(q, e4) do { const bool q1_ = (lane & 16) != 0, q2_ = (lane & 32) != 0; q.em = q1_ ? (q2_ ? e4[3] : e4[2]) : (q2_ ? e4[1] : e4[0]); q.us = USC[q.em.x]; q.vs = VSC[q.em.x]; } while (0)
  constexpr int GS = 4;
  u32x4 ua[GS], ub[GS]; u32x2 ea[GS], eb[GS]; QSel qa, qb;
#pragma unroll
  for (int i = 0; i < GS; ++i) ea[i] = eg[i];
  QSEL(qa, ea);
#pragma unroll
  for (int i = 0; i < GS; ++i) LOADU(ua[i], ea[i].x);
#pragma unroll 1
  for (int k = 0; k < 128; k += 2 * GS) {
#pragma unroll
    for (int i = 0; i < GS; ++i) eb[i] = eg[k + GS + i];
    QSEL(qb, eb);
#pragma unroll
    for (int i = 0; i < GS; ++i) LOADU(ub[i], eb[i].x);
    { float d[GS];
#pragma unroll
      for (int i = 0; i < GS; ++i) DOTROW(ua[i], d[i]);
      REDUCE4S(d, qa, k); }
    const int kn = (k + 2 * GS < 128) ? k + 2 * GS : 0;
#pragma unroll
    for (int i = 0; i < GS; ++i) ea[i] = eg[kn + i];
    QSEL(qa, ea);
#pragma unroll
    for (int i = 0; i < GS; ++i) LOADU(ua[i], ea[i].x);
    { float d[GS];
#pragma unroll
      for (int i = 0; i < GS; ++i) DOTROW(ub[i], d[i]);
      REDUCE4S(d, qb, k + GS); }
  }
#undef QSEL
#undef LOADU
#undef DOTROW
#undef REDUCE4S
}
__device__ __forceinline__ void gather_v_token(const unsigned char* __restrict__ V6, const f16* __restrict__ X2H, float* dst, const LAS u32x2* EG, const LAS float* WL, int t, int tl, int lane) {
  typedef _Float16 h2 __attribute__((ext_vector_type(2)));
  f32x32 acc;
#pragma unroll
  for (int i = 0; i < 32; ++i) acc[i] = 0.f;
  h2 accH[16];
#pragma unroll
  for (int i = 0; i < 16; ++i) accH[i] = (h2){(_Float16)0, (_Float16)0};
  const LAS u32x2* eg = EG + tl * 128;
  const LAS float* wl = WL + tl * 128;
#define LOADV(dst, e) do { dst = *(const u32x4*)(V6 + (size_t)(e) * 1024 + 16 * lane); } while (0)
#define ACCROW(src, w) do { const _Float16 wh1_ = (_Float16)(w); const h2 wh_ = {wh1_, wh1_}; _Pragma("unroll") for (int i_ = 0; i_ < 4; ++i_) { _Pragma("unroll") for (int j_ = 0; j_ < 4; ++j_) { \
      const h2 c_ = FP4PAIR(src[i_], j_); accH[4 * i_ + j_] = __builtin_elementwise_fma(c_, wh_, accH[4 * i_ + j_]); } } } while (0)
#define ACCFLUSH() do { const float one_ = 1.0f; __builtin_amdgcn_sched_barrier(0); asm volatile("s_nop 1"); __builtin_amdgcn_sched_barrier(0); \
    _Pragma("unroll") for (int i_ = 0; i_ < 16; ++i_) { asm("v_fma_mix_f32 %0, %1, %2, %0 op_sel_hi:[1,0,0]" : "+v"(acc[2 * i_]) : "v"(accH[i_]), "v"(one_)); \
                                                       asm("v_fma_mix_f32 %0, %1, %2, %0 op_sel:[1,0,0] op_sel_hi:[1,0,0]" : "+v"(acc[2 * i_ + 1]) : "v"(accH[i_]), "v"(one_)); accH[i_] = (h2){(_Float16)0, (_Float16)0}; } } while (0)
  constexpr int GS = 4;
  u32x4 va[GS], vb[GS];
#pragma unroll
  for (int i = 0; i < GS; ++i) LOADV(va[i], eg[i].x);
#pragma unroll 1
  for (int k = 0; k < 128; k += 2 * GS) {
#pragma unroll
    for (int i = 0; i < GS; ++i) LOADV(vb[i], eg[k + GS + i].x);
    { const f32x4 w4 = *(const LAS f32x4*)(wl + k);
#pragma unroll
      for (int i = 0; i < GS; ++i) { ACCROW(va[i], w4[i]); __builtin_amdgcn_sched_barrier(0); } }
    const int kn = (k + 2 * GS < 128) ? k + 2 * GS : 0;
#pragma unroll
    for (int i = 0; i < GS; ++i) LOADV(va[i], eg[kn + i].x);
    { const f32x4 w4 = *(const LAS f32x4*)(wl + k + GS);
#pragma unroll
      for (int i = 0; i < GS; ++i) { ACCROW(vb[i], w4[i]); __builtin_amdgcn_sched_barrier(0); } }
    ACCFLUSH();
  }
#undef LOADV
#undef ACCROW
#undef ACCFLUSH
  float* op = dst + (size_t)t * 2048 + 4 * lane;
#pragma unroll
  for (int i = 0; i < 8; ++i) { const f16x4 xv = *(const f16x4*)(X2H + (size_t)t * 2048 + 4 * lane + 256 * i);
    __builtin_nontemporal_store((f32x4){(float)xv[0] + acc[4 * i], (float)xv[1] + acc[4 * i + 1], (float)xv[2] + acc[4 * i + 2], (float)xv[3] + acc[4 * i + 3]}, (f32x4*)(op + 256 * i)); }
}
#undef FP4PAIR
#undef GELU_F
#endif
}

__device__ __forceinline__ void peer_phase(LAS unsigned char* lds, unsigned char* ws, const float* src, float* dst, int cu, int wave) {
  const int lane = lane_id_v();
  LAS u32x2* EG = (LAS u32x2*)lds;
  const int t0 = cu * 32;
  __syncthreads();
#if defined(MK_REPEAT)
#endif
#if SEL_INLANE
#if defined(MK_REPEAT)
  _Pragma("unroll 1") for (int rep8_ = 0; rep8_ < (MK_REPEAT == 8 ? 5 : 1); ++rep8_) { if (rep8_) WG_BAR(); asm volatile("" : "+s"(ws) :: "memory");
#endif
  peer::select_head((const f16*)(ws + WS_QR), (const f16*)(ws + WS_SK16), EG, t0, wave, lane);
#if defined(MK_REPEAT)
  }
#endif
#else
#pragma unroll 1
  for (int k = 0; k < 2; ++k) { const int task = wave + 8 * k; peer::select_task<0>((const f16*)(ws + WS_QR), (const f16*)(ws + WS_SK16), EG, t0, task & 1, task >> 1, lane); }
#endif
  WG_BAR();
#if GATHER_SPLIT && TAB_U_FP4 && TAB_V_FP4
  LAS float* WL = (LAS float*)(lds + 32768);
#pragma unroll 1
  for (int k = 0; k < 4; ++k) { const int tl = wave + 8 * k; peer::gather_u_token(ws + WS_U16, (const float*)(ws + WS_USCL), (const float*)(ws + WS_VSCL), (const f16*)(ws + WS_XN), (const float*)(ws + WS_SSQ2), EG, WL, t0 + tl, tl, lane); }
  WG_BAR();
#pragma unroll 1
  for (int k = 0; k < 4; ++k) { const int tl = wave + 8 * k; peer::gather_v_token(ws + WS_V16, (const f16*)(ws + WS_XN), dst, EG, WL, t0 + tl, tl, lane); }
#else
#pragma unroll 1
  for (int k = 0; k < 4; ++k) { const int tl = wave + 8 * k; peer::gather_token(ws + WS_U16, ws + WS_V16, (const float*)(ws + WS_USCL), (const float*)(ws + WS_VSCL), (const f16*)(ws + WS_XN), (const float*)(ws + WS_SSQ2), src, dst, EG, t0 + tl, tl, lane); }
#endif
}
#ifndef IDX_MODE
#define IDX_MODE 0
#endif
#define PHASE2_PROBE idx_phase<IDX_MODE>(lds + RING_OFF, (const f16*)(ws + WS_QI), (const f16*)(ws + WS_KI), (const float*)(ws + WS_WI), (unsigned*)(ws + WS_MASK), c, wave);
#define PHASE2_EXTRA idx_phase<0>(lds + RING_OFF, (const f16*)(ws + WS_QI), (const f16*)(ws + WS_KI), (const float*)(ws + WS_WI), (unsigned*)(ws + WS_MASK), c, wave);
#ifndef PHASE2_EXTRA
#define PHASE2_EXTRA
#endif
#ifndef PHASES_4_TO_6
#define PHASES_4_TO_6
#endif
#ifndef DEBUG_STAGE_2
#define DEBUG_STAGE_2
#endif

#ifndef MK_DEBUG
#define MK_DEBUG 0
#endif
constexpr int N_PHASES = 7;
__global__ void __launch_bounds__(NTHR, 2) mk_fwd(Args args) {
    extern __shared__ __attribute__((aligned(16))) unsigned char lds_raw[];
    LAS unsigned char* lds = (LAS unsigned char*)lds_raw;
    const int wave = __builtin_amdgcn_readfirstlane(threadIdx.x >> 6);
    volatile LAS unsigned* MISC = (volatile LAS unsigned*)(lds + MISC_OFF);
    if (threadIdx.x < 64) MISC[threadIdx.x] = 0u;
    __syncthreads();
    unsigned char* ws = args.ws;
    const int lo = args.ph_lo, hi = args.ph_hi;
    const bool multi = (hi - lo) > 1;
    XcdBarrier bar; bar.bar = (unsigned*)(ws + WS_CTL); bar.x = 0; bar.st = nullptr; bar.wave = wave;
    if (multi) bar = xcd_barrier_post((unsigned*)(ws + WS_CTL), MISC + 8, wave);
#define IN(k) (lo <= (k) && (k) < hi)
#ifdef MK_REPEAT
#define REP(k) for (int rep_ = 0; rep_ < ((k) == MK_REPEAT ? 2 : 1); ++rep_, ((k) == MK_REPEAT && rep_ == 1 ? xcd_barrier(bar) : (void)0))
#else
#define REP(k)
#endif
#ifdef MK_PROBE
    unsigned long long* stamps = (unsigned long long*)(ws + 49152);
#define STAMP(k) do { if (blockIdx.x == 0 && wave == 0 && lane_id_v() == 0) stamps[k] = __builtin_amdgcn_s_memrealtime(); } while (0)
#else
#define STAMP(k) do { } while (0)
#endif
    STAMP(0);
#define SEAM(k) do { const bool slice_ = TAB_SEAM_ROWS > 0 && (k) >= 0 && (k) <= 4 && IN(k) && (MK_DEBUG == 0 || MK_DEBUG >= 6); const bool bar_ = IN(k) && IN((k) + 1); \
    if (slice_) { if (bar_) xcd_barrier_arrive(bar); p0_tables(args, TAB_ROWS_P2 + (k) * TAB_SEAM_ROWS + blockIdx.x * NWAVES + wave, gridDim.x * NWAVES, TAB_ROWS_P2 + ((k) + 1) * TAB_SEAM_ROWS, lane_id_v()); if (bar_) xcd_barrier_wait(bar); } \
    else if (bar_) xcd_barrier(bar); } while (0)
    const int c = blockIdx.x;
    LAS float* P = (LAS float*)(lds + EPI_OFF);

#if defined(MK_REPEAT)
    if (MK_REPEAT == 20) { int x_ = wave; asm volatile(".rept 16384\n\tv_add_u32 %0, 1, %0\n\t.endr" : "+v"(x_)); if (x_ == 12345) ((int*)(ws + 49152))[0] = x_; }
    if (MK_REPEAT == 22) { int a_ = wave, b_ = wave + 1, c_ = wave + 2, d_ = wave + 3; for (int i_ = 0; i_ < 64; ++i_) asm volatile(".rept 64\n\tv_max_i32 %0, 1, %0\n\tv_max_i32 %1, 1, %1\n\tv_max_i32 %2, 1, %2\n\tv_max_i32 %3, 1, %3\n\t.endr" : "+v"(a_), "+v"(b_), "+v"(c_), "+v"(d_)); if (a_ + b_ + c_ + d_ == 12345) ((int*)(ws + 49152))[0] = a_; }
    if (MK_REPEAT == 23) { unsigned a_ = wave, b_ = wave + 1, c_ = wave + 2, d_ = wave + 3, e_ = wave * 7; for (int i_ = 0; i_ < 64; ++i_) asm volatile(".rept 64\n\tv_med3_u32 %0, %0, %1, %4\n\tv_med3_u32 %1, %1, %2, %4\n\tv_med3_u32 %2, %2, %3, %4\n\tv_med3_u32 %3, %3, %0, %4\n\t.endr" : "+v"(a_), "+v"(b_), "+v"(c_), "+v"(d_) : "v"(e_)); if (a_ + b_ + c_ + d_ == 12345) ((int*)(ws + 49152))[0] = a_; }
    if (MK_REPEAT == 24) { f32x2 a_ = {1.f, 2.f}, b_ = {1.f, 2.f}, c_ = {1.f, 2.f}, d_ = {1.f, 2.f}, e_ = {0.5f, 0.25f}; for (int i_ = 0; i_ < 64; ++i_) asm volatile(".rept 64\n\tv_pk_fma_f32 %0, %0, %4, %4\n\tv_pk_fma_f32 %1, %1, %4, %4\n\tv_pk_fma_f32 %2, %2, %4, %4\n\tv_pk_fma_f32 %3, %3, %4, %4\n\t.endr" : "+v"(a_), "+v"(b_), "+v"(c_), "+v"(d_) : "v"(e_)); if (a_[0] + b_[0] + c_[0] + d_[1] == 12345.f) ((int*)(ws + 49152))[0] = 1; }
    if (MK_REPEAT == 25) { float a_ = 1.f, b_ = 2.f, c_ = 3.f, d_ = 4.f, e_ = 0.5f; for (int i_ = 0; i_ < 64; ++i_) asm volatile(".rept 64\n\tv_fma_f32 %0, %0, %4, %4\n\tv_fma_f32 %1, %1, %4, %4\n\tv_fma_f32 %2, %2, %4, %4\n\tv_fma_f32 %3, %3, %4, %4\n\t.endr" : "+v"(a_), "+v"(b_), "+v"(c_), "+v"(d_) : "v"(e_)); if (a_ + b_ + c_ + d_ == 12345.f) ((int*)(ws + 49152))[0] = 1; }
    if (MK_REPEAT == 21) { int x_ = wave; for (int i_ = 0; i_ < 64; ++i_) asm volatile(".rept 256\n\tv_add_u32 %0, 1, %0\n\t.endr" : "+v"(x_)); if (x_ == 12345) ((int*)(ws + 49152))[0] = x_; }
#endif
#if defined(MK_REPEAT)
    if (MK_REPEAT >= 10 && MK_REPEAT <= 12 && IN(0)) { p0_prologue(args, lds, wave, lane_id_v(), true, 1 << (MK_REPEAT - 10)); __syncthreads(); xcd_barrier(bar); }
#endif
    REP(0) if (IN(0)) { p0_prologue(args, lds, wave, lane_id_v(), MK_DEBUG == 0 || MK_DEBUG >= 6); __syncthreads(); }
    SEAM(0); STAMP(1);
    REP(1) if (IN(1)) {
        pg8::Gemm g{(const f16*)(ws + WS_XN), (const f16*)(ws + WS_WT_IN), T_, 4096, 2048}; pg8::StaticOrder S; S.init(T_, 4096, gridDim.x, c);
        EpiIn E{(f16*)(ws + WS_CQ), (f16*)(ws + WS_CKV), (float*)(ws + WS_SSQ_CQ), (float*)(ws + WS_SSQ_CKV), (bf16_t*)(ws + WS_QD), (bf16_t*)(ws + WS_KD), (f16*)(ws + WS_QI), (f16*)(ws + WS_KI),
                (float*)(ws + WS_WI), (float*)(ws + WS_KR), (float*)(ws + WS_SSQ_KR), args.in[I_GDQ], args.in[I_GDK], args.in[I_GMK], (const float*)(ws + WS_CS), P};
        pg8::gemm_phase<EpiIn, pg8::StaticOrder>(lds + RING_OFF, g, S, E, wave);
    }
    SEAM(1); STAMP(2);
    if (IN(2)) {
        const int half = gridDim.x / 2;
#if defined(MK_REPEAT)
        for (int rep9_ = 0; rep9_ < (MK_REPEAT == 9 ? 2 : 1); ++rep9_)
#endif
        if (c < half) {
            pg8::Gemm g{(const f16*)(ws + WS_XN), (const f16*)(ws + WS_WT_IN) + (size_t)4096 * 2048, T_, 1024, 2048}; pg8::StaticOrder S; S.init(T_, 1024, half, c);
            EpiVd E{(bf16_t*)(ws + WS_VD)};
            pg8::gemm_phase<EpiVd, pg8::StaticOrder>(lds + RING_OFF, g, S, E, wave);
            if (TAB_ROWS_P2 > 0 && (MK_DEBUG == 0 || MK_DEBUG >= 6)) p0_tables(args, c * NWAVES + wave, half * NWAVES, TAB_ROWS_P2, lane_id_v());
        } else {
            { pg8::Gemm g{(const f16*)(ws + WS_CQ), (const f16*)(ws + WS_WT_UQ), T_, 2048, 512}; pg8::StaticOrder S; S.init(T_, 2048, half, c - half);
              EpiQup E{(bf16_t*)(ws + WS_QM), (const float*)(ws + WS_SSQ_CQ), args.in[I_GMQ], (const float*)(ws + WS_CS), P};
              pg8::gemm_phase<EpiQup, pg8::StaticOrder>(lds + RING_OFF, g, S, E, wave); }
            { pg8::Gemm g{(const f16*)(ws + WS_CKV), (const f16*)(ws + WS_WT_UKV), T_, 2048, 256}; pg8::StaticOrder S; S.init(T_, 2048, half, c - half);
              EpiKVup E{(bf16_t*)(ws + WS_KM), (bf16_t*)(ws + WS_VM), (const float*)(ws + WS_SSQ_CKV), (const float*)(ws + WS_SSQ_KR), (const float*)(ws + WS_KR), args.in[I_GMK], P};
              pg8::gemm_phase<EpiKVup, pg8::StaticOrder>(lds + RING_OFF, g, S, E, wave); }
        }
#if defined(MK_REPEAT)
        if (MK_REPEAT == 7) { PHASE2_PROBE }
#endif
        PHASE2_EXTRA
    }
    SEAM(2); STAMP(3);
    REP(3) if (IN(3)) { attn_phase(lds + RING_OFF, ws, args.in[I_RELB], c, wave); }
    SEAM(3); STAMP(4);
    REP(4) if (IN(4)) {
        pg8::Gemm g{(const f16*)(ws + WS_Y), (const f16*)(ws + WS_WT_O), T_, 2048, 2048}; pg8::StaticOrder S; S.init(T_, 2048, gridDim.x, c);
        EpiOut E{args.in[I_X], args.out, (f16*)(ws + WS_XN), (float*)(ws + WS_SSQ2)};
        pg8::gemm_phase<EpiOut, pg8::StaticOrder>(lds + RING_OFF, g, S, E, wave);
    }
    SEAM(4); STAMP(5);
    REP(5) if (IN(5)) {
        pg8::Gemm g{(const f16*)(ws + WS_XN), (const f16*)(ws + WS_WT_PQ), T_, 2048, 2048}; pg8::StaticOrder S; S.init(T_, 2048, gridDim.x, c);
        LAS float* R2s = (LAS float*)(lds + R2S_OFF);
        pg8::Unit u0;
        if (S.next(0, u0)) { const int tid = wave * 64 + lane_id_v();
            if (tid < 256) { const float* sp = (const float*)(ws + WS_SSQ2) + (size_t)(u0.pm * 256 + tid) * 32; float ss = 0.f;
#pragma unroll
                for (int i = 0; i < 8; ++i) ss += sum4(*(const f32x4*)(sp + 4 * i));
                R2s[tid] = 1.0f / sqrtf(ss * (1.0f / 2048.0f) + EPS); } }
        __syncthreads();
        EpiQr E{(f16*)(ws + WS_QR), R2s};
        pg8::gemm_phase<EpiQr, pg8::StaticOrder>(lds + RING_OFF, g, S, E, wave);
    }
    SEAM(5); STAMP(6);
#ifdef MK_REPEAT
    if (MK_REPEAT == 6 && IN(6)) { peer_phase(lds + RING_OFF, ws, args.out, (float*)(ws + 416 * MiB), c, wave); xcd_barrier(bar); }
#endif
    if (IN(6)) { peer_phase(lds + RING_OFF, ws, args.out, args.out, c, wave); }
#ifdef MK_PROBE
    if (multi) xcd_barrier(bar);
    STAMP(7);
#endif
#undef IN
#undef SEAM
}

#ifdef MK_PROBE
__global__ void k_probe_report(const unsigned long long* st, int i1, int j1, int i2, int j2, const float* __restrict__ x, float* __restrict__ out, size_t n) {
  const float D1 = (float)(st[j1] - st[i1]) * 0.01f, V = 300.f * (float)(st[j2] - st[i2]) * 0.01f;
  for (size_t i = (size_t)blockIdx.x * 256 + threadIdx.x; i < n; i += (size_t)gridDim.x * 256) out[i] = (i == 0) ? V : x[i] * (1.0f + D1);
}
#endif
extern "C" void kernel_launch(void* const* d_in, const int* in_sizes, int n_in, void* d_out, int out_size, void* d_ws, size_t ws_size, hipStream_t stream) {
    static int ok = 0;
    if (ok == 0) {
        if (n_in != 18 || in_sizes[0] != T_ * D_ || out_size != T_ * D_ || ws_size < (size_t)512 * MiB) { fprintf(stderr, "kernel_launch: unexpected shapes / workspace (n_in %d, ws %zu)\n", n_in, ws_size); ok = -1; return; }
        int dev = 0, cus = 0;
        if (hipGetDevice(&dev) != hipSuccess || hipDeviceGetAttribute(&cus, hipDeviceAttributeMultiprocessorCount, dev) != hipSuccess || cus < NCU) { fprintf(stderr, "kernel_launch: needs a %d-CU device (got %d)\n", NCU, cus); ok = -1; return; }
        if (hipFuncSetAttribute((const void*)mk_fwd, hipFuncAttributeMaxDynamicSharedMemorySize, LDS_BYTES) != hipSuccess) { fprintf(stderr, "kernel_launch: hipFuncSetAttribute failed\n"); ok = -1; return; }
        int per_cu = 0;
        if (hipOccupancyMaxActiveBlocksPerMultiprocessor(&per_cu, (const void*)mk_fwd, NTHR, LDS_BYTES) != hipSuccess || per_cu < 1 || (long)cus * per_cu < NCU) {
            fprintf(stderr, "kernel_launch: the occupancy query admits %d workgroups per CU on %d CUs: a grid of %d would not be co-resident; nothing launched\n", per_cu, cus, NCU); (void)hipGetLastError(); ok = -1; return; }
        ok = 1;
    }
    if (ok < 0) return;
    unsigned char* ws = (unsigned char*)d_ws;
    (void)hipMemsetAsync(ws + WS_CTL, 0, CTL_ZERO_BYTES, stream);
    Args a{};
    for (int i = 0; i < 18; ++i) a.in[i] = (const float*)d_in[i];
    a.out = (float*)d_out; a.ws = ws;
#if MK_DEBUG == 0
#ifdef MK_PROBE
    a.ph_lo = 0; a.ph_hi = N_PHASES;
    hipLaunchKernelGGL(mk_fwd, dim3(NCU), dim3(NTHR), LDS_BYTES, stream, a);
    k_probe_report<<<2048, 256, 0, stream>>>((const unsigned long long*)(ws + 49152), MK_PROBE_I1, MK_PROBE_J1, MK_PROBE_I2, MK_PROBE_J2, a.in[I_X], a.out, (size_t)T_ * D_);
#elif defined(MK_PER_PHASE)
    for (int ph = 0; ph < N_PHASES; ++ph) { a.ph_lo = ph; a.ph_hi = ph + 1; hipLaunchKernelGGL(mk_fwd, dim3(NCU), dim3(NTHR), LDS_BYTES, stream, a); }
#else
    a.ph_lo = 0; a.ph_hi = N_PHASES;
    hipLaunchKernelGGL(mk_fwd, dim3(NCU), dim3(NTHR), LDS_BYTES, stream, a);
#endif
#else
    const float* x = a.in[I_X];
    unsigned* ERR = (unsigned*)(ws + 32768);
    int nslots = 0;
#if MK_DEBUG == 1
    for (int ph = 0; ph < 3; ++ph) { a.ph_lo = ph; a.ph_hi = ph + 1; hipLaunchKernelGGL(mk_fwd, dim3(NCU), dim3(NTHR), LDS_BYTES, stream, a); }
    float* PROJ = (float*)(ws + 288 * MiB); float* H = (float*)(ws + 368 * MiB); float* QRAW = H; float* KVRAW = (float*)(ws + 400 * MiB);
    float* CQN = (float*)(ws + 432 * MiB); float* CKVN = (float*)(ws + 440 * MiB); float* QM = (float*)(ws + 432 * MiB); float* KMT = (float*)(ws + 456 * MiB);
    float* QD = (float*)(ws + 480 * MiB); float* KDT = (float*)(ws + 496 * MiB);
    k_rmsnorm<<<TB0 / 4, 256, 0, stream>>>(x, 2048, 2048, a.in[I_GATTN], H, 2048, TB0);
    k_cmp<<<1024, 256, 0, stream>>>(F_f16_f32{(const f16*)(ws + WS_XN), H}, (size_t)TB0 * 2048, ERR, 0, 0.004f, 0.004f);
    k_gemm<<<dim3((INW + 63) / 64, TB0 / 64), 256, 0, stream>>>(H, 2048, a.in[I_WIN], INW, PROJ, INW, TB0, INW, 2048, nullptr, 0);
    k_cmp<<<1024, 256, 0, stream>>>(F_cols16{(const f16*)(ws + WS_CQ), PROJ, 512, INW, OFF_CQ, 1.f}, (size_t)TB0 * 512, ERR, 1, 0.004f, 0.004f);
    k_cmp<<<1024, 256, 0, stream>>>(F_cols16{(const f16*)(ws + WS_CKV), PROJ, 256, INW, OFF_CKV, 1.f}, (size_t)TB0 * 256, ERR, 2, 0.004f, 0.004f);
    k_cmp<<<1024, 256, 0, stream>>>(F_cols16{(const f16*)(ws + WS_QI), PROJ, 1024, INW, OFF_QI, 0.125f}, (size_t)TB0 * 1024, ERR, 3, 0.004f, 0.0005f);
    k_cmp<<<1024, 256, 0, stream>>>(F_cols16{(const f16*)(ws + WS_KI), PROJ, 64, INW, OFF_KI, 1.f}, (size_t)TB0 * 64, ERR, 4, 0.004f, 0.004f);
    k_cmp<<<1024, 256, 0, stream>>>(F_cols32{(const float*)(ws + WS_WI), PROJ, 16, INW, OFF_WI, 0}, (size_t)TB0 * 16, ERR, 5, 0.004f, 0.004f);
    k_rmsnorm<<<TB0 / 4, 256, 0, stream>>>(PROJ + OFF_CQ, INW, 512, a.in[I_GCQ], CQN, 512, TB0);
    k_rmsnorm<<<TB0 / 4, 256, 0, stream>>>(PROJ + OFF_CKV, INW, 256, a.in[I_GCKV], CKVN, 256, TB0);
    k_gemm<<<dim3(1536 / 64, TB0 / 64), 256, 0, stream>>>(CQN, 512, a.in[I_WUQ], 1536, QRAW, 1536, TB0, 1536, 512, nullptr, 0);
    k_gemm<<<dim3(2048 / 64, TB0 / 64), 256, 0, stream>>>(CKVN, 256, a.in[I_WUKV], 2048, KVRAW, 2048, TB0, 2048, 256, nullptr, 0);
    k_mla_prep<<<TB0 * 8 / 4, 256, 0, stream>>>(QRAW, KVRAW, PROJ, a.in[I_GMQ], a.in[I_GMK], QM, KMT);
    k_dsa_prep<<<TB0 * 8 / 4, 256, 0, stream>>>(PROJ, a.in[I_GDQ], a.in[I_GDK], QD, KDT);
    k_cmp<<<1024, 256, 0, stream>>>(F_heads{(const bf16_t*)(ws + WS_QD), QD, 128, QS_DSA, 0, 0}, (size_t)8 * S_ * 128, ERR, 6, 0.008f, 0.006f * QS_DSA);
    k_cmp<<<1024, 256, 0, stream>>>(F_heads{(const bf16_t*)(ws + WS_KD), KDT, 128, 1.f, 1, 0}, (size_t)8 * S_ * 128, ERR, 7, 0.008f, 0.006f);
    k_cmp<<<1024, 256, 0, stream>>>(F_headcols{(const bf16_t*)(ws + WS_VD), PROJ, INW, OFF_VD, 128, 0}, (size_t)8 * S_ * 128, ERR, 8, 0.008f, 0.006f);
    k_cmp<<<1024, 256, 0, stream>>>(F_heads{(const bf16_t*)(ws + WS_QM), QM, 192, QS_MLA, 0, 1}, (size_t)8 * S_ * 192, ERR, 9, 0.008f, 0.006f * QS_MLA);
    k_cmp<<<1024, 256, 0, stream>>>(F_heads{(const bf16_t*)(ws + WS_KM), KMT, 192, 1.f, 1, 1}, (size_t)8 * S_ * 192, ERR, 10, 0.008f, 0.006f);
    k_cmp<<<1024, 256, 0, stream>>>(F_headcols{(const bf16_t*)(ws + WS_VM), KVRAW, 2048, 128, 256, 0}, (size_t)8 * S_ * 128, ERR, 11, 0.008f, 0.006f);
    nslots = 12;
#endif
#if MK_DEBUG == 2
    for (int ph = 0; ph < 3; ++ph) { a.ph_lo = ph; a.ph_hi = ph + 1; hipLaunchKernelGGL(mk_fwd, dim3(NCU), dim3(NTHR), LDS_BYTES, stream, a); }
    { float* PROJ = (float*)(ws + 288 * MiB); float* H = (float*)(ws + 368 * MiB); float* KIT = (float*)(ws + 400 * MiB); unsigned* MASKN = (unsigned*)(ws + 402 * MiB);
      k_rmsnorm<<<TB0 / 4, 256, 0, stream>>>(x, 2048, 2048, a.in[I_GATTN], H, 2048, TB0);
      k_gemm<<<dim3((INW + 63) / 64, TB0 / 64), 256, 0, stream>>>(H, 2048, a.in[I_WIN], INW, PROJ, INW, TB0, INW, 2048, nullptr, 0);
      k_kit<<<TB0 * 64 / 256, 256, 0, stream>>>(PROJ, KIT);
      k_index<<<TB0 / 2, 128, 0, stream>>>(PROJ, KIT, MASKN);
      k_cmp<<<1024, 256, 0, stream>>>(F_mask{(const unsigned*)(ws + WS_MASK), MASKN}, (size_t)TB0 * 128, ERR, 0, 0.f, 4.0f);
      nslots = 1; }
#endif
#if MK_DEBUG == 3
    for (int ph = 0; ph < 4; ++ph) { a.ph_lo = ph; a.ph_hi = ph + 1; hipLaunchKernelGGL(mk_fwd, dim3(NCU), dim3(NTHR), LDS_BYTES, stream, a); }
    { float* PROJ = (float*)(ws + 288 * MiB); float* H = (float*)(ws + 368 * MiB); float* QRAW = H; float* KVRAW = (float*)(ws + 400 * MiB);
      float* CQN = (float*)(ws + 432 * MiB); float* CKVN = (float*)(ws + 440 * MiB); float* QM = (float*)(ws + 432 * MiB); float* KMT = (float*)(ws + 456 * MiB);
      float* QD = (float*)(ws + 480 * MiB); float* KDT = (float*)(ws + 496 * MiB); float* KIT = (float*)(ws + 368 * MiB); unsigned* MASKN = (unsigned*)(ws + 370 * MiB); float* YN = a.out;
      k_rmsnorm<<<TB0 / 4, 256, 0, stream>>>(x, 2048, 2048, a.in[I_GATTN], H, 2048, TB0);
      k_gemm<<<dim3((INW + 63) / 64, TB0 / 64), 256, 0, stream>>>(H, 2048, a.in[I_WIN], INW, PROJ, INW, TB0, INW, 2048, nullptr, 0);
      k_rmsnorm<<<TB0 / 4, 256, 0, stream>>>(PROJ + OFF_CQ, INW, 512, a.in[I_GCQ], CQN, 512, TB0);
      k_rmsnorm<<<TB0 / 4, 256, 0, stream>>>(PROJ + OFF_CKV, INW, 256, a.in[I_GCKV], CKVN, 256, TB0);
      k_gemm<<<dim3(1536 / 64, TB0 / 64), 256, 0, stream>>>(CQN, 512, a.in[I_WUQ], 1536, QRAW, 1536, TB0, 1536, 512, nullptr, 0);
      k_gemm<<<dim3(2048 / 64, TB0 / 64), 256, 0, stream>>>(CKVN, 256, a.in[I_WUKV], 2048, KVRAW, 2048, TB0, 2048, 256, nullptr, 0);
      k_mla_prep<<<TB0 * 8 / 4, 256, 0, stream>>>(QRAW, KVRAW, PROJ, a.in[I_GMQ], a.in[I_GMK], QM, KMT);
      k_attn<192><<<8 * S_ / 4, 256, 0, stream>>>(QM, KMT, KVRAW, 2048, 128, 256, 0.07216878364870322f, nullptr, nullptr, YN, 0);
      k_dsa_prep<<<TB0 * 8 / 4, 256, 0, stream>>>(PROJ, a.in[I_GDQ], a.in[I_GDK], QD, KDT);
      k_kit<<<TB0 * 64 / 256, 256, 0, stream>>>(PROJ, KIT);
      k_index<<<TB0 / 2, 128, 0, stream>>>(PROJ, KIT, MASKN);
      k_attn<128><<<8 * S_ / 4, 256, 0, stream>>>(QD, KDT, PROJ, INW, OFF_VD, 128, 0.08838834764831845f, (const unsigned*)(ws + WS_MASK), a.in[I_RELB], YN, 1024);
      k_cmp<<<1024, 256, 0, stream>>>(F_ycols{(const f16*)(ws + WS_Y), YN, 0}, (size_t)TB0 * 1024, ERR, 0, 0.02f, 0.004f);
      k_cmp<<<1024, 256, 0, stream>>>(F_ycols{(const f16*)(ws + WS_Y), YN, 1024}, (size_t)TB0 * 1024, ERR, 1, 0.02f, 0.004f);
      nslots = 2; }
#endif
    k_report<<<2048, 256, 0, stream>>>(ERR, nslots, x, a.out, (size_t)T_ * D_);
#endif
    const hipError_t le = hipPeekAtLastError();
    if (le != hipSuccess) fprintf(stderr, "kernel_launch: launch failed: %s\n", hipGetErrorName(le));
}
```
